# Optimizing an MI355X kernel written in HIP

```python
import math
import jax, jax.numpy as jnp
from jax import lax
import numpy as np

D_MODEL = 2048
BATCH = 1
SEQ = 8192
DEPTH = 1

CHUNK = 64
EPS = 1e-6
A_HEADS = 8
A_HEAD_DIM = 128
A_WIDTH = A_HEADS * A_HEAD_DIM
B_HEADS = 8
B_HEAD_DIM = 128
B_WIDTH = B_HEADS * B_HEAD_DIM
Q_RANK = 512
KV_RANK = 256
IDX_HEADS = 16
IDX_DIM = 128
TOPK_MAX = 256
Q_BLOCK = 128
REL_BUCKETS = 32
REL_MAX_DIST = 128

SPLIT_SIZES = (A_WIDTH, A_WIDTH, A_WIDTH, A_WIDTH,
               Q_RANK, KV_RANK, IDX_DIM, IDX_HEADS, B_WIDTH,
               D_MODEL, D_MODEL)
SPLIT_POINTS = tuple(sum(SPLIT_SIZES[:i + 1]) for i in range(len(SPLIT_SIZES) - 1))
IN_WIDTH = sum(SPLIT_SIZES)

kernel_name = 'hgrn2_dsa_gated_hybrid_block'

F32 = jnp.float32


def rmsnorm(x, w):
    x32 = x.astype(F32)
    y = x32 * lax.rsqrt(jnp.mean(x32 * x32, axis=-1, keepdims=True) + EPS) * w.astype(F32)
    return y.astype(x.dtype)


def layernorm(x, w, b):
    x32 = x.astype(F32)
    mu = jnp.mean(x32, axis=-1, keepdims=True)
    var = jnp.mean(jnp.square(x32 - mu), axis=-1, keepdims=True)
    y = (x32 - mu) * lax.rsqrt(var + EPS) * w.astype(F32) + b.astype(F32)
    return y.astype(x.dtype)


def t5_bucket(rel):
    half = REL_BUCKETS // 2
    max_exact = half // 2
    base = jnp.where(rel > 0, half, 0)
    n = jnp.abs(rel)
    large = max_exact + (jnp.log(jnp.maximum(n, 1).astype(F32) / max_exact)
                         / math.log(REL_MAX_DIST / max_exact) * (half - max_exact)).astype(jnp.int32)
    large = jnp.minimum(large, half - 1)
    return base + jnp.where(n < max_exact, n, large)


def hgrn2_recurrence(q, k, log_f, v):
    b_, s_, h_, dk = q.shape
    dv = v.shape[-1]
    nc = s_ // CHUNK

    def to_chunks(t):
        return jnp.moveaxis(t.reshape(b_, nc, CHUNK, h_, t.shape[-1]), 1, 0)

    causal = jnp.tril(jnp.ones((CHUNK, CHUNK), bool))

    def step(state, inp):
        q_c, k_c, g_c, v_c = inp
        cum = jnp.cumsum(g_c, axis=1)
        inter = jnp.einsum('bthk,bhkv->bthv', q_c * jnp.exp(cum), state)
        diff = cum[:, :, None] - cum[:, None, :]
        decay = jnp.exp(jnp.where(causal[None, :, :, None, None], diff, -jnp.inf))
        scores = jnp.einsum('bthk,bshk,btshk->bhts', q_c, k_c, decay)
        intra = jnp.einsum('bhts,bshv->bthv', scores, v_c)
        last = cum[:, -1]
        new_state = (jnp.exp(last)[..., None] * state
                     + jnp.einsum('bshk,bshv->bhkv', k_c * jnp.exp(last[:, None] - cum), v_c))
        return new_state, inter + intra

    init = jnp.zeros((b_, h_, dk, dv), F32)
    _, out = lax.scan(step, init, (to_chunks(q), to_chunks(k), to_chunks(log_f), to_chunks(v)))
    return jnp.moveaxis(out, 0, 1).reshape(b_, s_, h_, dv)


def hgrn2_branch(a_q, a_f, a_i, a_g, lb, gnorm_w):
    b_, s_, _ = a_q.shape
    shp = (b_, s_, A_HEADS, A_HEAD_DIM)
    q = (jax.nn.silu(a_q.astype(F32)) * A_HEAD_DIM ** -0.5).reshape(shp)
    f = lb + (1.0 - lb) * jax.nn.sigmoid(a_f.astype(F32))
    k = (1.0 - f).reshape(shp)
    log_f = jnp.log(f).reshape(shp)
    v = a_i.astype(F32).reshape(shp)
    o = hgrn2_recurrence(q, k, log_f, v)
    o = rmsnorm(o, gnorm_w).reshape(b_, s_, A_WIDTH)
    return (o * jax.nn.silu(a_g.astype(F32))).astype(a_q.dtype)


def dsa_branch(c_q, c_kv, k_idx_raw, w_idx_raw, b_g, q_norm_w, kv_norm_w, w_uq, w_qidx,
               w_ukv, kidx_norm_w, kidx_norm_b, rel_bias, topk):
    b_, s_, _ = c_q.shape
    nb = s_ // Q_BLOCK
    cq = rmsnorm(c_q, q_norm_w)
    q = (cq @ w_uq).reshape(b_, s_, B_HEADS, B_HEAD_DIM)
    q_idx = (cq @ w_qidx).reshape(b_, s_, IDX_HEADS, IDX_DIM)
    kv = (rmsnorm(c_kv, kv_norm_w) @ w_ukv).reshape(b_, s_, B_HEADS, 2 * B_HEAD_DIM)
    k, v = kv[..., :B_HEAD_DIM], kv[..., B_HEAD_DIM:]
    k_idx = layernorm(k_idx_raw, kidx_norm_w, kidx_norm_b).astype(F32)
    w_idx = w_idx_raw.astype(F32) * (IDX_HEADS ** -0.5 * IDX_DIM ** -0.5)
    key_chunk = jnp.arange(s_) // CHUNK
    bias_table = rel_bias.astype(F32)

    def to_blocks(t):
        return jnp.moveaxis(t.reshape((b_, nb, Q_BLOCK) + t.shape[2:]), 1, 0)

    def attend_block(inp):
        q_blk, qi_blk, wi_blk, t0 = inp
        t_pos = t0 + jnp.arange(Q_BLOCK)
        rel_scores = jax.nn.relu(jnp.einsum('bthd,bsd->bths', qi_blk.astype(F32), k_idx))
        score = jnp.einsum('bths,bth->bts', rel_scores, wi_blk)
        visible = key_chunk[None, :] <= (t_pos // CHUNK)[:, None]
        score = jnp.where(visible[None], score, -jnp.inf)
        top_val, top_idx = lax.top_k(score, topk)
        valid = jnp.isfinite(top_val)
        k_sel = jax.vmap(lambda kk, ii: kk[ii])(k, top_idx)
        v_sel = jax.vmap(lambda vv, ii: vv[ii])(v, top_idx)
        logits = jnp.einsum('bthd,btkhd->bthk', q_blk, k_sel).astype(F32) * B_HEAD_DIM ** -0.5
        bias = jnp.moveaxis(bias_table[t5_bucket(top_idx - t_pos[None, :, None])], -1, 2)
        logits = jnp.where(valid[:, :, None, :], logits + bias, -jnp.inf)
        probs = jax.nn.softmax(logits, axis=-1).astype(v.dtype)
        return jnp.einsum('bthk,btkhd->bthd', probs, v_sel)

    out = lax.map(attend_block, (to_blocks(q), to_blocks(q_idx), to_blocks(w_idx),
                                 jnp.arange(nb, dtype=jnp.int32) * Q_BLOCK))
    out = jnp.moveaxis(out, 0, 1).reshape(b_, s_, B_WIDTH)
    return out * jax.nn.silu(b_g)


def setup_inputs(seed: int = 0) -> dict:
    key = jax.random.key(seed)
    ks = jax.random.split(key, 20)
    nrm = lambda k, shape, scale: jax.random.normal(k, shape, F32) * scale
    return {
        'x': nrm(ks[0], (BATCH, SEQ, D_MODEL), 1.0),
        'norm_w': 1.0 + nrm(ks[1], (DEPTH, D_MODEL), 0.02),
        'w_in': nrm(ks[2], (DEPTH, D_MODEL, IN_WIDTH), D_MODEL ** -0.5),
        'lb_table': nrm(ks[3], (DEPTH + 1, A_WIDTH), 0.1),
        'gnorm_a': 1.0 + nrm(ks[4], (DEPTH, A_HEAD_DIM), 0.02),
        'q_norm_w': 1.0 + nrm(ks[5], (DEPTH, Q_RANK), 0.02),
        'kv_norm_w': 1.0 + nrm(ks[6], (DEPTH, KV_RANK), 0.02),
        'w_uq': nrm(ks[7], (DEPTH, Q_RANK, B_WIDTH), Q_RANK ** -0.5),
        'w_qidx': nrm(ks[8], (DEPTH, Q_RANK, IDX_HEADS * IDX_DIM), Q_RANK ** -0.5),
        'w_ukv': nrm(ks[9], (DEPTH, KV_RANK, 2 * B_WIDTH), KV_RANK ** -0.5),
        'kidx_norm_w': 1.0 + nrm(ks[10], (DEPTH, IDX_DIM), 0.02),
        'kidx_norm_b': nrm(ks[11], (DEPTH, IDX_DIM), 0.02),
        'w_pa': nrm(ks[12], (DEPTH, A_WIDTH, D_MODEL), A_WIDTH ** -0.5),
        'w_pb': nrm(ks[13], (DEPTH, B_WIDTH, D_MODEL), B_WIDTH ** -0.5),
        'w_out': nrm(ks[14], (DEPTH, D_MODEL, D_MODEL), D_MODEL ** -0.5),
        'rel_bias': nrm(ks[15], (REL_BUCKETS, B_HEADS), 0.5),
        'final_norm_w': 1.0 + nrm(ks[16], (D_MODEL,), 0.02),
    }


def reference(x, norm_w, w_in, lb_table, gnorm_a, q_norm_w, kv_norm_w, w_uq, w_qidx, w_ukv,
              kidx_norm_w, kidx_norm_b, w_pa, w_pb, w_out, rel_bias, final_norm_w):
    s_ = x.shape[1]
    topk = min(TOPK_MAX, s_ // 4)
    lb_all = jnp.cumsum(jax.nn.softmax(lb_table.astype(F32), axis=0), axis=0)
    for layer in range(DEPTH):
        h = rmsnorm(x, norm_w[layer])
        proj = h @ w_in[layer]
        (a_q, a_f, a_i, a_g, c_q, c_kv, k_idx_raw, w_idx_raw, b_g, m_a, m_b) = jnp.split(
            proj, SPLIT_POINTS, axis=-1)
        y_a = hgrn2_branch(a_q, a_f, a_i, a_g, lb_all[layer], gnorm_a[layer])
        y_b = dsa_branch(c_q, c_kv, k_idx_raw, w_idx_raw, b_g, q_norm_w[layer], kv_norm_w[layer],
                         w_uq[layer], w_qidx[layer], w_ukv[layer], kidx_norm_w[layer],
                         kidx_norm_b[layer], rel_bias, topk)
        merged = (jax.nn.sigmoid(m_a) * (y_a @ w_pa[layer])
                  + jax.nn.sigmoid(m_b) * (y_b @ w_pb[layer]))
        x = x + merged @ w_out[layer]
    return rmsnorm(x, final_norm_w)
```

```cpp
#include <hip/hip_runtime.h>
#include <cstdio>

#define LAS __attribute__((address_space(3)))
#define GAS __attribute__((address_space(1)))
typedef unsigned short bf16;
typedef short bf16x8 __attribute__((ext_vector_type(8)));
typedef short s16x4 __attribute__((ext_vector_type(4)));
typedef float f32x4 __attribute__((ext_vector_type(4)));
typedef float f32x2 __attribute__((ext_vector_type(2)));
typedef float f32x16 __attribute__((ext_vector_type(16)));
typedef unsigned u32x4 __attribute__((ext_vector_type(4)));
typedef unsigned u32x2 __attribute__((ext_vector_type(2)));

namespace pg8 {
constexpr int BM = 256, BK = 64, HALF = 128, HTB = HALF * BK * 2, STAGE_BYTES = 8 * HTB, NXCD = 8, WGM = 8;
__device__ __forceinline__ int lds_byte(int r, int c) { const int st = (r >> 4) * 2 + (c >> 5), rr = r & 15, cc = c & 31, ob = rr * 64 + cc * 2; return st * 1024 + (ob ^ (((ob >> 9) & 1) << 5)); }
__device__ __forceinline__ void stage_rc(int b, int& R, int& C) { const int st = b / 1024, sb = b % 1024, swz = sb ^ (((sb >> 9) & 1) << 5); R = (st >> 1) * 16 + swz / 64; C = (st & 1) * 32 + (swz % 64) / 2; }
__device__ __forceinline__ int perm32(int rho) { const int n = rho >> 4, i = rho & 15; return 8 * (i >> 2) + 4 * n + (i & 3); }
struct Unit { int pm, pn, sub; };
struct TileOrder {
    int nM, nN, nwg, G, c;
    __device__ void init(int M, int N, int G_, int c_) { nM = M / BM; nN = N / BM; nwg = nM * nN; G = G_; c = c_; }
    __device__ bool tile(int i, int& pm, int& pn) const {
        const long L = (long)i * G + c; if (L >= nwg) return false;
        int wgid = (int)L; { const int q = nwg / NXCD, r = nwg % NXCD, xcd = wgid % NXCD, off = wgid / NXCD; wgid = (xcd < r ? xcd * (q + 1) : r * (q + 1) + (xcd - r) * q) + off; }
        const int nig = WGM * nN, gid = wgid / nig, fm = gid * WGM, gsz = (nM - fm) < WGM ? (nM - fm) : WGM;
        pm = fm + ((wgid % nig) % gsz); pn = (wgid % nig) / gsz; return true;
    }
};
template <class Epi, class Sched, bool ALIGN_EPI = true, bool SP2 = true>
__device__ __forceinline__ void gemm_phase(LAS unsigned char* lds, const int lda, const int ldb, const int K, const Sched& S, const Epi& E) {
    const int tid = threadIdx.x, wid = __builtin_amdgcn_readfirstlane(tid >> 6), lane = tid & 63, wr = wid >> 2, wc = wid & 3, fr = lane & 15, fq = lane >> 4;
    const int nt = K / BK;
    unsigned voffA[2], voffB[2];
#pragma unroll
    for (int i = 0; i < 2; ++i) { int R, C; stage_rc(tid * 16 + i * 8192, R, C); const int Rb = (R & ~31) + perm32(R & 31);
        voffA[i] = (unsigned)(R * lda + C) * 2u; voffB[i] = (unsigned)(Rb * ldb + C) * 2u; }
    const size_t kstep = (size_t)(BK * 2);
    const size_t hstepA = (size_t)HALF * lda * 2, hstepB = (size_t)HALF * ldb * 2;
    const unsigned ldsw = (unsigned)wid * 1024u;
    const int aoff = lds_byte(wr * 64 + fr, fq * 8), boff = lds_byte(wc * 32 + fr, fq * 8);
#define PG8_SA(b, h) (((b) * 2 + (h)) * HTB)
#define PG8_SB(b, h) ((4 + (b) * 2 + (h)) * HTB)
#define PG8_STAGE(bufoff, gbase, voff) do { _Pragma("unroll") for (int _i = 0; _i < 2; ++_i) \
        __builtin_amdgcn_global_load_lds((const unsigned*)((const char*)(gbase) + (voff)[_i]), (LAS unsigned*)(lds + (bufoff) + ldsw + _i * 8192), 16, 0, 0); } while (0)
#define PG8_LDA(dst, b, h) do { _Pragma("unroll") for (int m = 0; m < 4; ++m) _Pragma("unroll") for (int k = 0; k < 2; ++k) dst[m][k] = *(const LAS bf16x8*)(lds + PG8_SA(b, h) + aoff + m * 2048 + k * 1024); } while (0)
#define PG8_LDB(dst, b, h) do { _Pragma("unroll") for (int n = 0; n < 2; ++n) _Pragma("unroll") for (int k = 0; k < 2; ++k) dst[n][k] = *(const LAS bf16x8*)(lds + PG8_SB(b, h) + boff + n * 2048 + k * 1024); } while (0)
#define PG8_MMA(ai, bj, At, Bt) do { __builtin_amdgcn_s_setprio(1); _Pragma("unroll") for (int m = 0; m < 4; ++m) _Pragma("unroll") for (int n = 0; n < 2; ++n) _Pragma("unroll") for (int k = 0; k < 2; ++k) \
        acc[ai][bj][m][n] = __builtin_amdgcn_mfma_f32_16x16x32_bf16(Bt[n][k], At[m][k], acc[ai][bj][m][n], 0, 0, 0); __builtin_amdgcn_s_setprio(0); } while (0)
#define PG8_WAIT_V(n) asm volatile("s_waitcnt vmcnt(" #n ")" ::: "memory")
#define PG8_WAIT_L(n) asm volatile("s_waitcnt lgkmcnt(" #n ")" ::: "memory")
#define PG8_BAR __builtin_amdgcn_s_barrier()
#define PG8_SCHED __builtin_amdgcn_sched_barrier(0)
    Unit cur, nxt; int ui = 0;
    if (!S.next(0, cur)) return;
    f32x4 acc[2][2][4][2];
#pragma unroll
    for (int a = 0; a < 2; ++a)
#pragma unroll
        for (int b = 0; b < 2; ++b)
#pragma unroll
            for (int m = 0; m < 4; ++m)
#pragma unroll
                for (int n = 0; n < 2; ++n) acc[a][b][m][n] = (f32x4){0.f, 0.f, 0.f, 0.f};
    bf16x8 At[4][2], B0[2][2], B1[2][2];
    const char* cA = S.A(cur); const char* cB = S.B(cur);
    if constexpr (SP2) {
        PG8_STAGE(PG8_SB(0, 0), cB, voffB); PG8_STAGE(PG8_SB(0, 1), cB + hstepB, voffB); PG8_STAGE(PG8_SA(0, 0), cA, voffA); PG8_STAGE(PG8_SA(0, 1), cA + hstepA, voffA);
        if (wr == 1) PG8_BAR;
        PG8_WAIT_V(2); PG8_BAR;
        PG8_STAGE(PG8_SB(1, 0), cB + kstep, voffB); PG8_STAGE(PG8_SA(1, 0), cA + kstep, voffA); PG8_STAGE(PG8_SB(1, 1), cB + hstepB + kstep, voffB);
        PG8_WAIT_V(6); PG8_BAR;
    } else {
        PG8_STAGE(PG8_SB(0, 0), cB, voffB); PG8_STAGE(PG8_SA(0, 0), cA, voffA); PG8_STAGE(PG8_SB(0, 1), cB + hstepB, voffB); PG8_STAGE(PG8_SA(0, 1), cA + hstepA, voffA);
        if (wr == 1) PG8_BAR;
        PG8_WAIT_V(4); PG8_BAR;
        PG8_STAGE(PG8_SB(1, 0), cB + kstep, voffB); PG8_STAGE(PG8_SA(1, 0), cA + kstep, voffA); PG8_STAGE(PG8_SB(1, 1), cB + hstepB + kstep, voffB);
        PG8_WAIT_V(6); PG8_BAR;
    }
    for (;;) {
        const bool has_next = S.next(ui + 1, nxt);
        const char* nA = has_next ? S.A(nxt) : cA; const char* nB = has_next ? S.B(nxt) : cB;
        for (int t = 0; t < nt; t += 2) {
            const bool last = (t == nt - 2);
            const char* a1 = cA + (size_t)(t + 1) * kstep;
            const char* a2 = last ? nA : cA + (size_t)(t + 2) * kstep; const char* b2 = last ? nB : cB + (size_t)(t + 2) * kstep;
            const char* a3 = a2 + kstep; const char* b3 = b2 + kstep;
            if constexpr (SP2) {
            PG8_LDB(B0, 0, 0); PG8_LDB(B1, 0, 1); PG8_SCHED; PG8_LDA(At, 0, 0); PG8_STAGE(PG8_SA(1, 1), a1 + hstepA, voffA);
            PG8_WAIT_V(8); PG8_WAIT_L(0); PG8_BAR; PG8_MMA(0, 0, At, B0); PG8_MMA(0, 1, At, B1); PG8_BAR; PG8_SCHED;
            PG8_LDA(At, 0, 1); PG8_STAGE(PG8_SB(0, 0), b2, voffB); PG8_STAGE(PG8_SB(0, 1), b2 + hstepB, voffB); PG8_STAGE(PG8_SA(0, 0), a2, voffA);
            PG8_WAIT_V(8); PG8_WAIT_L(0); PG8_BAR; PG8_MMA(1, 0, At, B0); PG8_MMA(1, 1, At, B1); PG8_BAR; PG8_SCHED;
            PG8_LDB(B0, 1, 0); PG8_LDB(B1, 1, 1); PG8_SCHED; PG8_LDA(At, 1, 0); PG8_STAGE(PG8_SA(0, 1), a2 + hstepA, voffA);
            PG8_WAIT_V(8); PG8_WAIT_L(0); PG8_BAR; PG8_MMA(0, 0, At, B0); PG8_MMA(0, 1, At, B1); PG8_BAR; PG8_SCHED;
            PG8_LDA(At, 1, 1); PG8_STAGE(PG8_SB(1, 0), b3, voffB); PG8_STAGE(PG8_SB(1, 1), b3 + hstepB, voffB); PG8_STAGE(PG8_SA(1, 0), a3, voffA);
            PG8_WAIT_V(8); PG8_WAIT_L(0); PG8_BAR; PG8_MMA(1, 0, At, B0); PG8_MMA(1, 1, At, B1); PG8_BAR; PG8_SCHED;
            } else {
            PG8_LDB(B0, 0, 0); PG8_SCHED; PG8_LDA(At, 0, 0); PG8_STAGE(PG8_SA(1, 1), a1 + hstepA, voffA);
            PG8_WAIT_L(8); PG8_BAR; PG8_WAIT_L(0); PG8_MMA(0, 0, At, B0); PG8_BAR; PG8_SCHED;
            PG8_LDB(B1, 0, 1); PG8_STAGE(PG8_SB(0, 0), b2, voffB);
            PG8_BAR; PG8_WAIT_L(0); PG8_MMA(0, 1, At, B1); PG8_BAR;
            PG8_LDA(At, 0, 1); PG8_STAGE(PG8_SA(0, 0), a2, voffA);
            PG8_BAR; PG8_WAIT_L(0); PG8_MMA(1, 0, At, B0); PG8_BAR; PG8_SCHED;
            PG8_STAGE(PG8_SB(0, 1), b2 + hstepB, voffB);
            PG8_WAIT_V(6); PG8_BAR; PG8_MMA(1, 1, At, B1); PG8_BAR;
            PG8_LDB(B0, 1, 0); PG8_SCHED; PG8_LDA(At, 1, 0); PG8_STAGE(PG8_SA(0, 1), a2 + hstepA, voffA);
            PG8_WAIT_L(8); PG8_BAR; PG8_WAIT_L(0); PG8_MMA(0, 0, At, B0); PG8_BAR; PG8_SCHED;
            PG8_LDB(B1, 1, 1); PG8_STAGE(PG8_SB(1, 0), b3, voffB);
            PG8_BAR; PG8_WAIT_L(0); PG8_MMA(0, 1, At, B1); PG8_BAR;
            PG8_LDA(At, 1, 1); PG8_STAGE(PG8_SA(1, 0), a3, voffA);
            PG8_BAR; PG8_WAIT_L(0); PG8_MMA(1, 0, At, B0); PG8_BAR; PG8_SCHED;
            PG8_STAGE(PG8_SB(1, 1), b3 + hstepB, voffB);
            PG8_WAIT_V(6); PG8_BAR; PG8_MMA(1, 1, At, B1); PG8_BAR;
            }
        }
        if constexpr (ALIGN_EPI) { if (wr == 0) PG8_BAR; }
        E(acc, cur, wr, wc, fr, fq);
        if (!has_next) break;
        if (!S.keep(cur)) {
#pragma unroll
            for (int a = 0; a < 2; ++a)
#pragma unroll
                for (int b = 0; b < 2; ++b)
#pragma unroll
                    for (int m = 0; m < 4; ++m)
#pragma unroll
                        for (int n = 0; n < 2; ++n) acc[a][b][m][n] = (f32x4){0.f, 0.f, 0.f, 0.f};
        }
        cur = nxt; cA = nA; cB = nB; ++ui;
        if constexpr (ALIGN_EPI) { if (wr == 1) PG8_BAR; }
    }
    PG8_WAIT_V(0);
    if constexpr (!ALIGN_EPI) { if (wr == 0) PG8_BAR; }
    PG8_BAR;
#undef PG8_SA
#undef PG8_SB
#undef PG8_STAGE
#undef PG8_LDA
#undef PG8_LDB
#undef PG8_MMA
#undef PG8_WAIT_V
#undef PG8_WAIT_L
#undef PG8_BAR
#undef PG8_SCHED
}
}

#ifndef PROBE_REP
#define PROBE_REP -1
#endif
#define REP(k) for (int _r = 0; _r < ((k) == PROBE_REP ? 2 : 1); ++_r)
constexpr int S_ = 8192, D_ = 2048, AW = 1024, QR = 512, KVR = 256, IDXD = 128, IDXH = 16, BH = 8, TOPK = 256, CHUNK = 64, NCH = S_ / CHUNK;
constexpr int IN_W = 10128, NIN = 10240;
constexpr float EPS = 1e-6f;
constexpr int NWAVES = 8, NTHR = 512;

constexpr size_t MiB = 1u << 20;
constexpr size_t WS_CTL = 0, CTL_ZERO_BYTES = 1 * MiB;
constexpr size_t WS_LB = 1 * MiB;
constexpr size_t WS_NCNT = 1 * MiB + 64 * 1024;
constexpr size_t WS_DLAST = 1 * MiB + 128 * 1024;
constexpr size_t WS_WIDX = 2 * MiB;
constexpr size_t WS_WQ = 4 * MiB;
constexpr size_t WS_WUV = 8 * MiB;
constexpr size_t WS_WPA = 9 * MiB, WS_WPB = 13 * MiB;
constexpr size_t WS_WOUT = 17 * MiB;
constexpr size_t WS_QA = 25 * MiB;
constexpr size_t WS_G = 41 * MiB;
constexpr size_t WS_VA = 73 * MiB;
constexpr size_t WS_GA = 89 * MiB;
constexpr size_t WS_GB = 105 * MiB;
constexpr size_t WS_SA = 121 * MiB;
constexpr size_t WS_SB = 153 * MiB;
constexpr size_t WS_RAW = 185 * MiB;
constexpr size_t WS_H = 217 * MiB;
constexpr size_t WS_CQN = 217 * MiB, WS_CKVN = 225 * MiB, WS_KIDX = 229 * MiB, WS_IDX = 231 * MiB;
constexpr size_t WS_WIN = 249 * MiB;
constexpr size_t WS_QABS = 249 * MiB;
constexpr size_t WS_SPT = 281 * MiB;
constexpr size_t WS_END = 313 * MiB;
constexpr int RS_WORD = 65536;
constexpr int CW_BAR = 4096;

typedef __bf16 bf16x2_t __attribute__((ext_vector_type(2)));
typedef short s16x2 __attribute__((ext_vector_type(2)));
__device__ __forceinline__ unsigned pk2(float lo, float hi) { const f32x2 v = {lo, hi}; return __builtin_bit_cast(unsigned, __builtin_convertvector(v, bf16x2_t)); }
__device__ __forceinline__ unsigned f2bf(float f) { return pk2(f, 0.f) & 0xffffu; }
__device__ __forceinline__ unsigned pk2_relu(float lo, float hi) { const f32x2 v = {lo, hi}; const s16x2 z = {0, 0};
    return __builtin_bit_cast(unsigned, __builtin_elementwise_max(__builtin_bit_cast(s16x2, __builtin_convertvector(v, bf16x2_t)), z)); }
__device__ __forceinline__ float bf2f(unsigned short b) { return __builtin_bit_cast(float, ((unsigned)b) << 16); }
__device__ __forceinline__ float bflo(unsigned w) { return __builtin_bit_cast(float, w << 16); }
__device__ __forceinline__ float bfhi(unsigned w) { return __builtin_bit_cast(float, w & 0xffff0000u); }
__device__ __forceinline__ float wave_sum(float v) {
#pragma unroll
    for (int o = 1; o < 64; o <<= 1) v += __shfl_xor(v, o);
    return v;
}
__device__ __forceinline__ float sigmoidf_(float x) { return __builtin_amdgcn_rcpf(1.0f + __expf(-x)); }
__device__ __forceinline__ float siluf_(float x) { return x * __builtin_amdgcn_rcpf(1.0f + __expf(-x)); }
#define LDS_WAIT() asm volatile("s_waitcnt lgkmcnt(0)" ::: "memory")
#define VM_WAIT() asm volatile("s_waitcnt vmcnt(0)" ::: "memory")

#define XB_TMO      128
#define XB_XCNT(j)  (256  + 64 * (j))
#define XB_XSUB(j)  (1280 + 64 * (j))
#define XB_XGEN(j)  (2304 + 64 * (j))
#define XB_TOP      3328
#define XB_TOPGEN   3392
#define XCD_BAR_WORDS 3456
#define XB_SPIN_CAP (1u << 22)
__device__ __forceinline__ unsigned xb_ld(unsigned* p)              { return __hip_atomic_load(p, __ATOMIC_RELAXED, __HIP_MEMORY_SCOPE_AGENT); }
__device__ __forceinline__ unsigned xb_add(unsigned* p, unsigned v) { return __hip_atomic_fetch_add(p, v, __ATOMIC_RELAXED, __HIP_MEMORY_SCOPE_AGENT); }
__device__ __forceinline__ unsigned xb_xcc_id() { return (unsigned)__builtin_amdgcn_s_getreg((3 << 11) | 20) & 0xFu; }
#define XB_SPIN(cond, bar) do { unsigned _sp = 0; while (cond) { __builtin_amdgcn_s_sleep(1); \
    if ((++_sp & 255u) == 0u) { if (xb_ld(&(bar)[XB_TMO])) break; if (_sp > XB_SPIN_CAP) { atomicAdd(&(bar)[XB_TMO], 1u); break; } } } } while (0)
struct XcdBarrier { unsigned* bar; unsigned x; volatile LAS unsigned* st; };
__device__ __forceinline__ XcdBarrier xcd_barrier_post(unsigned* bar, volatile LAS unsigned* st) {
    XcdBarrier b; b.bar = bar; b.x = xb_xcc_id(); b.st = st;
    if (threadIdx.x == 0) (void)xb_add(&bar[XB_XCNT(b.x)], 1u);
    return b;
}
__device__ __forceinline__ void xcd_barrier_complete(unsigned* bar, unsigned x, unsigned& nloc, unsigned& nx) {
    const unsigned G = gridDim.x * gridDim.y * gridDim.z;
    unsigned sum, cnt, mine, sp = 0u;
    for (;;) {
        sum = 0u; cnt = 0u; mine = 0u;
#pragma unroll
        for (unsigned j = 0; j < 16; ++j) { const unsigned c = xb_ld(&bar[XB_XCNT(j)]); sum += c; cnt += (c > 0u) ? 1u : 0u; mine = (j == x) ? c : mine; }
        if (sum == G) break;
        __builtin_amdgcn_s_sleep(1);
        if ((++sp & 255u) == 0u) { if (xb_ld(&bar[XB_TMO])) break; if (sp > XB_SPIN_CAP) { atomicAdd(&bar[XB_TMO], 1u); break; } }
    }
    nloc = mine > 0u ? mine : 1u; nx = cnt > 0u ? cnt : 1u;
}
__device__ __forceinline__ void xcd_barrier(const XcdBarrier& b) {
    asm volatile("s_waitcnt vmcnt(0)" ::: "memory");
    __syncthreads();
    if (threadIdx.x == 0) {
        unsigned* bar = b.bar;
        __builtin_amdgcn_s_waitcnt(0);
        unsigned nloc = b.st[0], nx = b.st[1];
        if (nloc == 0u) { xcd_barrier_complete(bar, b.x, nloc, nx); b.st[0] = nloc; b.st[1] = nx; }
        const unsigned old = xb_add(&bar[XB_XSUB(b.x)], 1u);
        const unsigned gen = old / nloc;
        if (old + 1u == (gen + 1u) * nloc) {
            __builtin_amdgcn_fence(__ATOMIC_RELEASE, "agent");
            asm volatile("s_waitcnt vmcnt(0)" ::: "memory");
            const unsigned og = xb_add(&bar[XB_TOP], 1u);
            const unsigned tg = og / nx;
            if (og + 1u == (tg + 1u) * nx) xb_add(&bar[XB_TOPGEN], 1u);
            else XB_SPIN(xb_ld(&bar[XB_TOPGEN]) == tg, bar);
            __builtin_amdgcn_fence(__ATOMIC_ACQUIRE, "agent");
            xb_add(&bar[XB_XGEN(b.x)], 1u);
            asm volatile("s_waitcnt vmcnt(0)" ::: "memory");
        } else {
            XB_SPIN(xb_ld(&bar[XB_XGEN(b.x)]) == gen, bar);
            __builtin_amdgcn_fence(__ATOMIC_ACQUIRE, "agent");
            asm volatile("s_waitcnt vmcnt(0)" ::: "memory");
        }
    }
    __syncthreads();
}

struct Args {
    const float *x, *norm_w, *w_in, *lb_table, *gnorm_a, *q_norm_w, *kv_norm_w, *w_uq, *w_qidx, *w_ukv, *kidx_norm_w, *kidx_norm_b, *w_pa, *w_pb, *w_out, *rel_bias, *final_norm_w;
    float* out; unsigned char* ws; int ph_lo, ph_hi;
};
constexpr int LDS_BYTES = 155648;
constexpr int MISC_OFF = 154624;
struct Ctx { LAS unsigned char* lds; int tid, lane, wave, wg, G; };

struct P0Item { const float* src; bf16* dst; int N, ldk, sc; };
__device__ __forceinline__ P0Item p0_decode(const Args& a, unsigned char* ws, int it, int lane) {
    constexpr int I_IN = (D_ / 64) * (NIN / 32), I_QI = (QR / 64) * (2048 / 32), I_PA = (AW / 64) * (D_ / 32), I_OUT = (D_ / 64) * (D_ / 32);
    const int c4 = lane & 7; P0Item d; int r = it;
    if (r < I_IN) { const int kb = r / (NIN / 32), nb = r % (NIN / 32), np = 32 * nb + 4 * c4;
        d.src = a.w_in + (size_t)(64 * kb) * IN_W; d.N = IN_W; d.sc = np < 5008 ? np : (np < 5120 ? -1 : np - 112); d.dst = (bf16*)(ws + WS_WIN) + (size_t)(32 * nb) * D_ + 64 * kb; d.ldk = D_; return d; } r -= I_IN;
    if (r < I_QI) { const int kb = r / 64, nb = r % 64; d.src = a.w_qidx + (size_t)(64 * kb) * 2048; d.N = 2048; d.sc = 32 * nb + 4 * c4; d.dst = (bf16*)(ws + WS_WQ) + (size_t)(2048 + 32 * nb) * QR + 64 * kb; d.ldk = QR; return d; } r -= I_QI;
    if (r < 2 * I_PA) { const bool pb = r >= I_PA; if (pb) r -= I_PA; const int kb = r / 64, nb = r % 64;
        d.src = (pb ? a.w_pb : a.w_pa) + (size_t)(64 * kb) * D_; d.N = D_; d.sc = 32 * nb + 4 * c4; d.dst = (bf16*)(ws + (pb ? WS_WPB : WS_WPA)) + (size_t)(32 * nb) * AW + 64 * kb; d.ldk = AW; return d; } r -= 2 * I_PA;
    if (r < I_OUT) { const int kb = r / 64, nb = r % 64; d.src = a.w_out + (size_t)(64 * kb) * D_; d.N = D_; d.sc = 32 * nb + 4 * c4; d.dst = (bf16*)(ws + WS_WOUT) + (size_t)(32 * nb) * D_ + 64 * kb; d.ldk = D_; return d; } r -= I_OUT;
    {
        const int kb = r / 32, nb = r % 32, k0 = 64 * kb, hh = k0 >> 8, c0 = k0 & 255, np = 32 * nb + 4 * c4, h = np >> 7, dd = np & 127;
        d.src = a.w_ukv + (size_t)c0 * 2048; d.N = 2048; d.sc = (hh == (h & 1)) ? h * 256 + 128 + dd : -1; d.dst = (bf16*)(ws + WS_WUV) + (size_t)(32 * nb) * 512 + k0; d.ldk = 512; return d; }
}
__device__ __forceinline__ void p0_item_load(const P0Item& d, int lane, f32x4 (&v)[8]) {
    const int kr = lane >> 3;
#pragma unroll
    for (int i = 0; i < 8; ++i) v[i] = d.sc >= 0 ? *(const f32x4*)(d.src + (size_t)(kr + 8 * i) * d.N + d.sc) : (f32x4){0.f, 0.f, 0.f, 0.f};
}
__device__ __forceinline__ void p0_item_put(const P0Item& d, int lane, const f32x4 (&v)[8], LAS float* scr) {
    const int c4 = lane & 7, kr = lane >> 3;
#pragma unroll
    for (int i = 0; i < 8; ++i) { LAS float* p = scr + (kr + 8 * i) * 33 + 4 * c4; p[0] = v[i].x; p[1] = v[i].y; p[2] = v[i].z; p[3] = v[i].w; }
    LDS_WAIT(); asm volatile("" ::: "memory");
    const int c = lane & 7;
#pragma unroll
    for (int j = 0; j < 4; ++j) { const int n = (lane >> 3) + 8 * j; const LAS float* sp = scr + (8 * c) * 33 + n;
        u32x4 o; o.x = pk2(sp[0 * 33], sp[1 * 33]); o.y = pk2(sp[2 * 33], sp[3 * 33]); o.z = pk2(sp[4 * 33], sp[5 * 33]); o.w = pk2(sp[6 * 33], sp[7 * 33]);
        *(u32x4*)(d.dst + (size_t)n * d.ldk + 8 * c) = o; }
    LDS_WAIT(); asm volatile("" ::: "memory");
}
__device__ __forceinline__ void p0_prep(const Ctx& C, const Args& a) {
    unsigned char* ws = a.ws;
    LAS float* scr = (LAS float*)(C.lds + C.wave * 16384);
    const int gw = C.wg * NWAVES + C.wave, NGW = C.G * NWAVES;
    constexpr int NITEMS = (D_ / 64) * (NIN / 32) + (QR / 64) * (2048 / 32) + 2 * (AW / 64) * (D_ / 32) + (D_ / 64) * (D_ / 32) + (512 / 64) * (1024 / 32);
    {
        f32x4 va[8], vb[8]; int it = gw;
        P0Item da, db;
        if (it < NITEMS) { da = p0_decode(a, ws, it, C.lane); p0_item_load(da, C.lane, va); }
        while (it < NITEMS) {
            const int i1 = it + NGW; if (i1 < NITEMS) { db = p0_decode(a, ws, i1, C.lane); p0_item_load(db, C.lane, vb); }
            p0_item_put(da, C.lane, va, scr);
            if (i1 >= NITEMS) break;
            const int i2 = i1 + NGW; if (i2 < NITEMS) { da = p0_decode(a, ws, i2, C.lane); p0_item_load(da, C.lane, va); }
            p0_item_put(db, C.lane, vb, scr);
            it = i2;
        }
    }
    for (int m = gw; m < S_; m += NGW) {
        const f32x4* xr = (const f32x4*)(a.x + (size_t)m * D_) + C.lane; const f32x4* wr = (const f32x4*)a.norm_w + C.lane;
        f32x4 v[8]; float s = 0.f;
#pragma unroll
        for (int j = 0; j < 8; ++j) { v[j] = xr[64 * j]; s += (v[j].x * v[j].x + v[j].y * v[j].y) + (v[j].z * v[j].z + v[j].w * v[j].w); }
        const float rs = rsqrtf(wave_sum(s) * (1.f / D_) + EPS);
        u32x2* o8 = (u32x2*)((bf16*)(ws + WS_H) + (size_t)m * D_) + C.lane;
#pragma unroll
        for (int j = 0; j < 8; ++j) { const f32x4 w = wr[64 * j]; u32x2 o; o.x = pk2(v[j].x * rs * w.x, v[j].y * rs * w.y); o.y = pk2(v[j].z * rs * w.z, v[j].w * rs * w.w); o8[64 * j] = o; }
    }
    { const int g = C.wg * NTHR + C.tid; if (g < AW) { const float l0 = a.lb_table[g], l1 = a.lb_table[AW + g], mx = fmaxf(l0, l1), e0 = __expf(l0 - mx), e1 = __expf(l1 - mx); ((float*)(ws + WS_LB))[g] = e0 / (e0 + e1); } }
    __syncthreads();
    {
        LAS float* As = (LAS float*)C.lds;
        LAS float* Bs = As + 64 * 129;
        bf16* WqT = (bf16*)(ws + WS_WQ);
        for (int it = C.wg; it < 256; it += C.G) {
            const int h = it >> 5, cb = (it >> 3) & 3, rb = it & 7, c0 = cb * 64, r0 = rb * 64;
            { const int rr = C.tid >> 3, seg = C.tid & 7;
#pragma unroll
              for (int j = 0; j < 4; ++j) { const f32x4 va = *(const f32x4*)(a.w_uq + (size_t)(r0 + rr) * 1024 + h * 128 + seg * 16 + 4 * j); const f32x4 vb = *(const f32x4*)(a.w_ukv + (size_t)(c0 + rr) * 2048 + h * 256 + seg * 16 + 4 * j);
                  LAS float* pa = As + rr * 129 + seg * 16 + 4 * j; pa[0] = va.x; pa[1] = va.y; pa[2] = va.z; pa[3] = va.w;
                  LAS float* pb = Bs + rr * 129 + seg * 16 + 4 * j; pb[0] = vb.x; pb[1] = vb.y; pb[2] = vb.z; pb[3] = vb.w; } }
            __syncthreads();
            { const int r = C.tid & 63, cg = C.tid >> 6; float o[8];
#pragma unroll
              for (int i = 0; i < 8; ++i) o[i] = 0.f;
              for (int d = 0; d < 128; ++d) { const float av = As[r * 129 + d];
#pragma unroll
                  for (int i = 0; i < 8; ++i) o[i] += av * Bs[(cg * 8 + i) * 129 + d]; }
#pragma unroll
              for (int i = 0; i < 8; ++i) WqT[(size_t)(h * 256 + c0 + cg * 8 + i) * QR + r0 + r] = (bf16)f2bf(o[i] * 0.08838834764831845f); }
            __syncthreads();
        }
    }
}

struct SchedPlain {
    pg8::TileOrder T; const char* Ab; const char* Bb; size_t tA, tB;
    __device__ __forceinline__ bool next(int i, pg8::Unit& u) const { u.sub = 0; return T.tile(i, u.pm, u.pn); }
    __device__ __forceinline__ const char* A(const pg8::Unit& u) const { return Ab + (size_t)u.pm * tA; }
    __device__ __forceinline__ const char* B(const pg8::Unit& u) const { return Bb + (size_t)u.pn * tB; }
    __device__ __forceinline__ bool keep(const pg8::Unit&) const { return false; }
};
#define EPI_FOREACH(...) \
    _Pragma("unroll") for (int ai = 0; ai < 2; ++ai) _Pragma("unroll") for (int m = 0; m < 4; ++m) { const int row = u.pm * 256 + ai * 128 + wr * 64 + m * 16 + fr; \
    _Pragma("unroll") for (int bj = 0; bj < 2; ++bj) { const int col = u.pn * 256 + bj * 128 + wc * 32 + 8 * fq; f32x4& v0 = acc[ai][bj][m][0]; f32x4& v1 = acc[ai][bj][m][1]; __VA_ARGS__ } }

struct EpiProj {
    unsigned char* ws;
    __device__ __forceinline__ void operator()(f32x4 (&acc)[2][2][4][2], const pg8::Unit& u, int wr, int wc, int fr, int fq) const {
        const int pn = u.pn;
        if (pn < 4) {
            bf16* O = (bf16*)(ws + WS_QA);
            EPI_FOREACH({ u32x4 w; const float s = 0.08838834764831845f; w.x = pk2(siluf_(v0[0]) * s, siluf_(v0[1]) * s); w.y = pk2(siluf_(v0[2]) * s, siluf_(v0[3]) * s); w.z = pk2(siluf_(v1[0]) * s, siluf_(v1[1]) * s); w.w = pk2(siluf_(v1[2]) * s, siluf_(v1[3]) * s);
                *(u32x4*)(O + (size_t)row * AW + col) = w; })
        } else if (pn < 8) {
            float* O = (float*)(ws + WS_G); const float* lb = (const float*)(ws + WS_LB);
            EPI_FOREACH({ const int c = col - 1024; const f32x4 l0 = *(const f32x4*)(lb + c), l1 = *(const f32x4*)(lb + c + 4); f32x4 o0, o1;
                _Pragma("unroll") for (int j = 0; j < 4; ++j) { o0[j] = __logf(l0[j] + (1.f - l0[j]) * sigmoidf_(v0[j])); o1[j] = __logf(l1[j] + (1.f - l1[j]) * sigmoidf_(v1[j])); }
                *(f32x4*)(O + (size_t)row * AW + c) = o0; *(f32x4*)(O + (size_t)row * AW + c + 4) = o1; })
        } else if (pn < 12) {
            bf16* O = (bf16*)(ws + WS_VA);
            EPI_FOREACH({ u32x4 w; w.x = pk2(v0[0], v0[1]); w.y = pk2(v0[2], v0[3]); w.z = pk2(v1[0], v1[1]); w.w = pk2(v1[2], v1[3]); *(u32x4*)(O + (size_t)row * AW + col - 2048) = w; })
        } else if (pn < 16 || (pn >= 20 && pn < 24)) {
            bf16* O = (bf16*)(ws + (pn < 16 ? WS_GA : WS_GB)); const int cb = pn < 16 ? 3072 : 5120;
            EPI_FOREACH({ u32x4 w; w.x = pk2(siluf_(v0[0]), siluf_(v0[1])); w.y = pk2(siluf_(v0[2]), siluf_(v0[3])); w.z = pk2(siluf_(v1[0]), siluf_(v1[1])); w.w = pk2(siluf_(v1[2]), siluf_(v1[3]));
                *(u32x4*)(O + (size_t)row * AW + col - cb) = w; })
        } else if (pn < 20) {
            float* O = (float*)(ws + WS_RAW);
            EPI_FOREACH({ *(f32x4*)(O + (size_t)row * 1024 + col - 4096) = v0; *(f32x4*)(O + (size_t)row * 1024 + col - 4096 + 4) = v1; })
        } else {
            bf16* O = (bf16*)(ws + (pn < 32 ? WS_SA : WS_SB)); const int cb = pn < 32 ? 6144 : 8192;
            EPI_FOREACH({ u32x4 w; w.x = pk2(sigmoidf_(v0[0]), sigmoidf_(v0[1])); w.y = pk2(sigmoidf_(v0[2]), sigmoidf_(v0[3])); w.z = pk2(sigmoidf_(v1[0]), sigmoidf_(v1[1])); w.w = pk2(sigmoidf_(v1[2]), sigmoidf_(v1[3]));
                *(u32x4*)(O + (size_t)row * D_ + col - cb) = w; })
        }
    }
};

__device__ __forceinline__ void p2_norms(const Ctx& C, const Args& a) {
    unsigned char* ws = a.ws;
    const int gw = C.wg * NWAVES + C.wave, NGW = C.G * NWAVES, lane = C.lane;
    const float* RAW = (const float*)(ws + WS_RAW);
    for (int t = gw; t < S_; t += NGW) {
        const float* r = RAW + (size_t)t * 1024;
        { const f32x4 v0 = *(const f32x4*)(r + 4 * lane), v1 = *(const f32x4*)(r + 256 + 4 * lane);
          const float ss = wave_sum((v0.x * v0.x + v0.y * v0.y) + (v0.z * v0.z + v0.w * v0.w) + (v1.x * v1.x + v1.y * v1.y) + (v1.z * v1.z + v1.w * v1.w));
          const float rs = rsqrtf(ss * (1.f / QR) + EPS);
          const f32x4 w0 = *(const f32x4*)(a.q_norm_w + 4 * lane), w1 = *(const f32x4*)(a.q_norm_w + 256 + 4 * lane);
          bf16* o = (bf16*)(ws + WS_CQN) + (size_t)t * QR;
          u32x2 p0, p1; p0.x = pk2(v0.x * rs * w0.x, v0.y * rs * w0.y); p0.y = pk2(v0.z * rs * w0.z, v0.w * rs * w0.w); p1.x = pk2(v1.x * rs * w1.x, v1.y * rs * w1.y); p1.y = pk2(v1.z * rs * w1.z, v1.w * rs * w1.w);
          *(u32x2*)(o + 4 * lane) = p0; *(u32x2*)(o + 256 + 4 * lane) = p1; }
        { const f32x4 v0 = *(const f32x4*)(r + 512 + 4 * lane);
          const float ss = wave_sum((v0.x * v0.x + v0.y * v0.y) + (v0.z * v0.z + v0.w * v0.w));
          const float rs = rsqrtf(ss * (1.f / KVR) + EPS);
          const f32x4 w0 = *(const f32x4*)(a.kv_norm_w + 4 * lane);
          u32x2 p0; p0.x = pk2(v0.x * rs * w0.x, v0.y * rs * w0.y); p0.y = pk2(v0.z * rs * w0.z, v0.w * rs * w0.w);
          *(u32x2*)((bf16*)(ws + WS_CKVN) + (size_t)t * KVR + 4 * lane) = p0; }
        { const f32x2 v = *(const f32x2*)(r + 768 + 2 * lane);
          const float mu = wave_sum(v.x + v.y) * (1.f / IDXD); const float d0 = v.x - mu, d1 = v.y - mu;
          const float var = wave_sum(d0 * d0 + d1 * d1) * (1.f / IDXD); const float rs = rsqrtf(var + EPS);
          const f32x2 w = *(const f32x2*)(a.kidx_norm_w + 2 * lane), b = *(const f32x2*)(a.kidx_norm_b + 2 * lane);
          *(unsigned*)((bf16*)(ws + WS_KIDX) + (size_t)t * IDXD + 2 * lane) = pk2(d0 * rs * w.x + b.x, d1 * rs * w.y + b.y); }
        if (lane < IDXH) ((float*)(ws + WS_WIDX))[(size_t)t * IDXH + lane] = r[896 + lane] * 0.02209708691207961f;
    }
}
constexpr int R64 = 144, R128 = 272;
__device__ __forceinline__ void p2_hgrn_states(const Ctx& C, const Args& a, float* UT) {
    unsigned char* ws = a.ws;
    const float* G = (const float*)(ws + WS_G); const bf16* VA = (const bf16*)(ws + WS_VA); float* DL = (float*)(ws + WS_DLAST);
    LAS unsigned char* kdT = C.lds;
    LAS unsigned char* vT = C.lds + 128 * R64;
    LAS float* segtot = (LAS float*)(C.lds + 2 * 128 * R64);
    const int tid = C.tid, lane = C.lane, w = C.wave;
    for (int it = C.wg; it < NCH * BH; it += C.G) {
        const int c = it >> 3, h = it & 7;
        const int k = tid & 127, seg = tid >> 7, t0 = c * CHUNK + seg * 16;
        float g[16], cum[16]; float run = 0.f;
#pragma unroll
        for (int i = 0; i < 16; ++i) { g[i] = G[(size_t)(t0 + i) * AW + h * 128 + k]; run += g[i]; cum[i] = run; }
        segtot[seg * 128 + k] = run;
        unsigned short vv[16];
#pragma unroll
        for (int i = 0; i < 16; ++i) vv[i] = VA[(size_t)(t0 + i) * AW + h * 128 + k];
        __syncthreads();
        float pre = 0.f, last = 0.f;
#pragma unroll
        for (int s2 = 0; s2 < 4; ++s2) { const float st = segtot[s2 * 128 + k]; if (s2 < seg) pre += st; last += st; }
        unsigned kd[8], vp[8];
#pragma unroll
        for (int i = 0; i < 8; ++i) {
            const float c0 = cum[2 * i] + pre, c1 = cum[2 * i + 1] + pre;
            const float k0 = -expm1f(g[2 * i]) * __expf(last - c0), k1 = -expm1f(g[2 * i + 1]) * __expf(last - c1);
            kd[i] = pk2(k0, k1); vp[i] = (unsigned)vv[2 * i] | ((unsigned)vv[2 * i + 1] << 16);
        }
        *(LAS u32x4*)(kdT + k * R64 + seg * 32) = (u32x4){kd[0], kd[1], kd[2], kd[3]}; *(LAS u32x4*)(kdT + k * R64 + seg * 32 + 16) = (u32x4){kd[4], kd[5], kd[6], kd[7]};
        *(LAS u32x4*)(vT + k * R64 + seg * 32) = (u32x4){vp[0], vp[1], vp[2], vp[3]}; *(LAS u32x4*)(vT + k * R64 + seg * 32 + 16) = (u32x4){vp[4], vp[5], vp[6], vp[7]};
        if (seg == 0) DL[(size_t)it * 128 + k] = __expf(last);
        __syncthreads();
        f32x4 acc[2][4];
#pragma unroll
        for (int mi = 0; mi < 2; ++mi)
#pragma unroll
            for (int ni = 0; ni < 4; ++ni) acc[mi][ni] = (f32x4){0.f, 0.f, 0.f, 0.f};
        const int fr = lane & 15, fq = lane >> 4;
#pragma unroll
        for (int ks = 0; ks < 2; ++ks) {
            bf16x8 af[2], bfr[4];
#pragma unroll
            for (int mi = 0; mi < 2; ++mi) af[mi] = *(const LAS bf16x8*)(vT + (32 * (w >> 1) + 16 * mi + fr) * R64 + (32 * ks + 8 * fq) * 2);
#pragma unroll
            for (int ni = 0; ni < 4; ++ni) bfr[ni] = *(const LAS bf16x8*)(kdT + (64 * (w & 1) + 16 * ni + fr) * R64 + (32 * ks + 8 * fq) * 2);
#pragma unroll
            for (int mi = 0; mi < 2; ++mi)
#pragma unroll
                for (int ni = 0; ni < 4; ++ni) acc[mi][ni] = __builtin_amdgcn_mfma_f32_16x16x32_bf16(af[mi], bfr[ni], acc[mi][ni], 0, 0, 0);
        }
        float* U = UT + (size_t)it * 16384;
#pragma unroll
        for (int mi = 0; mi < 2; ++mi)
#pragma unroll
            for (int ni = 0; ni < 4; ++ni)
#pragma unroll
                for (int r = 0; r < 4; ++r) U[(32 * (w >> 1) + 16 * mi + 4 * fq + r) * 128 + 64 * (w & 1) + 16 * ni + fr] = acc[mi][ni][r];
        __syncthreads();
    }
}

struct EpiQ {
    unsigned char* ws;
    __device__ __forceinline__ void operator()(f32x4 (&acc)[2][2][4][2], const pg8::Unit& u, int wr, int wc, int fr, int fq) const {
        bf16* O = (bf16*)(ws + (u.pn < 8 ? WS_QABS : WS_RAW)); const int cb = u.pn < 8 ? 0 : 2048;
        EPI_FOREACH({ u32x4 w; w.x = pk2(v0[0], v0[1]); w.y = pk2(v0[2], v0[3]); w.z = pk2(v1[0], v1[1]); w.w = pk2(v1[2], v1[3]); *(u32x4*)(O + (size_t)row * 2048 + col - cb) = w; })
    }
};
__device__ __forceinline__ void p3_scan(const Ctx& C, const Args& a, const float* UT) {
    unsigned char* ws = a.ws;
    const float* DL = (const float*)(ws + WS_DLAST); bf16* SPT = (bf16*)(ws + WS_SPT);
    for (int e = C.wg * NTHR + C.tid; e < BH * 128 * 128; e += C.G * NTHR) {
        const int h = e >> 14, k = e & 127;
        float Sv = 0.f;
        for (int c0 = 0; c0 < NCH; c0 += 16) {
            float u[16], d[16];
#pragma unroll
            for (int j = 0; j < 16; ++j) { u[j] = UT[(size_t)(c0 + j) * (BH * 16384) + e]; d[j] = DL[(size_t)((c0 + j) * BH + h) * 128 + k]; }
#pragma unroll
            for (int j = 0; j < 16; ++j) { SPT[(size_t)(c0 + j) * (BH * 16384) + e] = (bf16)f2bf(Sv); Sv = d[j] * Sv + u[j]; }
        }
    }
}

__device__ __forceinline__ int t5_bucket(int rel) {
    const int n = rel < 0 ? -rel : rel; int b = rel > 0 ? 16 : 0;
    const int large = n < 12 ? 8 : n < 16 ? 9 : n < 23 ? 10 : n < 32 ? 11 : n < 46 ? 12 : n < 64 ? 13 : n < 91 ? 14 : 15;
    return b + (n < 8 ? n : large);
}
__device__ __forceinline__ int swz_sigma(int r) { return ((r & 3) << 1) | ((((r >> 3) ^ (r >> 2)) & 1) << 3) | ((r >> 2) & 1); }
__device__ __forceinline__ int lat_off(int row, int c) { return row * 512 + ((((c & 15) ^ swz_sigma(row & 15)) | (c & 16)) << 4); }
constexpr int AT_SIDX = 131072, AT_BIAS = 139264;
__device__ __forceinline__ void attn_setup(const Ctx& C, const Args& a) {
    LAS float* bias2 = (LAS float*)(C.lds + AT_BIAS);
    for (int e = C.tid; e < 2 * 92 * 8; e += NTHR) { const int sg = e / (92 * 8), nn = (e / 8) % 92, h = e & 7; bias2[e] = a.rel_bias[t5_bucket(sg ? nn : -nn) * BH + h]; }
    __syncthreads();
}
__device__ __forceinline__ void attn_one(const Ctx& C, const Args& a, const int t, const int n) {
    unsigned char* ws = a.ws;
    const bf16* QABS = (const bf16*)(ws + WS_QABS); const char* CKVNb = (const char*)(ws + WS_CKVN);
    bf16* OL = (bf16*)(ws + WS_RAW);
    const int lane = C.lane, w = C.wave, fr = lane & 15, fq = lane >> 4;
    LAS unsigned char* L = C.lds + w * 16384;
    const LAS int* sidx = (const LAS int*)(C.lds + AT_SIDX) + w * 256;
    const LAS float* bias2 = (const LAS float*)(C.lds + AT_BIAS);
    const int q4 = fr >> 2, p4 = fr & 3;
    unsigned aqk[4], apv[8];
    { const int s = swz_sigma(fr); const unsigned b0 = (unsigned)(fr * 512 + 16 * (fq ^ (s & 3))) | (unsigned)(64 * (s >> 2));
#pragma unroll
      for (int k = 0; k < 4; ++k) aqk[k] = (unsigned)(size_t)L + (b0 ^ (unsigned)(64 * k)); }
    { const int rr = 4 * fq + q4, s = swz_sigma(rr & 15); const unsigned b0 = (unsigned)(rr * 512 + 16 * ((p4 >> 1) ^ (s & 1)) + 8 * (p4 & 1)) | (unsigned)(32 * (s >> 1));
#pragma unroll
      for (int k = 0; k < 8; ++k) apv[k] = (unsigned)(size_t)L + (b0 ^ (unsigned)(32 * k)); }
    unsigned c16[16];
#pragma unroll
    for (int i = 0; i < 16; ++i) { const int row = 2 * i + (lane >> 5), pos = lane & 31; c16[i] = (unsigned)(((pos & 16) | ((pos & 15) ^ swz_sigma(row & 15))) << 4); }
    {
        bf16x8 qf[8];
#pragma unroll
        for (int ks = 0; ks < 8; ++ks) { if (fr < BH) qf[ks] = *(const bf16x8*)(QABS + (size_t)t * 2048 + fr * 256 + 32 * ks + 8 * fq); else qf[ks] = (bf16x8){0, 0, 0, 0, 0, 0, 0, 0}; }
        f32x4 oa[16];
#pragma unroll
        for (int i = 0; i < 16; ++i) oa[i] = (f32x4){0.f, 0.f, 0.f, 0.f};
        float m_run = -INFINITY, l_run = 0.f;
        LDS_WAIT();
        for (int ch = 0; ch * 32 < n; ++ch) {
#pragma unroll
            for (int i = 0; i < 16; ++i) { const int sj = sidx[32 * ch + 2 * i + (lane >> 5)];
                __builtin_amdgcn_global_load_lds((const unsigned*)(CKVNb + (unsigned)(sj * 512 + (int)c16[i])), (LAS unsigned*)(L + i * 1024), 16, 0, 0); }
            const u32x4 s0 = *(const LAS u32x4*)(sidx + 32 * ch + 4 * fq), s1 = *(const LAS u32x4*)(sidx + 32 * ch + 16 + 4 * fq);
            float bv[2][4];
#pragma unroll
            for (int T = 0; T < 2; ++T)
#pragma unroll
                for (int r = 0; r < 4; ++r) { const int rel = (int)(T ? s1[r] : s0[r]) - t; const int nn = rel < 0 ? -rel : rel; bv[T][r] = bias2[((rel > 0 ? 92 : 0) + (nn < 91 ? nn : 91)) * 8 + (fr & 7)]; }
            VM_WAIT();
            f32x4 lg[2] = {{0.f, 0.f, 0.f, 0.f}, {0.f, 0.f, 0.f, 0.f}};
#pragma unroll
            for (int ks = 0; ks < 8; ++ks)
#pragma unroll
                for (int T = 0; T < 2; ++T) { const bf16x8 kf = *(const LAS bf16x8*)(size_t)(aqk[ks & 3] + 256 * (ks >> 2) + 8192 * T);
                    lg[T] = __builtin_amdgcn_mfma_f32_16x16x32_bf16(kf, qf[ks], lg[T], 0, 0, 0); }
            float mx = -INFINITY;
#pragma unroll
            for (int T = 0; T < 2; ++T)
#pragma unroll
                for (int r = 0; r < 4; ++r) { const int j = 32 * ch + 16 * T + 4 * fq + r; float v = lg[T][r] + bv[T][r];
                    v = (j < n) ? v : -INFINITY; lg[T][r] = v; mx = fmaxf(mx, v); }
            mx = fmaxf(mx, __shfl_xor(mx, 16)); mx = fmaxf(mx, __shfl_xor(mx, 32));
            const float m_new = fmaxf(m_run, mx), scale = __expf(m_run - m_new);
            float sm = 0.f;
#pragma unroll
            for (int T = 0; T < 2; ++T)
#pragma unroll
                for (int r = 0; r < 4; ++r) { const float p = __expf(lg[T][r] - m_new); lg[T][r] = p; sm += p; }
            sm += __shfl_xor(sm, 16); sm += __shfl_xor(sm, 32);
            l_run = l_run * scale + sm; m_run = m_new;
            bf16x8 pf; { const unsigned w0 = pk2(lg[0][0], lg[0][1]), w1 = pk2(lg[0][2], lg[0][3]), w2 = pk2(lg[1][0], lg[1][1]), w3 = pk2(lg[1][2], lg[1][3]);
                pf = __builtin_bit_cast(bf16x8, (u32x4){w0, w1, w2, w3}); }
            if (__any(scale != 1.f)) {
#pragma unroll
                for (int ct = 0; ct < 16; ++ct) oa[ct] *= scale; }
#pragma unroll
            for (int ct = 0; ct < 16; ++ct) {
                const s16x4 lo = __builtin_bit_cast(s16x4, __builtin_amdgcn_ds_read_tr16_b64_v4i16((LAS s16x4*)(size_t)(apv[ct & 7] + 256 * (ct >> 3))));
                const s16x4 hi = __builtin_bit_cast(s16x4, __builtin_amdgcn_ds_read_tr16_b64_v4i16((LAS s16x4*)(size_t)(apv[ct & 7] + 256 * (ct >> 3) + 8192)));
                const bf16x8 cf = {lo[0], lo[1], lo[2], lo[3], hi[0], hi[1], hi[2], hi[3]};
                oa[ct] = __builtin_amdgcn_mfma_f32_16x16x32_bf16(cf, pf, oa[ct], 0, 0, 0);
            }
            LDS_WAIT();
        }
        if (fr < BH) { const float inv = __builtin_amdgcn_rcpf(l_run); bf16* o = OL + (size_t)t * 2048 + fr * 256 + 4 * fq;
#pragma unroll
            for (int ct = 0; ct < 16; ++ct) { u32x2 pw; pw.x = pk2(oa[ct][0] * inv, oa[ct][1] * inv); pw.y = pk2(oa[ct][2] * inv, oa[ct][3] * inv); *(u32x2*)(o + 16 * ct) = pw; } }
    }
}

__device__ __forceinline__ unsigned fkey(float f) { const unsigned u = __builtin_bit_cast(unsigned, f); return (u & 0x80000000u) ? ~u : (u | 0x80000000u); }
__device__ __forceinline__ void lds_add_u32(LAS unsigned* p, unsigned v) { asm volatile("ds_add_u32 %0, %1" :: "v"((unsigned)(size_t)p), "v"(v) : "memory"); }
constexpr int IX_KBUF = 65536, IX_CAP = 512;
__device__ __noinline__ void select_slow(const float* sc, int nvis, LAS int* idxrow, LAS unsigned* hist, int lane) {
    unsigned prefix = 0u; int need = TOPK;
#pragma unroll 1
    for (int pass = 0; pass < 4; ++pass) {
        const int shift = 24 - 8 * pass;
#pragma unroll
        for (int j = 0; j < 4; ++j) hist[lane * 4 + j] = 0u;
        LDS_WAIT();
        const unsigned himask = pass == 0 ? 0u : (0xffffffffu << (shift + 8));
        for (int i = lane; i < nvis; i += 64) { const unsigned kk = fkey(sc[i]); if ((kk & himask) == (prefix & himask)) __hip_atomic_fetch_add(&hist[(kk >> shift) & 255u], 1u, __ATOMIC_RELAXED, __HIP_MEMORY_SCOPE_WORKGROUP); }
        LDS_WAIT();
        unsigned cnt[4]; unsigned tl = 0u;
#pragma unroll
        for (int j = 0; j < 4; ++j) { cnt[j] = hist[lane * 4 + j]; tl += cnt[j]; }
        unsigned incl = tl;
#pragma unroll
        for (int o = 1; o < 64; o <<= 1) { const unsigned v = __shfl_down(incl, o); if (lane + o < 64) incl += v; }
        unsigned above = incl - tl;
        int dsel = -1; unsigned asel = 0u;
#pragma unroll
        for (int j = 3; j >= 0; --j) { if (dsel < 0 && above < (unsigned)need && above + cnt[j] >= (unsigned)need) { dsel = lane * 4 + j; asel = above; } above += cnt[j]; }
        const unsigned long long bal = __ballot(dsel >= 0);
        const int src = __ffsll((long long)bal) - 1;
        const int d = __shfl(dsel, src); const unsigned ab = __shfl(asel, src);
        need -= (int)ab; prefix |= ((unsigned)d) << shift;
    }
    int base = 0, eqseen = 0;
    for (int i0 = 0; i0 < nvis; i0 += 64) {
        const int i = i0 + lane; const unsigned kk = fkey(sc[i]);
        const bool gt = kk > prefix, eq = kk == prefix;
        const unsigned long long beq = __ballot(eq);
        const unsigned long long lt_mask = (1ull << lane) - 1ull;
        const int eqrank = eqseen + __popcll(beq & lt_mask);
        const bool sel = gt || (eq && eqrank < need);
        const unsigned long long bs = __ballot(sel);
        if (sel) idxrow[base + __popcll(bs & lt_mask)] = i;
        base += __popcll(bs); eqseen += __popcll(beq);
    }
}
__device__ __forceinline__ void p4_indexer(const Ctx& C, const Args& a, float* SCall) {
    unsigned char* ws = a.ws;
    const bf16* QIDX = (const bf16*)(ws + WS_RAW); const char* KIDXb = (const char*)(ws + WS_KIDX); const float* WIDX = (const float*)(ws + WS_WIDX);
    LAS int* sidx = (LAS int*)(C.lds + AT_SIDX) + C.wave * 256;
    float* SC = SCall + (size_t)C.wg * (8 * 8192);
    LAS unsigned* HIST = (LAS unsigned*)C.lds;
    LAS unsigned char* KBUF = C.lds + IX_KBUF;
    const int tid = C.tid, lane = C.lane, w = C.wave, quad = w & 1, kg = w >> 1, r16 = lane & 15, kq = lane >> 4;
    for (int ti = C.wg; ti < 1024; ti += C.G) {
        const int tile = (ti < 256) ? ti : (ti < 512) ? 767 - ti : (ti < 768) ? ti : 1791 - ti;
        const int q0 = tile * 8, nvis = ((q0 >> 6) + 1) * CHUNK;
        if (nvis <= TOPK) {
            for (int j = lane; j < TOPK; j += 64) sidx[j] = j < nvis ? j : 0;
            LDS_WAIT(); __syncthreads();
            attn_one(C, a, q0 + w, nvis);
            LDS_WAIT(); __syncthreads();
            continue;
        }
        for (int i = tid; i < 8 * 2048; i += NTHR) HIST[i] = 0u;
        bf16x8 af[4][4];
#pragma unroll
        for (int j = 0; j < 4; ++j) {
            const bf16* qp = QIDX + (size_t)(q0 + 4 * quad + j) * 2048 + r16 * 128 + 8 * kq;
#pragma unroll
            for (int ks = 0; ks < 4; ++ks) af[j][ks] = *(const bf16x8*)(qp + 32 * ks);
        }
        u32x4 wA[2][2];
        { const int grp = r16 >> 2, mem = r16 & 3;
          const f32x4 wv = mem < 2 ? *(const f32x4*)(WIDX + (size_t)(q0 + 4 * quad + 2 * (grp & 1) + mem) * IDXH + 4 * kq) : (f32x4){0.f, 0.f, 0.f, 0.f};
          const unsigned w01 = pk2(wv[0], wv[1]), w23 = pk2(wv[2], wv[3]);
#pragma unroll
          for (int p = 0; p < 2; ++p)
#pragma unroll
              for (int T = 0; T < 2; ++T) { const bool on = (grp == 2 * T + p) && mem < 2;
                  wA[p][T] = (u32x4){(on && mem == 0) ? w01 : 0u, (on && mem == 0) ? w23 : 0u, (on && mem == 1) ? w01 : 0u, (on && mem == 1) ? w23 : 0u}; } }
        const int ntile = nvis >> 5, nstep = (ntile + 3) >> 2;
        const unsigned soffA = (unsigned)((16 * quad + (lane >> 4)) * 256 + (((lane & 15) ^ (lane >> 4)) << 4));
#define IX_STAGE(step_, buf_) do { const int kt_ = 4 * (step_) + kg; if (kt_ < ntile) { const char* sb_ = KIDXb + (size_t)kt_ * 8192; unsigned so_ = soffA; asm volatile("" : "+v"(so_));   \
            _Pragma("unroll") for (int i_ = 0; i_ < 4; ++i_) { \
            __builtin_amdgcn_global_load_lds((const unsigned*)(sb_ + ((so_ ^ (unsigned)(64 * i_)) + (unsigned)(1024 * i_))), (LAS unsigned*)(KBUF + (buf_) * 32768 + kg * 8192 + (4 * quad + i_) * 1024), 16, 0, 0); } } } while (0)
        const unsigned flane = (unsigned)((4 * quad + 2 * (kq & 1)) * 8192 + 16 * (kq >> 1) + r16);
        LAS unsigned* const hlane = HIST + (4 * quad + 2 * (kq & 1)) * 2048;
#define IX_FLUSH(yv, kt_) do { if ((kt_) < ntile) { _Pragma("unroll") for (int j = 0; j < 2; ++j) { float* scb_ = SC + (size_t)((kt_) * 32 + j * 8192); scb_[flane] = yv[j]; \
            const unsigned bin = fkey(yv[j]) >> 20; lds_add_u32(hlane + j * 2048 + (bin >> 1), 1u << (16 * (bin & 1u))); } } } while (0)
        IX_STAGE(0, 0);
        VM_WAIT(); LDS_WAIT(); __builtin_amdgcn_s_barrier();
        float yp[2] = {0.f, 0.f};
        for (int step = 0; step < nstep; ++step) {
            if (step > 0) IX_FLUSH(yp, 4 * (step - 1) + kg);
            if (step + 1 < nstep) IX_STAGE(step + 1, (step + 1) & 1);
            const unsigned tb = (unsigned)(size_t)(KBUF + (step & 1) * 32768 + kg * 8192) + (unsigned)(r16 * 256 + ((kq ^ r16) << 4));
            bf16x8 bfr[2][4];
#pragma unroll
            for (int T = 0; T < 2; ++T)
#pragma unroll
                for (int ks = 0; ks < 4; ++ks) bfr[T][ks] = *(const LAS bf16x8*)(size_t)((tb ^ (unsigned)(64 * ks)) + 4096 * T);
            f32x4 acc[4][2];
#pragma unroll
            for (int j = 0; j < 4; ++j)
#pragma unroll
                for (int T = 0; T < 2; ++T) acc[j][T] = (f32x4){0.f, 0.f, 0.f, 0.f};
#pragma unroll
            for (int ks = 0; ks < 4; ++ks)
#pragma unroll
                for (int j = 0; j < 4; ++j)
#pragma unroll
                    for (int T = 0; T < 2; ++T) acc[j][T] = __builtin_amdgcn_mfma_f32_16x16x32_bf16(af[j][ks], bfr[T][ks], acc[j][T], 0, 0, 0);
            f32x4 y = {0.f, 0.f, 0.f, 0.f};
#pragma unroll
            for (int p = 0; p < 2; ++p)
#pragma unroll
                for (int T = 0; T < 2; ++T) { const f32x4 xa = acc[2 * p][T], xb = acc[2 * p + 1][T];
                    const u32x4 fr4 = {pk2_relu(xa.x, xa.y), pk2_relu(xa.z, xa.w), pk2_relu(xb.x, xb.y), pk2_relu(xb.z, xb.w)};
                    y = __builtin_amdgcn_mfma_f32_16x16x32_bf16(__builtin_bit_cast(bf16x8, wA[p][T]), __builtin_bit_cast(bf16x8, fr4), y, 0, 0, 0); }
            yp[0] = y.x; yp[1] = y.y;
            VM_WAIT(); LDS_WAIT(); __builtin_amdgcn_s_barrier();
        }
        IX_FLUSH(yp, 4 * (nstep - 1) + kg);
        VM_WAIT(); LDS_WAIT();
        __builtin_amdgcn_s_barrier();
#undef IX_STAGE
#undef IX_FLUSH
        for (int rep_q = 0; rep_q < (PROBE_REP == 42 ? 2 : 1); ++rep_q)
        {
            const float* sc = SC + (size_t)w * 8192; LAS int* idxrow = sidx; const unsigned long long lt_mask = (1ull << lane) - 1ull;
            LAS unsigned* hq = HIST + w * 2048;
            unsigned tl = 0u;
#pragma unroll 8
            for (int i = 0; i < 32; ++i) { const unsigned v = hq[lane * 32 + ((i + lane) & 31)]; tl += (v & 0xffffu) + (v >> 16); }
            unsigned incl = tl;
#pragma unroll
            for (int o = 1; o < 64; o <<= 1) { const unsigned v = __shfl_down(incl, o); if (lane + o < 64) incl += v; }
            const unsigned above_l = incl - tl;
            const unsigned long long own = __ballot(above_l < (unsigned)TOPK && above_l + tl >= (unsigned)TOPK);
            const int lo = __ffsll((long long)own) - 1;
            const unsigned above_o = __shfl(above_l, lo);
            const unsigned vw = hq[lo * 32 + (lane >> 1)]; const unsigned cb = (lane & 1) ? (vw >> 16) : (vw & 0xffffu);
            unsigned incl2 = cb;
#pragma unroll
            for (int o = 1; o < 64; o <<= 1) { const unsigned v = __shfl_down(incl2, o); if (lane + o < 64) incl2 += v; }
            const unsigned above_b = above_o + incl2 - cb;
            const unsigned long long ownb = __ballot(above_b < (unsigned)TOPK && above_b + cb >= (unsigned)TOPK);
            const int lb = __ffsll((long long)ownb) - 1;
            const int b1 = lo * 64 + lb; const unsigned ab1 = __shfl(above_b, lb), cn1 = __shfl(cb, lb);
            if (cn1 > (unsigned)IX_CAP) { __builtin_amdgcn_fence(__ATOMIC_ACQUIRE, "agent"); VM_WAIT(); select_slow(sc, nvis, idxrow, hq, lane); }
            else {
                LAS unsigned* cand = (LAS unsigned*)KBUF + w * (2 * IX_CAP);
                const auto scrs = __builtin_amdgcn_make_buffer_rsrc((void*)sc, 0, 8192 * 4, 0x00020000);
                const unsigned klo = (unsigned)b1 << 20, khi = klo + (1u << 20);
                int selbase = 0, cbase = 0;
                for (int i0 = 0; i0 < nvis; i0 += 2048) {
                    f32x4 v[8];
#pragma unroll
                    for (int j = 0; j < 8; ++j) v[j] = __builtin_bit_cast(f32x4, __builtin_amdgcn_raw_buffer_load_b128(scrs, (unsigned)(((i0 + j * 256 + 4 * lane) & 8191) * 4), 0, 16));
#pragma unroll
                    for (int j = 0; j < 8; ++j) { const int e0 = i0 + j * 256 + 4 * lane; const bool valid = e0 < nvis;
#pragma unroll
                        for (int e = 0; e < 4; ++e) { const unsigned kk = fkey(v[j][e]);
                            const bool ge = valid && kk >= klo; const bool sel = ge && (b1 < 4095) && kk >= khi, cd = ge && !sel;
                            const unsigned long long bs = __ballot(sel), bc = __ballot(cd);
                            if (sel) idxrow[selbase + __popcll(bs & lt_mask)] = e0 + e;
                            if (cd) { const int pos = cbase + __popcll(bc & lt_mask); cand[2 * pos] = kk; cand[2 * pos + 1] = (unsigned)(e0 + e); }
                            selbase += __popcll(bs); cbase += __popcll(bc); } }
                }
                LDS_WAIT();
                const int nc = (int)cn1; int need = TOPK - (int)ab1;
                LAS unsigned* h2 = hq;
                unsigned prefix = klo;
#pragma unroll 1
                for (int pass = 0; pass < 3; ++pass) {
                    const int shift = pass == 0 ? 12 : pass == 1 ? 4 : 0; const unsigned dmask = pass == 2 ? 15u : 255u; const unsigned himask = 0xffffffffu << (pass == 0 ? 20 : pass == 1 ? 12 : 4);
#pragma unroll
                    for (int j = 0; j < 4; ++j) h2[lane * 4 + j] = 0u;
                    LDS_WAIT();
                    for (int i = lane; i < nc; i += 64) { const unsigned kk = cand[2 * i]; if ((kk & himask) == (prefix & himask)) __hip_atomic_fetch_add(&h2[(kk >> shift) & dmask], 1u, __ATOMIC_RELAXED, __HIP_MEMORY_SCOPE_WORKGROUP); }
                    LDS_WAIT();
                    unsigned cnt[4]; unsigned tl2 = 0u;
#pragma unroll
                    for (int j = 0; j < 4; ++j) { cnt[j] = h2[lane * 4 + j]; tl2 += cnt[j]; }
                    unsigned inc3 = tl2;
#pragma unroll
                    for (int o = 1; o < 64; o <<= 1) { const unsigned v2 = __shfl_down(inc3, o); if (lane + o < 64) inc3 += v2; }
                    unsigned above = inc3 - tl2; int dsel = -1; unsigned asel = 0u;
#pragma unroll
                    for (int j = 3; j >= 0; --j) { if (dsel < 0 && above < (unsigned)need && above + cnt[j] >= (unsigned)need) { dsel = lane * 4 + j; asel = above; } above += cnt[j]; }
                    const unsigned long long bal = __ballot(dsel >= 0); const int src = __ffsll((long long)bal) - 1;
                    const int d = __shfl(dsel, src); const unsigned ab = __shfl(asel, src);
                    need -= (int)ab; prefix |= ((unsigned)d) << shift;
                }
                int eqseen = 0;
                for (int i0 = 0; i0 < nc; i0 += 64) {
                    const int i = i0 + lane; const bool vi = i < nc; const unsigned kk = vi ? cand[2 * i] : 0u;
                    const bool gt = vi && kk > prefix, eq = vi && kk == prefix;
                    const unsigned long long beq = __ballot(eq);
                    const int eqrank = eqseen + __popcll(beq & lt_mask);
                    const bool sel = gt || (eq && eqrank < need);
                    const unsigned long long bs = __ballot(sel);
                    if (sel) idxrow[selbase + __popcll(bs & lt_mask)] = (int)cand[2 * i + 1];
                    selbase += __popcll(bs); eqseen += __popcll(beq);
                }
            }
        }
        VM_WAIT(); LDS_WAIT(); __syncthreads();
        attn_one(C, a, q0 + w, TOPK);
        LDS_WAIT(); __syncthreads();
    }
}

__device__ __forceinline__ void p4_hgrn_out(const Ctx& C, const Args& a, const bool do_store) {
    unsigned char* ws = a.ws;
    const float* G = (const float*)(ws + WS_G); bf16* QA = (bf16*)(ws + WS_QA); const bf16* VA = (const bf16*)(ws + WS_VA); const bf16* GA = (const bf16*)(ws + WS_GA);
    const bf16* SPT = (const bf16*)(ws + WS_SPT);
    LAS unsigned char* QI = C.lds;
    LAS unsigned char* QM = QI + 64 * R128;
    LAS unsigned char* KM = QM + 64 * R128;
    LAS unsigned char* vT = KM + 64 * R128;
    LAS unsigned char* SCb = vT + 128 * R64;
    LAS float* segtot = (LAS float*)(SCb + 64 * R64);
    LAS float* rsp = segtot + 8 * 128;
    const int tid = C.tid, lane = C.lane, w = C.wave, fr = lane & 15, fq = lane >> 4;
    for (int it = C.wg; it < NCH * BH; it += C.G) {
        const int c = it >> 3, h = it & 7;
        bf16x8 sfr[4][4];
        { const bf16* sp0 = SPT + (size_t)it * 16384 + (size_t)(64 * (w & 1) + fr) * 128 + 8 * fq;
#pragma unroll
          for (int ks = 0; ks < 4; ++ks)
#pragma unroll
              for (int ni = 0; ni < 4; ++ni) sfr[ks][ni] = *(const bf16x8*)(sp0 + (size_t)(16 * ni) * 128 + 32 * ks); }
        unsigned short gav[4][4];
#pragma unroll
        for (int r = 0; r < 4; ++r)
#pragma unroll
            for (int ni = 0; ni < 4; ++ni) gav[r][ni] = GA[(size_t)(c * CHUNK + 16 * (w >> 1) + 4 * fq + r) * AW + h * 128 + 64 * (w & 1) + 16 * ni + fr];
        {
            const int k2 = tid & 63, seg = tid >> 6, t0 = c * CHUNK + seg * 8;
            f32x2 g[8], cum[8]; f32x2 run = {0.f, 0.f};
#pragma unroll
            for (int i = 0; i < 8; ++i) { g[i] = *(const f32x2*)(G + (size_t)(t0 + i) * AW + h * 128 + 2 * k2); run += g[i]; cum[i] = run; }
            unsigned qv[8];
#pragma unroll
            for (int i = 0; i < 8; ++i) qv[i] = *(const unsigned*)(QA + (size_t)(t0 + i) * AW + h * 128 + 2 * k2);
            segtot[seg * 128 + 2 * k2] = run.x; segtot[seg * 128 + 2 * k2 + 1] = run.y;
            { const int v = tid & 127, sg = tid >> 7, tv = c * CHUNK + sg * 16; unsigned vp[8];
#pragma unroll
              for (int i = 0; i < 8; ++i) vp[i] = (unsigned)VA[(size_t)(tv + 2 * i) * AW + h * 128 + v] | ((unsigned)VA[(size_t)(tv + 2 * i + 1) * AW + h * 128 + v] << 16);
              *(LAS u32x4*)(vT + v * R64 + sg * 32) = (u32x4){vp[0], vp[1], vp[2], vp[3]}; *(LAS u32x4*)(vT + v * R64 + sg * 32 + 16) = (u32x4){vp[4], vp[5], vp[6], vp[7]}; }
            __syncthreads();
            f32x2 pre = {0.f, 0.f}, cmid = {0.f, 0.f};
#pragma unroll
            for (int s2 = 0; s2 < 8; ++s2) { const f32x2 st = {segtot[s2 * 128 + 2 * k2], segtot[s2 * 128 + 2 * k2 + 1]}; if (s2 < seg) pre += st; if (s2 < 4) cmid += st; }
#pragma unroll
            for (int i = 0; i < 8; ++i) {
                const f32x2 cm = cum[i] + pre; const float q0 = bflo(qv[i]), q1 = bfhi(qv[i]);
                const int row = seg * 8 + i;
                *(LAS unsigned*)(QI + row * R128 + 4 * k2) = pk2(q0 * __expf(cm.x), q1 * __expf(cm.y));
                *(LAS unsigned*)(QM + row * R128 + 4 * k2) = pk2(q0 * __expf(cm.x - cmid.x), q1 * __expf(cm.y - cmid.y));
                *(LAS unsigned*)(KM + row * R128 + 4 * k2) = pk2(-expm1f(g[i].x) * __expf(cmid.x - cm.x), -expm1f(g[i].y) * __expf(cmid.y - cm.y));
            }
        }
        __syncthreads();
        const int tt = w >> 1;
        {
            f32x4 sa[2] = {{0.f, 0.f, 0.f, 0.f}, {0.f, 0.f, 0.f, 0.f}};
#pragma unroll
            for (int ks = 0; ks < 4; ++ks) {
                const bf16x8 qf = *(const LAS bf16x8*)(QM + (16 * tt + fr) * R128 + (32 * ks + 8 * fq) * 2);
#pragma unroll
                for (int si = 0; si < 2; ++si) { const bf16x8 kf = *(const LAS bf16x8*)(KM + (16 * (2 * (w & 1) + si) + fr) * R128 + (32 * ks + 8 * fq) * 2);
                    sa[si] = __builtin_amdgcn_mfma_f32_16x16x32_bf16(qf, kf, sa[si], 0, 0, 0); }
            }
#pragma unroll
            for (int si = 0; si < 2; ++si)
#pragma unroll
                for (int r = 0; r < 4; ++r) { const int t = 16 * tt + 4 * fq + r, s = 16 * (2 * (w & 1) + si) + fr;
                    *(LAS unsigned short*)(SCb + t * R64 + s * 2) = (unsigned short)f2bf(s <= t ? sa[si][r] : 0.f); }
        }
        __syncthreads();
        f32x4 acc[4];
#pragma unroll
        for (int ni = 0; ni < 4; ++ni) acc[ni] = (f32x4){0.f, 0.f, 0.f, 0.f};
        {
#pragma unroll
            for (int ks = 0; ks < 4; ++ks) {
                const bf16x8 qf = *(const LAS bf16x8*)(QI + (16 * tt + fr) * R128 + (32 * ks + 8 * fq) * 2);
#pragma unroll
                for (int ni = 0; ni < 4; ++ni) acc[ni] = __builtin_amdgcn_mfma_f32_16x16x32_bf16(qf, sfr[ks][ni], acc[ni], 0, 0, 0);
            }
#pragma unroll
            for (int ks = 0; ks < 2; ++ks) {
                const bf16x8 pf = *(const LAS bf16x8*)(SCb + (16 * tt + fr) * R64 + (32 * ks + 8 * fq) * 2);
#pragma unroll
                for (int ni = 0; ni < 4; ++ni) { const bf16x8 vf = *(const LAS bf16x8*)(vT + (64 * (w & 1) + 16 * ni + fr) * R64 + (32 * ks + 8 * fq) * 2);
                    acc[ni] = __builtin_amdgcn_mfma_f32_16x16x32_bf16(pf, vf, acc[ni], 0, 0, 0); }
            }
        }
        float ss[4];
#pragma unroll
        for (int r = 0; r < 4; ++r) { float s = 0.f;
#pragma unroll
            for (int ni = 0; ni < 4; ++ni) s += acc[ni][r] * acc[ni][r];
            s += __shfl_xor(s, 1); s += __shfl_xor(s, 2); s += __shfl_xor(s, 4); s += __shfl_xor(s, 8); ss[r] = s; }
        if (fr == 0) {
#pragma unroll
            for (int r = 0; r < 4; ++r) rsp[(16 * tt + 4 * fq + r) * 2 + (w & 1)] = ss[r]; }
        __syncthreads();
#pragma unroll
        for (int r = 0; r < 4; ++r) {
            const int tl = 16 * tt + 4 * fq + r; const float rstd = rsqrtf((rsp[tl * 2] + rsp[tl * 2 + 1]) * (1.f / 128.f) + EPS);
            const size_t rowoff = (size_t)(c * CHUNK + tl) * AW + h * 128;
#pragma unroll
            for (int ni = 0; ni < 4; ++ni) { const int v = 64 * (w & 1) + 16 * ni + fr;
                const unsigned short yv = (unsigned short)f2bf(acc[ni][r] * rstd * a.gnorm_a[v] * bf2f(gav[r][ni])); if (do_store) QA[rowoff + v] = yv; }
        }
        __syncthreads();
    }
}

struct SchedUV {
    pg8::TileOrder T; const char* Ab; const char* Bb;
    __device__ __forceinline__ bool next(int i, pg8::Unit& u) const { u.sub = 0; return T.tile(i, u.pm, u.pn); }
    __device__ __forceinline__ const char* A(const pg8::Unit& u) const { return Ab + ((size_t)u.pm * 256 * 2048 + (size_t)u.pn * 512) * 2; }
    __device__ __forceinline__ const char* B(const pg8::Unit& u) const { return Bb + (size_t)u.pn * 256 * 512 * 2; }
    __device__ __forceinline__ bool keep(const pg8::Unit&) const { return false; }
};
struct EpiUV {
    unsigned char* ws;
    __device__ __forceinline__ void operator()(f32x4 (&acc)[2][2][4][2], const pg8::Unit& u, int wr, int wc, int fr, int fq) const {
        bf16* O = (bf16*)(ws + WS_GB);
        EPI_FOREACH({ const u32x4 gv = *(const u32x4*)(O + (size_t)row * AW + col); u32x4 w;
            w.x = pk2(v0[0] * bflo(gv.x), v0[1] * bfhi(gv.x)); w.y = pk2(v0[2] * bflo(gv.y), v0[3] * bfhi(gv.y)); w.z = pk2(v1[0] * bflo(gv.z), v1[1] * bfhi(gv.z)); w.w = pk2(v1[2] * bflo(gv.w), v1[3] * bfhi(gv.w));
            *(u32x4*)(O + (size_t)row * AW + col) = w; })
    }
};
struct SchedMerge {
    pg8::TileOrder T; const char* Aa; const char* Ab; const char* Ba; const char* Bb;
    __device__ __forceinline__ bool next(int i, pg8::Unit& u) const { u.sub = i & 1; return T.tile(i >> 1, u.pm, u.pn); }
    __device__ __forceinline__ const char* A(const pg8::Unit& u) const { return (u.sub ? Ab : Aa) + (size_t)u.pm * 256 * AW * 2; }
    __device__ __forceinline__ const char* B(const pg8::Unit& u) const { return (u.sub ? Bb : Ba) + (size_t)u.pn * 256 * AW * 2; }
    __device__ __forceinline__ bool keep(const pg8::Unit& u) const { return u.sub == 0; }
};
struct EpiMerge {
    unsigned char* ws;
    __device__ __forceinline__ void operator()(f32x4 (&acc)[2][2][4][2], const pg8::Unit& u, int wr, int wc, int fr, int fq) const {
        const bf16* SA = (const bf16*)(ws + WS_SA); bf16* SB = (bf16*)(ws + WS_SB);
        if (u.sub == 0) {
            EPI_FOREACH({ const u32x4 av = *(const u32x4*)(SA + (size_t)row * D_ + col); const u32x4 bv = *(const u32x4*)(SB + (size_t)row * D_ + col);
                v0[0] *= bflo(av.x) * __builtin_amdgcn_rcpf(bflo(bv.x)); v0[1] *= bfhi(av.x) * __builtin_amdgcn_rcpf(bfhi(bv.x)); v0[2] *= bflo(av.y) * __builtin_amdgcn_rcpf(bflo(bv.y)); v0[3] *= bfhi(av.y) * __builtin_amdgcn_rcpf(bfhi(bv.y));
                v1[0] *= bflo(av.z) * __builtin_amdgcn_rcpf(bflo(bv.z)); v1[1] *= bfhi(av.z) * __builtin_amdgcn_rcpf(bfhi(bv.z)); v1[2] *= bflo(av.w) * __builtin_amdgcn_rcpf(bflo(bv.w)); v1[3] *= bfhi(av.w) * __builtin_amdgcn_rcpf(bfhi(bv.w)); })
        } else {
            EPI_FOREACH({ const u32x4 bv = *(const u32x4*)(SB + (size_t)row * D_ + col); u32x4 w;
                w.x = pk2(v0[0] * bflo(bv.x), v0[1] * bfhi(bv.x)); w.y = pk2(v0[2] * bflo(bv.y), v0[3] * bfhi(bv.y)); w.z = pk2(v1[0] * bflo(bv.z), v1[1] * bfhi(bv.z)); w.w = pk2(v1[2] * bflo(bv.w), v1[3] * bfhi(bv.w));
                *(u32x4*)(SB + (size_t)row * D_ + col) = w; })
        }
    }
};
struct EpiOut {
    const float* x; bf16* ybf; float* RS;
    __device__ __forceinline__ void operator()(f32x4 (&acc)[2][2][4][2], const pg8::Unit& u, int wr, int wc, int fr, int fq) const {
#pragma unroll
        for (int ai = 0; ai < 2; ++ai)
#pragma unroll
            for (int m = 0; m < 4; ++m) { const int row = u.pm * 256 + ai * 128 + wr * 64 + m * 16 + fr; float ss = 0.f;
#pragma unroll
                for (int bj = 0; bj < 2; ++bj) { const int col = u.pn * 256 + bj * 128 + wc * 32 + 8 * fq; const size_t off = (size_t)row * D_ + col;
                    const f32x4 x0 = *(const f32x4*)(x + off), x1 = *(const f32x4*)(x + off + 4); const f32x4 y0 = x0 + acc[ai][bj][m][0], y1 = x1 + acc[ai][bj][m][1];
                    u32x4 pw; pw.x = pk2(y0[0], y0[1]); pw.y = pk2(y0[2], y0[3]); pw.z = pk2(y1[0], y1[1]); pw.w = pk2(y1[2], y1[3]);
                    *(u32x4*)(ybf + off) = pw;
                    ss += (y0[0] * y0[0] + y0[1] * y0[1]) + (y0[2] * y0[2] + y0[3] * y0[3]) + (y1[0] * y1[0] + y1[1] * y1[1]) + (y1[2] * y1[2] + y1[3] * y1[3]); }
                ss += __shfl_xor(ss, 16); ss += __shfl_xor(ss, 32);
                if (fq == 0) atomicAdd(RS + row, ss); }
    }
};
__device__ __forceinline__ void p9_final_norm(const Ctx& C, const Args& a) {
    const float* RS = (const float*)(a.ws + WS_CTL) + RS_WORD; const bf16* YBF = (const bf16*)(a.ws + WS_G);
    const int gw = C.wg * NWAVES + C.wave, NGW = C.G * NWAVES;
    for (int m = gw; m < S_; m += NGW) {
        const float rs = rsqrtf(RS[m] * (1.f / D_) + EPS);
        const u32x4* yr = (const u32x4*)(YBF + (size_t)m * D_) + C.lane; f32x4* orow = (f32x4*)(a.out + (size_t)m * D_); const f32x4* wr = (const f32x4*)a.final_norm_w;
#pragma unroll
        for (int j = 0; j < 4; ++j) { const u32x4 yv = yr[64 * j]; const int c4 = 2 * (C.lane + 64 * j);
            const f32x4 w0 = wr[c4], w1 = wr[c4 + 1];
            f32x4 o0, o1; o0.x = bflo(yv.x) * rs * w0.x; o0.y = bfhi(yv.x) * rs * w0.y; o0.z = bflo(yv.y) * rs * w0.z; o0.w = bfhi(yv.y) * rs * w0.w;
            o1.x = bflo(yv.z) * rs * w1.x; o1.y = bfhi(yv.z) * rs * w1.y; o1.z = bflo(yv.w) * rs * w1.z; o1.w = bfhi(yv.w) * rs * w1.w;
            orow[c4] = o0; orow[c4 + 1] = o1; }
    }
}

#ifndef MK_N_LAUNCHES
#define MK_N_LAUNCHES 1
#endif
constexpr int N_PHASES = 10;
__global__ void __launch_bounds__(NTHR, 2) mega_fwd(Args a) {
    extern __shared__ __attribute__((aligned(16))) unsigned char lds_raw[];
    Ctx C; C.lds = (LAS unsigned char*)lds_raw; C.tid = threadIdx.x; C.lane = C.tid & 63; C.wave = __builtin_amdgcn_readfirstlane(C.tid >> 6); C.wg = blockIdx.x; C.G = gridDim.x;
    volatile LAS unsigned* MISC = (volatile LAS unsigned*)(C.lds + MISC_OFF);
    if (C.tid < 32) MISC[C.tid] = 0u;
    __syncthreads();
    unsigned char* ws = a.ws;
    XcdBarrier bar; bar.bar = (unsigned*)(ws + WS_CTL) + CW_BAR; bar.x = 0; bar.st = nullptr;
    const int lo = a.ph_lo, hi = a.ph_hi;
    if (hi - lo > 1) bar = xcd_barrier_post((unsigned*)(ws + WS_CTL) + CW_BAR, MISC + 8);
#define IN(k) (lo <= (k) && (k) < hi)
#define SEAM(k) do { if (IN(k) && IN((k) + 1)) xcd_barrier(bar); } while (0)
    float* dscr = a.out;
    if (IN(0)) { REP(0) p0_prep(C, a); } SEAM(0);
    if (IN(1)) {
        SchedPlain S; S.T.init(S_, NIN, C.G, C.wg); S.Ab = (const char*)(ws + WS_H); S.Bb = (const char*)(ws + WS_WIN); S.tA = (size_t)256 * D_ * 2; S.tB = (size_t)256 * D_ * 2;
        EpiProj E{ws}; REP(1) pg8::gemm_phase(C.lds, D_, D_, D_, S, E);
    } SEAM(1);
    if (IN(2)) { REP(2) p2_norms(C, a); REP(12) p2_hgrn_states(C, a, dscr); } SEAM(2);
    if (IN(3)) {
        SchedPlain S; S.T.init(S_, 4096, C.G, C.wg); S.Ab = (const char*)(ws + WS_CQN); S.Bb = (const char*)(ws + WS_WQ); S.tA = (size_t)256 * QR * 2; S.tB = (size_t)256 * QR * 2;
        EpiQ E{ws}; REP(3) pg8::gemm_phase(C.lds, QR, QR, QR, S, E);
        REP(13) p3_scan(C, a, dscr);
    } SEAM(3);
    if (IN(4)) { attn_setup(C, a); REP(4) p4_indexer(C, a, dscr); if (PROBE_REP == 14) p4_hgrn_out(C, a, a.ph_hi > 100); p4_hgrn_out(C, a, true); } SEAM(4);
    if (IN(6)) {
        SchedUV S; S.T.init(S_, AW, C.G, C.wg); S.Ab = (const char*)(ws + WS_RAW); S.Bb = (const char*)(ws + WS_WUV);
        EpiUV E{ws}; pg8::gemm_phase(C.lds, 2048, 512, 512, S, E);
    } SEAM(6);
    if (IN(7)) {
        SchedMerge S; S.T.init(S_, D_, C.G, C.wg); S.Aa = (const char*)(ws + WS_QA); S.Ab = (const char*)(ws + WS_GB); S.Ba = (const char*)(ws + WS_WPA); S.Bb = (const char*)(ws + WS_WPB);
        EpiMerge E{ws}; pg8::gemm_phase(C.lds, AW, AW, AW, S, E);
    } SEAM(7);
    if (IN(8)) {
        SchedPlain S; S.T.init(S_, D_, C.G, C.wg); S.Ab = (const char*)(ws + WS_SB); S.Bb = (const char*)(ws + WS_WOUT); S.tA = (size_t)256 * D_ * 2; S.tB = (size_t)256 * D_ * 2;
        EpiOut E{a.x, (bf16*)(ws + WS_G), (float*)(ws + WS_CTL) + RS_WORD}; pg8::gemm_phase(C.lds, D_, D_, D_, S, E);
    } SEAM(8);
    if (IN(9)) { p9_final_norm(C, a); }
#undef IN
#undef SEAM
}

extern "C" void kernel_launch(void* const* d_in, const int* in_sizes, int n_in, void* d_out, int out_size, void* d_ws, size_t ws_size, hipStream_t stream) {
    static int grid = 0;
    if (grid == 0) {
        if (n_in != 17 || in_sizes[0] != S_ * D_ || out_size != S_ * D_ || ws_size < WS_END) {
            fprintf(stderr, "kernel_launch: unexpected shapes / workspace (n_in %d, in0 %d, out %d, ws %zu < %zu); nothing launched\n", n_in, n_in > 0 ? in_sizes[0] : -1, out_size, ws_size, (size_t)WS_END); grid = -1; return; }
        int dev = 0, cus = 0;
        if (hipGetDevice(&dev) != hipSuccess || hipDeviceGetAttribute(&cus, hipDeviceAttributeMultiprocessorCount, dev) != hipSuccess) { grid = -1; return; }
        if (hipFuncSetAttribute((const void*)mega_fwd, hipFuncAttributeMaxDynamicSharedMemorySize, LDS_BYTES) != hipSuccess) { fprintf(stderr, "kernel_launch: hipFuncSetAttribute failed\n"); grid = -1; return; }
        (void)hipGetLastError();
        grid = cus;
    }
    if (grid < 0) return;
    (void)hipMemsetAsync((char*)d_ws + WS_CTL, 0, CTL_ZERO_BYTES, stream);
    Args a{};
    const float** ip = (const float**)&a;
    for (int i = 0; i < 17; ++i) ip[i] = (const float*)d_in[i];
    a.out = (float*)d_out; a.ws = (unsigned char*)d_ws;
    constexpr int NL = MK_N_LAUNCHES;
    for (int li = 0; li < NL; ++li) {
        a.ph_lo = li * N_PHASES / NL; a.ph_hi = (li + 1) * N_PHASES / NL;
        hipLaunchKernelGGL(mega_fwd, dim3(grid), dim3(NTHR), LDS_BYTES, stream, a);
    }
}
```

```cpp
#include <hip/hip_runtime.h>
#include <cstdio>

#define LAS __attribute__((address_space(3)))
#define GAS __attribute__((address_space(1)))
typedef unsigned short bf16;
typedef short bf16x8 __attribute__((ext_vector_type(8)));
typedef short s16x4 __attribute__((ext_vector_type(4)));
typedef float f32x4 __attribute__((ext_vector_type(4)));
typedef float f32x2 __attribute__((ext_vector_type(2)));
typedef float f32x16 __attribute__((ext_vector_type(16)));
typedef unsigned u32x4 __attribute__((ext_vector_type(4)));
typedef unsigned u32x2 __attribute__((ext_vector_type(2)));

namespace pg8 {
constexpr int BM = 256, BK = 64, HALF = 128, HTB = HALF * BK * 2, STAGE_BYTES = 8 * HTB, NXCD = 8, WGM = 8;
__device__ __forceinline__ int lds_byte(int r, int c) { const int st = (r >> 4) * 2 + (c >> 5), rr = r & 15, cc = c & 31, ob = rr * 64 + cc * 2; return st * 1024 + (ob ^ (((ob >> 9) & 1) << 5)); }
__device__ __forceinline__ void stage_rc(int b, int& R, int& C) { const int st = b / 1024, sb = b % 1024, swz = sb ^ (((sb >> 9) & 1) << 5); R = (st >> 1) * 16 + swz / 64; C = (st & 1) * 32 + (swz % 64) / 2; }
__device__ __forceinline__ int perm32(int rho) { const int n = rho >> 4, i = rho & 15; return 8 * (i >> 2) + 4 * n + (i & 3); }
struct Unit { int pm, pn, sub; };
struct TileOrder {
    int nM, nN, nwg, G, c;
    __device__ void init(int M, int N, int G_, int c_) { nM = M / BM; nN = N / BM; nwg = nM * nN; G = G_; c = c_; }
    __device__ bool tile(int i, int& pm, int& pn) const {
        const long L = (long)i * G + c; if (L >= nwg) return false;
        int wgid = (int)L; { const int q = nwg / NXCD, r = nwg % NXCD, xcd = wgid % NXCD, off = wgid / NXCD; wgid = (xcd < r ? xcd * (q + 1) : r * (q + 1) + (xcd - r) * q) + off; }
        const int nig = WGM * nN, gid = wgid / nig, fm = gid * WGM, gsz = (nM - fm) < WGM ? (nM - fm) : WGM;
        pm = fm + ((wgid % nig) % gsz); pn = (wgid % nig) / gsz; return true;
    }
};
template <class Epi, class Sched, bool ALIGN_EPI = true, bool SP2 = true>
__device__ __forceinline__ void gemm_phase(LAS unsigned char* lds, const int lda, const int ldb, const int K, const Sched& S, const Epi& E) {
    const int tid = threadIdx.x, wid = __builtin_amdgcn_readfirstlane(tid >> 6), lane = tid & 63, wr = wid >> 2, wc = wid & 3, fr = lane & 15, fq = lane >> 4;
    const int nt = K / BK;
    unsigned voffA[2], voffB[2];
#pragma unroll
    for (int i = 0; i < 2; ++i) { int R, C; stage_rc(tid * 16 + i * 8192, R, C); const int Rb = (R & ~31) + perm32(R & 31);
        voffA[i] = (unsigned)(R * lda + C) * 2u; voffB[i] = (unsigned)(Rb * ldb + C) * 2u; }
    const size_t kstep = (size_t)(BK * 2);
    const size_t hstepA = (size_t)HALF * lda * 2, hstepB = (size_t)HALF * ldb * 2;
    const unsigned ldsw = (unsigned)wid * 1024u;
    const int aoff = lds_byte(wr * 64 + fr, fq * 8), boff = lds_byte(wc * 32 + fr, fq * 8);
#define PG8_SA(b, h) (((b) * 2 + (h)) * HTB)
#define PG8_SB(b, h) ((4 + (b) * 2 + (h)) * HTB)
#define PG8_STAGE(bufoff, gbase, voff) do { _Pragma("unroll") for (int _i = 0; _i < 2; ++_i) \
        __builtin_amdgcn_global_load_lds((const unsigned*)((const char*)(gbase) + (voff)[_i]), (LAS unsigned*)(lds + (bufoff) + ldsw + _i * 8192), 16, 0, 0); } while (0)
#define PG8_LDA(dst, b, h) do { _Pragma("unroll") for (int m = 0; m < 4; ++m) _Pragma("unroll") for (int k = 0; k < 2; ++k) dst[m][k] = *(const LAS bf16x8*)(lds + PG8_SA(b, h) + aoff + m * 2048 + k * 1024); } while (0)
#define PG8_LDB(dst, b, h) do { _Pragma("unroll") for (int n = 0; n < 2; ++n) _Pragma("unroll") for (int k = 0; k < 2; ++k) dst[n][k] = *(const LAS bf16x8*)(lds + PG8_SB(b, h) + boff + n * 2048 + k * 1024); } while (0)
#define PG8_MMA(ai, bj, At, Bt) do { __builtin_amdgcn_s_setprio(1); _Pragma("unroll") for (int m = 0; m < 4; ++m) _Pragma("unroll") for (int n = 0; n < 2; ++n) _Pragma("unroll") for (int k = 0; k < 2; ++k) \
        acc[ai][bj][m][n] = __builtin_amdgcn_mfma_f32_16x16x32_bf16(Bt[n][k], At[m][k], acc[ai][bj][m][n], 0, 0, 0); __builtin_amdgcn_s_setprio(0); } while (0)
#define PG8_WAIT_V(n) asm volatile("s_waitcnt vmcnt(" #n ")" ::: "memory")
#define PG8_WAIT_L(n) asm volatile("s_waitcnt lgkmcnt(" #n ")" ::: "memory")
#define PG8_BAR __builtin_amdgcn_s_barrier()
#define PG8_SCHED __builtin_amdgcn_sched_barrier(0)
    Unit cur, nxt; int ui = 0;
    if (!S.next(0, cur)) return;
    f32x4 acc[2][2][4][2];
#pragma unroll
    for (int a = 0; a < 2; ++a)
#pragma unroll
        for (int b = 0; b < 2; ++b)
#pragma unroll
            for (int m = 0; m < 4; ++m)
#pragma unroll
                for (int n = 0; n < 2; ++n) acc[a][b][m][n] = (f32x4){0.f, 0.f, 0.f, 0.f};
    bf16x8 At[4][2], B0[2][2], B1[2][2];
    const char* cA = S.A(cur); const char* cB = S.B(cur);
    if constexpr (SP2) {
        PG8_STAGE(PG8_SB(0, 0), cB, voffB); PG8_STAGE(PG8_SB(0, 1), cB + hstepB, voffB); PG8_STAGE(PG8_SA(0, 0), cA, voffA); PG8_STAGE(PG8_SA(0, 1), cA + hstepA, voffA);
        if (wr == 1) PG8_BAR;
        PG8_WAIT_V(2); PG8_BAR;
        PG8_STAGE(PG8_SB(1, 0), cB + kstep, voffB); PG8_STAGE(PG8_SA(1, 0), cA + kstep, voffA); PG8_STAGE(PG8_SB(1, 1), cB + hstepB + kstep, voffB);
        PG8_WAIT_V(6); PG8_BAR;
    } else {
        PG8_STAGE(PG8_SB(0, 0), cB, voffB); PG8_STAGE(PG8_SA(0, 0), cA, voffA); PG8_STAGE(PG8_SB(0, 1), cB + hstepB, voffB); PG8_STAGE(PG8_SA(0, 1), cA + hstepA, voffA);
        if (wr == 1) PG8_BAR;
        PG8_WAIT_V(4); PG8_BAR;
        PG8_STAGE(PG8_SB(1, 0), cB + kstep, voffB); PG8_STAGE(PG8_SA(1, 0), cA + kstep, voffA); PG8_STAGE(PG8_SB(1, 1), cB + hstepB + kstep, voffB);
        PG8_WAIT_V(6); PG8_BAR;
    }
    for (;;) {
        const bool has_next = S.next(ui + 1, nxt);
        const char* nA = has_next ? S.A(nxt) : cA; const char* nB = has_next ? S.B(nxt) : cB;
        for (int t = 0; t < nt; t += 2) {
            const bool last = (t == nt - 2);
            const char* a1 = cA + (size_t)(t + 1) * kstep;
            const char* a2 = last ? nA : cA + (size_t)(t + 2) * kstep; const char* b2 = last ? nB : cB + (size_t)(t + 2) * kstep;
            const char* a3 = a2 + kstep; const char* b3 = b2 + kstep;
            if constexpr (SP2) {
            PG8_LDB(B0, 0, 0); PG8_LDB(B1, 0, 1); PG8_SCHED; PG8_LDA(At, 0, 0); PG8_STAGE(PG8_SA(1, 1), a1 + hstepA, voffA);
            PG8_WAIT_V(8); PG8_WAIT_L(0); PG8_BAR; PG8_MMA(0, 0, At, B0); PG8_MMA(0, 1, At, B1); PG8_BAR; PG8_SCHED;
            PG8_LDA(At, 0, 1); PG8_STAGE(PG8_SB(0, 0), b2, voffB); PG8_STAGE(PG8_SB(0, 1), b2 + hstepB, voffB); PG8_STAGE(PG8_SA(0, 0), a2, voffA);
            PG8_WAIT_V(8); PG8_WAIT_L(0); PG8_BAR; PG8_MMA(1, 0, At, B0); PG8_MMA(1, 1, At, B1); PG8_BAR; PG8_SCHED;
            PG8_LDB(B0, 1, 0); PG8_LDB(B1, 1, 1); PG8_SCHED; PG8_LDA(At, 1, 0); PG8_STAGE(PG8_SA(0, 1), a2 + hstepA, voffA);
            PG8_WAIT_V(8); PG8_WAIT_L(0); PG8_BAR; PG8_MMA(0, 0, At, B0); PG8_MMA(0, 1, At, B1); PG8_BAR; PG8_SCHED;
            PG8_LDA(At, 1, 1); PG8_STAGE(PG8_SB(1, 0), b3, voffB); PG8_STAGE(PG8_SB(1, 1), b3 + hstepB, voffB); PG8_STAGE(PG8_SA(1, 0), a3, voffA);
            PG8_WAIT_V(8); PG8_WAIT_L(0); PG8_BAR; PG8_MMA(1, 0, At, B0); PG8_MMA(1, 1, At, B1); PG8_BAR; PG8_SCHED;
            } else {
            PG8_LDB(B0, 0, 0); PG8_SCHED; PG8_LDA(At, 0, 0); PG8_STAGE(PG8_SA(1, 1), a1 + hstepA, voffA);
            PG8_WAIT_L(8); PG8_BAR; PG8_WAIT_L(0); PG8_MMA(0, 0, At, B0); PG8_BAR; PG8_SCHED;
            PG8_LDB(B1, 0, 1); PG8_STAGE(PG8_SB(0, 0), b2, voffB);
            PG8_BAR; PG8_WAIT_L(0); PG8_MMA(0, 1, At, B1); PG8_BAR;
            PG8_LDA(At, 0, 1); PG8_STAGE(PG8_SA(0, 0), a2, voffA);
            PG8_BAR; PG8_WAIT_L(0); PG8_MMA(1, 0, At, B0); PG8_BAR; PG8_SCHED;
            PG8_STAGE(PG8_SB(0, 1), b2 + hstepB, voffB);
            PG8_WAIT_V(6); PG8_BAR; PG8_MMA(1, 1, At, B1); PG8_BAR;
            PG8_LDB(B0, 1, 0); PG8_SCHED; PG8_LDA(At, 1, 0); PG8_STAGE(PG8_SA(0, 1), a2 + hstepA, voffA);
            PG8_WAIT_L(8); PG8_BAR; PG8_WAIT_L(0); PG8_MMA(0, 0, At, B0); PG8_BAR; PG8_SCHED;
            PG8_LDB(B1, 1, 1); PG8_STAGE(PG8_SB(1, 0), b3, voffB);
            PG8_BAR; PG8_WAIT_L(0); PG8_MMA(0, 1, At, B1); PG8_BAR;
            PG8_LDA(At, 1, 1); PG8_STAGE(PG8_SA(1, 0), a3, voffA);
            PG8_BAR; PG8_WAIT_L(0); PG8_MMA(1, 0, At, B0); PG8_BAR; PG8_SCHED;
            PG8_STAGE(PG8_SB(1, 1), b3 + hstepB, voffB);
            PG8_WAIT_V(6); PG8_BAR; PG8_MMA(1, 1, At, B1); PG8_BAR;
            }
        }
        if constexpr (ALIGN_EPI) { if (wr == 0) PG8_BAR; }
        E(acc, cur, wr, wc, fr, fq);
        if (!has_next) break;
        if (!S.keep(cur)) {
#pragma unroll
            for (int a = 0; a < 2; ++a)
#pragma unroll
                for (int b = 0; b < 2; ++b)
#pragma unroll
                    for (int m = 0; m < 4; ++m)
#pragma unroll
                        for (int n = 0; n < 2; ++n) acc[a][b][m][n] = (f32x4){0.f, 0.f, 0.f, 0.f};
        }
        cur = nxt; cA = nA; cB = nB; ++ui;
        if constexpr (ALIGN_EPI) { if (wr == 1) PG8_BAR; }
    }
    PG8_WAIT_V(0);
    if constexpr (!ALIGN_EPI) { if (wr == 0) PG8_BAR; }
    PG8_BAR;
#undef PG8_SA
#undef PG8_SB
#undef PG8_STAGE
#undef PG8_LDA
#undef PG8_LDB
#undef PG8_MMA
#undef PG8_WAIT_V
#undef PG8_WAIT_L
#undef PG8_BAR
#undef PG8_SCHED
}
}

#ifndef PROBE_REP
#define PROBE_REP -1
#endif
#define REP(k) for (int _r = 0; _r < ((k) == PROBE_REP ? 2 : 1); ++_r)
constexpr int S_ = 8192, D_ = 2048, AW = 1024, QR = 512, KVR = 256, IDXD = 128, IDXH = 16, BH = 8, TOPK = 256, CHUNK = 64, NCH = S_ / CHUNK;
constexpr int IN_W = 10128, NIN = 10240;
constexpr float EPS = 1e-6f;
constexpr int NWAVES = 8, NTHR = 512;

constexpr size_t MiB = 1u << 20;
constexpr size_t WS_CTL = 0, CTL_ZERO_BYTES = 1 * MiB;
constexpr size_t WS_LB = 1 * MiB;
constexpr size_t WS_NCNT = 1 * MiB + 64 * 1024;
constexpr size_t WS_DLAST = 1 * MiB + 128 * 1024;
constexpr size_t WS_WIDX = 2 * MiB;
constexpr size_t WS_WQ = 4 * MiB;
constexpr size_t WS_WUV = 8 * MiB;
constexpr size_t WS_WPA = 9 * MiB, WS_WPB = 13 * MiB;
constexpr size_t WS_WOUT = 17 * MiB;
constexpr size_t WS_QA = 25 * MiB;
constexpr size_t WS_G = 41 * MiB;
constexpr size_t WS_VA = 73 * MiB;
constexpr size_t WS_GA = 89 * MiB;
constexpr size_t WS_GB = 105 * MiB;
constexpr size_t WS_SA = 121 * MiB;
constexpr size_t WS_SB = 153 * MiB;
constexpr size_t WS_RAW = 185 * MiB;
constexpr size_t WS_H = 217 * MiB;
constexpr size_t WS_CQN = 217 * MiB, WS_CKVN = 225 * MiB, WS_KIDX = 229 * MiB, WS_IDX = 231 * MiB;
constexpr size_t WS_WIN = 249 * MiB;
constexpr size_t WS_QABS = 249 * MiB;
constexpr size_t WS_SPT = 281 * MiB;
constexpr size_t WS_END = 313 * MiB;
constexpr int RS_WORD = 65536;
constexpr int CW_BAR = 4096;
constexpr int CW_Q4 = 8192;
constexpr int MISC_Q4 = 16;

typedef __bf16 bf16x2_t __attribute__((ext_vector_type(2)));
typedef short s16x2 __attribute__((ext_vector_type(2)));
__device__ __forceinline__ unsigned pk2(float lo, float hi) { const f32x2 v = {lo, hi}; return __builtin_bit_cast(unsigned, __builtin_convertvector(v, bf16x2_t)); }
__device__ __forceinline__ unsigned f2bf(float f) { return pk2(f, 0.f) & 0xffffu; }
__device__ __forceinline__ unsigned pk2_relu(float lo, float hi) { const f32x2 v = {lo, hi}; const s16x2 z = {0, 0};
    return __builtin_bit_cast(unsigned, __builtin_elementwise_max(__builtin_bit_cast(s16x2, __builtin_convertvector(v, bf16x2_t)), z)); }
__device__ __forceinline__ float bf2f(unsigned short b) { return __builtin_bit_cast(float, ((unsigned)b) << 16); }
__device__ __forceinline__ float bflo(unsigned w) { return __builtin_bit_cast(float, w << 16); }
__device__ __forceinline__ float bfhi(unsigned w) { return __builtin_bit_cast(float, w & 0xffff0000u); }
__device__ __forceinline__ float wave_sum(float v) {
#pragma unroll
    for (int o = 1; o < 64; o <<= 1) v += __shfl_xor(v, o);
    return v;
}
__device__ __forceinline__ float sigmoidf_(float x) { return __builtin_amdgcn_rcpf(1.0f + __expf(-x)); }
__device__ __forceinline__ float siluf_(float x) { return x * __builtin_amdgcn_rcpf(1.0f + __expf(-x)); }
#define LDS_WAIT() asm volatile("s_waitcnt lgkmcnt(0)" ::: "memory")
#define VM_WAIT() asm volatile("s_waitcnt vmcnt(0)" ::: "memory")

#define XB_TMO      128
#define XB_XCNT(j)  (256  + 64 * (j))
#define XB_XSUB(j)  (1280 + 64 * (j))
#define XB_XGEN(j)  (2304 + 64 * (j))
#define XB_TOP      3328
#define XB_TOPGEN   3392
#define XCD_BAR_WORDS 3456
#define XB_SPIN_CAP (1u << 22)
__device__ __forceinline__ unsigned xb_ld(unsigned* p)              { return __hip_atomic_load(p, __ATOMIC_RELAXED, __HIP_MEMORY_SCOPE_AGENT); }
__device__ __forceinline__ unsigned xb_add(unsigned* p, unsigned v) { return __hip_atomic_fetch_add(p, v, __ATOMIC_RELAXED, __HIP_MEMORY_SCOPE_AGENT); }
__device__ __forceinline__ unsigned xb_xcc_id() { return (unsigned)__builtin_amdgcn_s_getreg((3 << 11) | 20) & 0xFu; }
#define XB_SPIN(cond, bar) do { unsigned _sp = 0; while (cond) { __builtin_amdgcn_s_sleep(1); \
    if ((++_sp & 255u) == 0u) { if (xb_ld(&(bar)[XB_TMO])) break; if (_sp > XB_SPIN_CAP) { atomicAdd(&(bar)[XB_TMO], 1u); break; } } } } while (0)
struct XcdBarrier { unsigned* bar; unsigned x; volatile LAS unsigned* st; };
__device__ __forceinline__ XcdBarrier xcd_barrier_post(unsigned* bar, volatile LAS unsigned* st) {
    XcdBarrier b; b.bar = bar; b.x = xb_xcc_id(); b.st = st;
    if (threadIdx.x == 0) (void)xb_add(&bar[XB_XCNT(b.x)], 1u);
    return b;
}
__device__ __forceinline__ void xcd_barrier_complete(unsigned* bar, unsigned x, unsigned& nloc, unsigned& nx) {
    const unsigned G = gridDim.x * gridDim.y * gridDim.z;
    unsigned sum, cnt, mine, sp = 0u;
    for (;;) {
        sum = 0u; cnt = 0u; mine = 0u;
#pragma unroll
        for (unsigned j = 0; j < 16; ++j) { const unsigned c = xb_ld(&bar[XB_XCNT(j)]); sum += c; cnt += (c > 0u) ? 1u : 0u; mine = (j == x) ? c : mine; }
        if (sum == G) break;
        __builtin_amdgcn_s_sleep(1);
        if ((++sp & 255u) == 0u) { if (xb_ld(&bar[XB_TMO])) break; if (sp > XB_SPIN_CAP) { atomicAdd(&bar[XB_TMO], 1u); break; } }
    }
    nloc = mine > 0u ? mine : 1u; nx = cnt > 0u ? cnt : 1u;
}
__device__ __forceinline__ void xcd_barrier(const XcdBarrier& b) {
    asm volatile("s_waitcnt vmcnt(0)" ::: "memory");
    __syncthreads();
    if (threadIdx.x == 0) {
        unsigned* bar = b.bar;
        __builtin_amdgcn_s_waitcnt(0);
        unsigned nloc = b.st[0], nx = b.st[1];
        if (nloc == 0u) { xcd_barrier_complete(bar, b.x, nloc, nx); b.st[0] = nloc; b.st[1] = nx; }
        const unsigned old = xb_add(&bar[XB_XSUB(b.x)], 1u);
        const unsigned gen = old / nloc;
        if (old + 1u == (gen + 1u) * nloc) {
            __builtin_amdgcn_fence(__ATOMIC_RELEASE, "agent");
            asm volatile("s_waitcnt vmcnt(0)" ::: "memory");
            const unsigned og = xb_add(&bar[XB_TOP], 1u);
            const unsigned tg = og / nx;
            if (og + 1u == (tg + 1u) * nx) xb_add(&bar[XB_TOPGEN], 1u);
            else XB_SPIN(xb_ld(&bar[XB_TOPGEN]) == tg, bar);
            __builtin_amdgcn_fence(__ATOMIC_ACQUIRE, "agent");
            xb_add(&bar[XB_XGEN(b.x)], 1u);
            asm volatile("s_waitcnt vmcnt(0)" ::: "memory");
        } else {
            XB_SPIN(xb_ld(&bar[XB_XGEN(b.x)]) == gen, bar);
            __builtin_amdgcn_fence(__ATOMIC_ACQUIRE, "agent");
            asm volatile("s_waitcnt vmcnt(0)" ::: "memory");
        }
    }
    __syncthreads();
}

struct Args {
    const float *x, *norm_w, *w_in, *lb_table, *gnorm_a, *q_norm_w, *kv_norm_w, *w_uq, *w_qidx, *w_ukv, *kidx_norm_w, *kidx_norm_b, *w_pa, *w_pb, *w_out, *rel_bias, *final_norm_w;
    float* out; unsigned char* ws; int ph_lo, ph_hi;
};
constexpr int LDS_BYTES = 155648;
constexpr int MISC_OFF = 154624;
struct Ctx { LAS unsigned char* lds; int tid, lane, wave, wg, G; };

struct P0Item { const float* src; bf16* dst; int N, ldk, sc; };
__device__ __forceinline__ P0Item p0_decode(const Args& a, unsigned char* ws, int it, int lane) {
    constexpr int I_IN = (D_ / 64) * (NIN / 32), I_QI = (QR / 64) * (2048 / 32), I_PA = (AW / 64) * (D_ / 32), I_OUT = (D_ / 64) * (D_ / 32);
    const int c4 = lane & 7; P0Item d; int r = it;
    if (r < I_IN) { const int kb = r / (NIN / 32), nb = r % (NIN / 32), np = 32 * nb + 4 * c4;
        d.src = a.w_in + (size_t)(64 * kb) * IN_W; d.N = IN_W; d.sc = np < 5008 ? np : (np < 5120 ? -1 : np - 112); d.dst = (bf16*)(ws + WS_WIN) + (size_t)(32 * nb) * D_ + 64 * kb; d.ldk = D_; return d; } r -= I_IN;
    if (r < I_QI) { const int kb = r / 64, nb = r % 64; d.src = a.w_qidx + (size_t)(64 * kb) * 2048; d.N = 2048; d.sc = 32 * nb + 4 * c4; d.dst = (bf16*)(ws + WS_WQ) + (size_t)(2048 + 32 * nb) * QR + 64 * kb; d.ldk = QR; return d; } r -= I_QI;
    if (r < 2 * I_PA) { const bool pb = r >= I_PA; if (pb) r -= I_PA; const int kb = r / 64, nb = r % 64;
        d.src = (pb ? a.w_pb : a.w_pa) + (size_t)(64 * kb) * D_; d.N = D_; d.sc = 32 * nb + 4 * c4; d.dst = (bf16*)(ws + (pb ? WS_WPB : WS_WPA)) + (size_t)(32 * nb) * AW + 64 * kb; d.ldk = AW; return d; } r -= 2 * I_PA;
    if (r < I_OUT) { const int kb = r / 64, nb = r % 64; d.src = a.w_out + (size_t)(64 * kb) * D_; d.N = D_; d.sc = 32 * nb + 4 * c4; d.dst = (bf16*)(ws + WS_WOUT) + (size_t)(32 * nb) * D_ + 64 * kb; d.ldk = D_; return d; } r -= I_OUT;
    {
        const int kb = r / 32, nb = r % 32, k0 = 64 * kb, hh = k0 >> 8, c0 = k0 & 255, np = 32 * nb + 4 * c4, h = np >> 7, dd = np & 127;
        d.src = a.w_ukv + (size_t)c0 * 2048; d.N = 2048; d.sc = (hh == (h & 1)) ? h * 256 + 128 + dd : -1; d.dst = (bf16*)(ws + WS_WUV) + (size_t)(32 * nb) * 512 + k0; d.ldk = 512; return d; }
}
__device__ __forceinline__ void p0_item_load(const P0Item& d, int lane, f32x4 (&v)[8]) {
    const int kr = lane >> 3;
#pragma unroll
    for (int i = 0; i < 8; ++i) v[i] = d.sc >= 0 ? *(const f32x4*)(d.src + (size_t)(kr + 8 * i) * d.N + d.sc) : (f32x4){0.f, 0.f, 0.f, 0.f};
}
__device__ __forceinline__ void p0_item_put(const P0Item& d, int lane, const f32x4 (&v)[8], LAS float* scr) {
    const int c4 = lane & 7, kr = lane >> 3;
#pragma unroll
    for (int i = 0; i < 8; ++i) { LAS float* p = scr + (kr + 8 * i) * 33 + 4 * c4; p[0] = v[i].x; p[1] = v[i].y; p[2] = v[i].z; p[3] = v[i].w; }
    LDS_WAIT(); asm volatile("" ::: "memory");
    const int c = lane & 7;
#pragma unroll
    for (int j = 0; j < 4; ++j) { const int n = (lane >> 3) + 8 * j; const LAS float* sp = scr + (8 * c) * 33 + n;
        u32x4 o; o.x = pk2(sp[0 * 33], sp[1 * 33]); o.y = pk2(sp[2 * 33], sp[3 * 33]); o.z = pk2(sp[4 * 33], sp[5 * 33]); o.w = pk2(sp[6 * 33], sp[7 * 33]);
        *(u32x4*)(d.dst + (size_t)n * d.ldk + 8 * c) = o; }
    LDS_WAIT(); asm volatile("" ::: "memory");
}
__device__ __forceinline__ void p0_prep(const Ctx& C, const Args& a) {
    unsigned char* ws = a.ws;
    LAS float* scr = (LAS float*)(C.lds + C.wave * 16384);
    const int gw = C.wg * NWAVES + C.wave, NGW = C.G * NWAVES;
    constexpr int NITEMS = (D_ / 64) * (NIN / 32) + (QR / 64) * (2048 / 32) + 2 * (AW / 64) * (D_ / 32) + (D_ / 64) * (D_ / 32) + (512 / 64) * (1024 / 32);
    {
        f32x4 va[8], vb[8]; int it = gw;
        P0Item da, db;
        if (it < NITEMS) { da = p0_decode(a, ws, it, C.lane); p0_item_load(da, C.lane, va); }
        while (it < NITEMS) {
            const int i1 = it + NGW; if (i1 < NITEMS) { db = p0_decode(a, ws, i1, C.lane); p0_item_load(db, C.lane, vb); }
            p0_item_put(da, C.lane, va, scr);
            if (i1 >= NITEMS) break;
            const int i2 = i1 + NGW; if (i2 < NITEMS) { da = p0_decode(a, ws, i2, C.lane); p0_item_load(da, C.lane, va); }
            p0_item_put(db, C.lane, vb, scr);
            it = i2;
        }
    }
    for (int m = gw; m < S_; m += NGW) {
        const f32x4* xr = (const f32x4*)(a.x + (size_t)m * D_) + C.lane; const f32x4* wr = (const f32x4*)a.norm_w + C.lane;
        f32x4 v[8]; float s = 0.f;
#pragma unroll
        for (int j = 0; j < 8; ++j) { v[j] = xr[64 * j]; s += (v[j].x * v[j].x + v[j].y * v[j].y) + (v[j].z * v[j].z + v[j].w * v[j].w); }
        const float rs = rsqrtf(wave_sum(s) * (1.f / D_) + EPS);
        u32x2* o8 = (u32x2*)((bf16*)(ws + WS_H) + (size_t)m * D_) + C.lane;
#pragma unroll
        for (int j = 0; j < 8; ++j) { const f32x4 w = wr[64 * j]; u32x2 o; o.x = pk2(v[j].x * rs * w.x, v[j].y * rs * w.y); o.y = pk2(v[j].z * rs * w.z, v[j].w * rs * w.w); o8[64 * j] = o; }
    }
    { const int g = C.wg * NTHR + C.tid; if (g < AW) { const float l0 = a.lb_table[g], l1 = a.lb_table[AW + g], mx = fmaxf(l0, l1), e0 = __expf(l0 - mx), e1 = __expf(l1 - mx); ((float*)(ws + WS_LB))[g] = e0 / (e0 + e1); } }
    __syncthreads();
    {
        LAS float* As = (LAS float*)C.lds;
        LAS float* Bs = As + 64 * 129;
        bf16* WqT = (bf16*)(ws + WS_WQ);
        for (int it = C.wg; it < 256; it += C.G) {
            const int h = it >> 5, cb = (it >> 3) & 3, rb = it & 7, c0 = cb * 64, r0 = rb * 64;
            { const int rr = C.tid >> 3, seg = C.tid & 7;
#pragma unroll
              for (int j = 0; j < 4; ++j) { const f32x4 va = *(const f32x4*)(a.w_uq + (size_t)(r0 + rr) * 1024 + h * 128 + seg * 16 + 4 * j); const f32x4 vb = *(const f32x4*)(a.w_ukv + (size_t)(c0 + rr) * 2048 + h * 256 + seg * 16 + 4 * j);
                  LAS float* pa = As + rr * 129 + seg * 16 + 4 * j; pa[0] = va.x; pa[1] = va.y; pa[2] = va.z; pa[3] = va.w;
                  LAS float* pb = Bs + rr * 129 + seg * 16 + 4 * j; pb[0] = vb.x; pb[1] = vb.y; pb[2] = vb.z; pb[3] = vb.w; } }
            __syncthreads();
            { const int r = C.tid & 63, cg = C.tid >> 6; float o[8];
#pragma unroll
              for (int i = 0; i < 8; ++i) o[i] = 0.f;
              for (int d = 0; d < 128; ++d) { const float av = As[r * 129 + d];
#pragma unroll
                  for (int i = 0; i < 8; ++i) o[i] += av * Bs[(cg * 8 + i) * 129 + d]; }
#pragma unroll
              for (int i = 0; i < 8; ++i) WqT[(size_t)(h * 256 + c0 + cg * 8 + i) * QR + r0 + r] = (bf16)f2bf(o[i] * 0.08838834764831845f); }
            __syncthreads();
        }
    }
}

struct SchedPlain {
    pg8::TileOrder T; const char* Ab; const char* Bb; size_t tA, tB;
    __device__ __forceinline__ bool next(int i, pg8::Unit& u) const { u.sub = 0; return T.tile(i, u.pm, u.pn); }
    __device__ __forceinline__ const char* A(const pg8::Unit& u) const { return Ab + (size_t)u.pm * tA; }
    __device__ __forceinline__ const char* B(const pg8::Unit& u) const { return Bb + (size_t)u.pn * tB; }
    __device__ __forceinline__ bool keep(const pg8::Unit&) const { return false; }
};
#define EPI_FOREACH(...) \
    _Pragma("unroll") for (int ai = 0; ai < 2; ++ai) _Pragma("unroll") for (int m = 0; m < 4; ++m) { const int row = u.pm * 256 + ai * 128 + wr * 64 + m * 16 + fr; \
    _Pragma("unroll") for (int bj = 0; bj < 2; ++bj) { const int col = u.pn * 256 + bj * 128 + wc * 32 + 8 * fq; f32x4& v0 = acc[ai][bj][m][0]; f32x4& v1 = acc[ai][bj][m][1]; __VA_ARGS__ } }

struct EpiProj {
    unsigned char* ws;
    __device__ __forceinline__ void operator()(f32x4 (&acc)[2][2][4][2], const pg8::Unit& u, int wr, int wc, int fr, int fq) const {
        const int pn = u.pn;
        if (pn < 4) {
            bf16* O = (bf16*)(ws + WS_QA);
            EPI_FOREACH({ u32x4 w; const float s = 0.08838834764831845f; w.x = pk2(siluf_(v0[0]) * s, siluf_(v0[1]) * s); w.y = pk2(siluf_(v0[2]) * s, siluf_(v0[3]) * s); w.z = pk2(siluf_(v1[0]) * s, siluf_(v1[1]) * s); w.w = pk2(siluf_(v1[2]) * s, siluf_(v1[3]) * s);
                *(u32x4*)(O + (size_t)row * AW + col) = w; })
        } else if (pn < 8) {
            float* O = (float*)(ws + WS_G); const float* lb = (const float*)(ws + WS_LB);
            EPI_FOREACH({ const int c = col - 1024; const f32x4 l0 = *(const f32x4*)(lb + c), l1 = *(const f32x4*)(lb + c + 4); f32x4 o0, o1;
                _Pragma("unroll") for (int j = 0; j < 4; ++j) { o0[j] = __logf(l0[j] + (1.f - l0[j]) * sigmoidf_(v0[j])); o1[j] = __logf(l1[j] + (1.f - l1[j]) * sigmoidf_(v1[j])); }
                *(f32x4*)(O + (size_t)row * AW + c) = o0; *(f32x4*)(O + (size_t)row * AW + c + 4) = o1; })
        } else if (pn < 12) {
            bf16* O = (bf16*)(ws + WS_VA);
            EPI_FOREACH({ u32x4 w; w.x = pk2(v0[0], v0[1]); w.y = pk2(v0[2], v0[3]); w.z = pk2(v1[0], v1[1]); w.w = pk2(v1[2], v1[3]); *(u32x4*)(O + (size_t)row * AW + col - 2048) = w; })
        } else if (pn < 16 || (pn >= 20 && pn < 24)) {
            bf16* O = (bf16*)(ws + (pn < 16 ? WS_GA : WS_GB)); const int cb = pn < 16 ? 3072 : 5120;
            EPI_FOREACH({ u32x4 w; w.x = pk2(siluf_(v0[0]), siluf_(v0[1])); w.y = pk2(siluf_(v0[2]), siluf_(v0[3])); w.z = pk2(siluf_(v1[0]), siluf_(v1[1])); w.w = pk2(siluf_(v1[2]), siluf_(v1[3]));
                *(u32x4*)(O + (size_t)row * AW + col - cb) = w; })
        } else if (pn < 20) {
            float* O = (float*)(ws + WS_RAW);
            EPI_FOREACH({ *(f32x4*)(O + (size_t)row * 1024 + col - 4096) = v0; *(f32x4*)(O + (size_t)row * 1024 + col - 4096 + 4) = v1; })
        } else {
            bf16* O = (bf16*)(ws + (pn < 32 ? WS_SA : WS_SB)); const int cb = pn < 32 ? 6144 : 8192;
            EPI_FOREACH({ u32x4 w; w.x = pk2(sigmoidf_(v0[0]), sigmoidf_(v0[1])); w.y = pk2(sigmoidf_(v0[2]), sigmoidf_(v0[3])); w.z = pk2(sigmoidf_(v1[0]), sigmoidf_(v1[1])); w.w = pk2(sigmoidf_(v1[2]), sigmoidf_(v1[3]));
                *(u32x4*)(O + (size_t)row * D_ + col - cb) = w; })
        }
    }
};

__device__ __forceinline__ void p2_norms(const Ctx& C, const Args& a) {
    unsigned char* ws = a.ws;
    const int gw = C.wg * NWAVES + C.wave, NGW = C.G * NWAVES, lane = C.lane;
    const float* RAW = (const float*)(ws + WS_RAW);
    for (int t = gw; t < S_; t += NGW) {
        const float* r = RAW + (size_t)t * 1024;
        { const f32x4 v0 = *(const f32x4*)(r + 4 * lane), v1 = *(const f32x4*)(r + 256 + 4 * lane);
          const float ss = wave_sum((v0.x * v0.x + v0.y * v0.y) + (v0.z * v0.z + v0.w * v0.w) + (v1.x * v1.x + v1.y * v1.y) + (v1.z * v1.z + v1.w * v1.w));
          const float rs = rsqrtf(ss * (1.f / QR) + EPS);
          const f32x4 w0 = *(const f32x4*)(a.q_norm_w + 4 * lane), w1 = *(const f32x4*)(a.q_norm_w + 256 + 4 * lane);
          bf16* o = (bf16*)(ws + WS_CQN) + (size_t)t * QR;
          u32x2 p0, p1; p0.x = pk2(v0.x * rs * w0.x, v0.y * rs * w0.y); p0.y = pk2(v0.z * rs * w0.z, v0.w * rs * w0.w); p1.x = pk2(v1.x * rs * w1.x, v1.y * rs * w1.y); p1.y = pk2(v1.z * rs * w1.z, v1.w * rs * w1.w);
          *(u32x2*)(o + 4 * lane) = p0; *(u32x2*)(o + 256 + 4 * lane) = p1; }
        { const f32x4 v0 = *(const f32x4*)(r + 512 + 4 * lane);
          const float ss = wave_sum((v0.x * v0.x + v0.y * v0.y) + (v0.z * v0.z + v0.w * v0.w));
          const float rs = rsqrtf(ss * (1.f / KVR) + EPS);
          const f32x4 w0 = *(const f32x4*)(a.kv_norm_w + 4 * lane);
          u32x2 p0; p0.x = pk2(v0.x * rs * w0.x, v0.y * rs * w0.y); p0.y = pk2(v0.z * rs * w0.z, v0.w * rs * w0.w);
          *(u32x2*)((bf16*)(ws + WS_CKVN) + (size_t)t * KVR + 4 * lane) = p0; }
        { const f32x2 v = *(const f32x2*)(r + 768 + 2 * lane);
          const float mu = wave_sum(v.x + v.y) * (1.f / IDXD); const float d0 = v.x - mu, d1 = v.y - mu;
          const float var = wave_sum(d0 * d0 + d1 * d1) * (1.f / IDXD); const float rs = rsqrtf(var + EPS);
          const f32x2 w = *(const f32x2*)(a.kidx_norm_w + 2 * lane), b = *(const f32x2*)(a.kidx_norm_b + 2 * lane);
          *(unsigned*)((bf16*)(ws + WS_KIDX) + (size_t)t * IDXD + 2 * lane) = pk2(d0 * rs * w.x + b.x, d1 * rs * w.y + b.y); }
        if (lane < IDXH) ((float*)(ws + WS_WIDX))[(size_t)t * IDXH + lane] = r[896 + lane] * 0.02209708691207961f;
    }
}
constexpr int R64 = 144, R128 = 272;
__device__ __forceinline__ void p2_hgrn_states(const Ctx& C, const Args& a, float* UT) {
    unsigned char* ws = a.ws;
    const float* G = (const float*)(ws + WS_G); const bf16* VA = (const bf16*)(ws + WS_VA); float* DL = (float*)(ws + WS_DLAST);
    LAS unsigned char* kdT = C.lds;
    LAS unsigned char* vT = C.lds + 128 * R64;
    LAS float* segtot = (LAS float*)(C.lds + 2 * 128 * R64);
    const int tid = C.tid, lane = C.lane, w = C.wave;
    for (int it = C.wg; it < NCH * BH; it += C.G) {
        const int c = it >> 3, h = it & 7;
        const int k = tid & 127, seg = tid >> 7, t0 = c * CHUNK + seg * 16;
        float g[16], cum[16]; float run = 0.f;
#pragma unroll
        for (int i = 0; i < 16; ++i) { g[i] = G[(size_t)(t0 + i) * AW + h * 128 + k]; run += g[i]; cum[i] = run; }
        segtot[seg * 128 + k] = run;
        unsigned short vv[16];
#pragma unroll
        for (int i = 0; i < 16; ++i) vv[i] = VA[(size_t)(t0 + i) * AW + h * 128 + k];
        __syncthreads();
        float pre = 0.f, last = 0.f;
#pragma unroll
        for (int s2 = 0; s2 < 4; ++s2) { const float st = segtot[s2 * 128 + k]; if (s2 < seg) pre += st; last += st; }
        unsigned kd[8], vp[8];
#pragma unroll
        for (int i = 0; i < 8; ++i) {
            const float c0 = cum[2 * i] + pre, c1 = cum[2 * i + 1] + pre;
            const float k0 = -expm1f(g[2 * i]) * __expf(last - c0), k1 = -expm1f(g[2 * i + 1]) * __expf(last - c1);
            kd[i] = pk2(k0, k1); vp[i] = (unsigned)vv[2 * i] | ((unsigned)vv[2 * i + 1] << 16);
        }
        *(LAS u32x4*)(kdT + k * R64 + seg * 32) = (u32x4){kd[0], kd[1], kd[2], kd[3]}; *(LAS u32x4*)(kdT + k * R64 + seg * 32 + 16) = (u32x4){kd[4], kd[5], kd[6], kd[7]};
        *(LAS u32x4*)(vT + k * R64 + seg * 32) = (u32x4){vp[0], vp[1], vp[2], vp[3]}; *(LAS u32x4*)(vT + k * R64 + seg * 32 + 16) = (u32x4){vp[4], vp[5], vp[6], vp[7]};
        if (seg == 0) DL[(size_t)it * 128 + k] = __expf(last);
        __syncthreads();
        f32x4 acc[2][4];
#pragma unroll
        for (int mi = 0; mi < 2; ++mi)
#pragma unroll
            for (int ni = 0; ni < 4; ++ni) acc[mi][ni] = (f32x4){0.f, 0.f, 0.f, 0.f};
        const int fr = lane & 15, fq = lane >> 4;
#pragma unroll
        for (int ks = 0; ks < 2; ++ks) {
            bf16x8 af[2], bfr[4];
#pragma unroll
            for (int mi = 0; mi < 2; ++mi) af[mi] = *(const LAS bf16x8*)(vT + (32 * (w >> 1) + 16 * mi + fr) * R64 + (32 * ks + 8 * fq) * 2);
#pragma unroll
            for (int ni = 0; ni < 4; ++ni) bfr[ni] = *(const LAS bf16x8*)(kdT + (64 * (w & 1) + 16 * ni + fr) * R64 + (32 * ks + 8 * fq) * 2);
#pragma unroll
            for (int mi = 0; mi < 2; ++mi)
#pragma unroll
                for (int ni = 0; ni < 4; ++ni) acc[mi][ni] = __builtin_amdgcn_mfma_f32_16x16x32_bf16(af[mi], bfr[ni], acc[mi][ni], 0, 0, 0);
        }
        float* U = UT + (size_t)it * 16384;
#pragma unroll
        for (int mi = 0; mi < 2; ++mi)
#pragma unroll
            for (int ni = 0; ni < 4; ++ni)
#pragma unroll
                for (int r = 0; r < 4; ++r) U[(32 * (w >> 1) + 16 * mi + 4 * fq + r) * 128 + 64 * (w & 1) + 16 * ni + fr] = acc[mi][ni][r];
        __syncthreads();
    }
}

struct EpiQ {
    unsigned char* ws;
    __device__ __forceinline__ void operator()(f32x4 (&acc)[2][2][4][2], const pg8::Unit& u, int wr, int wc, int fr, int fq) const {
        bf16* O = (bf16*)(ws + (u.pn < 8 ? WS_QABS : WS_RAW)); const int cb = u.pn < 8 ? 0 : 2048;
        EPI_FOREACH({ u32x4 w; w.x = pk2(v0[0], v0[1]); w.y = pk2(v0[2], v0[3]); w.z = pk2(v1[0], v1[1]); w.w = pk2(v1[2], v1[3]); *(u32x4*)(O + (size_t)row * 2048 + col - cb) = w; })
    }
};
__device__ __forceinline__ void p3_scan(const Ctx& C, const Args& a, const float* UT) {
    unsigned char* ws = a.ws;
    const float* DL = (const float*)(ws + WS_DLAST); bf16* SPT = (bf16*)(ws + WS_SPT);
    for (int e = C.wg * NTHR + C.tid; e < BH * 128 * 128; e += C.G * NTHR) {
        const int h = e >> 14, k = e & 127;
        float Sv = 0.f;
        for (int c0 = 0; c0 < NCH; c0 += 16) {
            float u[16], d[16];
#pragma unroll
            for (int j = 0; j < 16; ++j) { u[j] = UT[(size_t)(c0 + j) * (BH * 16384) + e]; d[j] = DL[(size_t)((c0 + j) * BH + h) * 128 + k]; }
#pragma unroll
            for (int j = 0; j < 16; ++j) { SPT[(size_t)(c0 + j) * (BH * 16384) + e] = (bf16)f2bf(Sv); Sv = d[j] * Sv + u[j]; }
        }
    }
}

__device__ __forceinline__ int t5_bucket(int rel) {
    const int n = rel < 0 ? -rel : rel; int b = rel > 0 ? 16 : 0;
    const int large = n < 12 ? 8 : n < 16 ? 9 : n < 23 ? 10 : n < 32 ? 11 : n < 46 ? 12 : n < 64 ? 13 : n < 91 ? 14 : 15;
    return b + (n < 8 ? n : large);
}
__device__ __forceinline__ int swz_sigma(int r) { return ((r & 3) << 1) | ((((r >> 3) ^ (r >> 2)) & 1) << 3) | ((r >> 2) & 1); }
__device__ __forceinline__ int lat_off(int row, int c) { return row * 512 + ((((c & 15) ^ swz_sigma(row & 15)) | (c & 16)) << 4); }
constexpr int AT_SIDX = 131072, AT_BIAS = 139264;
__device__ __forceinline__ void attn_setup(const Ctx& C, const Args& a) {
    LAS float* bias2 = (LAS float*)(C.lds + AT_BIAS);
    for (int e = C.tid; e < 2 * 92 * 8; e += NTHR) { const int sg = e / (92 * 8), nn = (e / 8) % 92, h = e & 7; bias2[e] = a.rel_bias[t5_bucket(sg ? nn : -nn) * BH + h]; }
    __syncthreads();
}
__device__ __forceinline__ void attn_one(const Ctx& C, const Args& a, const int t, const int n) {
    unsigned char* ws = a.ws;
    const bf16* QABS = (const bf16*)(ws + WS_QABS); const char* CKVNb = (const char*)(ws + WS_CKVN);
    bf16* OL = (bf16*)(ws + WS_RAW);
    const int lane = C.lane, w = C.wave, fr = lane & 15, fq = lane >> 4;
    LAS unsigned char* L = C.lds + w * 16384;
    const LAS int* sidx = (const LAS int*)(C.lds + AT_SIDX) + w * 256;
    const LAS float* bias2 = (const LAS float*)(C.lds + AT_BIAS);
    const int q4 = fr >> 2, p4 = fr & 3;
    unsigned aqk[4], apv[8];
    { const int s = swz_sigma(fr); const unsigned b0 = (unsigned)(fr * 512 + 16 * (fq ^ (s & 3))) | (unsigned)(64 * (s >> 2));
#pragma unroll
      for (int k = 0; k < 4; ++k) aqk[k] = (unsigned)(size_t)L + (b0 ^ (unsigned)(64 * k)); }
    { const int rr = 4 * fq + q4, s = swz_sigma(rr & 15); const unsigned b0 = (unsigned)(rr * 512 + 16 * ((p4 >> 1) ^ (s & 1)) + 8 * (p4 & 1)) | (unsigned)(32 * (s >> 1));
#pragma unroll
      for (int k = 0; k < 8; ++k) apv[k] = (unsigned)(size_t)L + (b0 ^ (unsigned)(32 * k)); }
    unsigned c16[16];
#pragma unroll
    for (int i = 0; i < 16; ++i) { const int row = 2 * i + (lane >> 5), pos = lane & 31; c16[i] = (unsigned)(((pos & 16) | ((pos & 15) ^ swz_sigma(row & 15))) << 4); }
    {
        bf16x8 qf[8];
#pragma unroll
        for (int ks = 0; ks < 8; ++ks) { if (fr < BH) qf[ks] = *(const bf16x8*)(QABS + (size_t)t * 2048 + fr * 256 + 32 * ks + 8 * fq); else qf[ks] = (bf16x8){0, 0, 0, 0, 0, 0, 0, 0}; }
        f32x4 oa[16];
#pragma unroll
        for (int i = 0; i < 16; ++i) oa[i] = (f32x4){0.f, 0.f, 0.f, 0.f};
        float m_run = -INFINITY, l_run = 0.f;
        LDS_WAIT();
        for (int ch = 0; ch * 32 < n; ++ch) {
#pragma unroll
            for (int i = 0; i < 16; ++i) { const int sj = sidx[32 * ch + 2 * i + (lane >> 5)];
                __builtin_amdgcn_global_load_lds((const unsigned*)(CKVNb + (unsigned)(sj * 512 + (int)c16[i])), (LAS unsigned*)(L + i * 1024), 16, 0, 0); }
            const u32x4 s0 = *(const LAS u32x4*)(sidx + 32 * ch + 4 * fq), s1 = *(const LAS u32x4*)(sidx + 32 * ch + 16 + 4 * fq);
            float bv[2][4];
#pragma unroll
            for (int T = 0; T < 2; ++T)
#pragma unroll
                for (int r = 0; r < 4; ++r) { const int rel = (int)(T ? s1[r] : s0[r]) - t; const int nn = rel < 0 ? -rel : rel; bv[T][r] = bias2[((rel > 0 ? 92 : 0) + (nn < 91 ? nn : 91)) * 8 + (fr & 7)]; }
            VM_WAIT();
            f32x4 lg[2] = {{0.f, 0.f, 0.f, 0.f}, {0.f, 0.f, 0.f, 0.f}};
#pragma unroll
            for (int ks = 0; ks < 8; ++ks)
#pragma unroll
                for (int T = 0; T < 2; ++T) { const bf16x8 kf = *(const LAS bf16x8*)(size_t)(aqk[ks & 3] + 256 * (ks >> 2) + 8192 * T);
                    lg[T] = __builtin_amdgcn_mfma_f32_16x16x32_bf16(kf, qf[ks], lg[T], 0, 0, 0); }
            float mx = -INFINITY;
#pragma unroll
            for (int T = 0; T < 2; ++T)
#pragma unroll
                for (int r = 0; r < 4; ++r) { const int j = 32 * ch + 16 * T + 4 * fq + r; float v = lg[T][r] + bv[T][r];
                    v = (j < n) ? v : -INFINITY; lg[T][r] = v; mx = fmaxf(mx, v); }
            mx = fmaxf(mx, __shfl_xor(mx, 16)); mx = fmaxf(mx, __shfl_xor(mx, 32));
            const float m_new = fmaxf(m_run, mx), scale = __expf(m_run - m_new);
            float sm = 0.f;
#pragma unroll
            for (int T = 0; T < 2; ++T)
#pragma unroll
                for (int r = 0; r < 4; ++r) { const float p = __expf(lg[T][r] - m_new); lg[T][r] = p; sm += p; }
            sm += __shfl_xor(sm, 16); sm += __shfl_xor(sm, 32);
            l_run = l_run * scale + sm; m_run = m_new;
            bf16x8 pf; { const unsigned w0 = pk2(lg[0][0], lg[0][1]), w1 = pk2(lg[0][2], lg[0][3]), w2 = pk2(lg[1][0], lg[1][1]), w3 = pk2(lg[1][2], lg[1][3]);
                pf = __builtin_bit_cast(bf16x8, (u32x4){w0, w1, w2, w3}); }
            if (__any(scale != 1.f)) {
#pragma unroll
                for (int ct = 0; ct < 16; ++ct) oa[ct] *= scale; }
#pragma unroll
            for (int ct = 0; ct < 16; ++ct) {
                const s16x4 lo = __builtin_bit_cast(s16x4, __builtin_amdgcn_ds_read_tr16_b64_v4i16((LAS s16x4*)(size_t)(apv[ct & 7] + 256 * (ct >> 3))));
                const s16x4 hi = __builtin_bit_cast(s16x4, __builtin_amdgcn_ds_read_tr16_b64_v4i16((LAS s16x4*)(size_t)(apv[ct & 7] + 256 * (ct >> 3) + 8192)));
                const bf16x8 cf = {lo[0], lo[1], lo[2], lo[3], hi[0], hi[1], hi[2], hi[3]};
                oa[ct] = __builtin_amdgcn_mfma_f32_16x16x32_bf16(cf, pf, oa[ct], 0, 0, 0);
            }
            LDS_WAIT();
        }
        if (fr < BH) { const float inv = __builtin_amdgcn_rcpf(l_run); bf16* o = OL + (size_t)t * 2048 + fr * 256 + 4 * fq;
#pragma unroll
            for (int ct = 0; ct < 16; ++ct) { u32x2 pw; pw.x = pk2(oa[ct][0] * inv, oa[ct][1] * inv); pw.y = pk2(oa[ct][2] * inv, oa[ct][3] * inv); *(u32x2*)(o + 16 * ct) = pw; } }
    }
}

__device__ __forceinline__ unsigned fkey(float f) { const unsigned u = __builtin_bit_cast(unsigned, f); return (u & 0x80000000u) ? ~u : (u | 0x80000000u); }
__device__ __forceinline__ void lds_add_u32(LAS unsigned* p, unsigned v) { asm volatile("ds_add_u32 %0, %1" :: "v"((unsigned)(size_t)p), "v"(v) : "memory"); }
constexpr int IX_KBUF = 65536, IX_CAP = 512;
__device__ __noinline__ void select_slow(const float* sc, int nvis, LAS int* idxrow, LAS unsigned* hist, int lane) {
    unsigned prefix = 0u; int need = TOPK;
#pragma unroll 1
    for (int pass = 0; pass < 4; ++pass) {
        const int shift = 24 - 8 * pass;
#pragma unroll
        for (int j = 0; j < 4; ++j) hist[lane * 4 + j] = 0u;
        LDS_WAIT();
        const unsigned himask = pass == 0 ? 0u : (0xffffffffu << (shift + 8));
        for (int i = lane; i < nvis; i += 64) { const unsigned kk = fkey(sc[i]); if ((kk & himask) == (prefix & himask)) __hip_atomic_fetch_add(&hist[(kk >> shift) & 255u], 1u, __ATOMIC_RELAXED, __HIP_MEMORY_SCOPE_WORKGROUP); }
        LDS_WAIT();
        unsigned cnt[4]; unsigned tl = 0u;
#pragma unroll
        for (int j = 0; j < 4; ++j) { cnt[j] = hist[lane * 4 + j]; tl += cnt[j]; }
        unsigned incl = tl;
#pragma unroll
        for (int o = 1; o < 64; o <<= 1) { const unsigned v = __shfl_down(incl, o); if (lane + o < 64) incl += v; }
        unsigned above = incl - tl;
        int dsel = -1; unsigned asel = 0u;
#pragma unroll
        for (int j = 3; j >= 0; --j) { if (dsel < 0 && above < (unsigned)need && above + cnt[j] >= (unsigned)need) { dsel = lane * 4 + j; asel = above; } above += cnt[j]; }
        const unsigned long long bal = __ballot(dsel >= 0);
        const int src = __ffsll((long long)bal) - 1;
        const int d = __shfl(dsel, src); const unsigned ab = __shfl(asel, src);
        need -= (int)ab; prefix |= ((unsigned)d) << shift;
    }
    int base = 0, eqseen = 0;
    for (int i0 = 0; i0 < nvis; i0 += 64) {
        const int i = i0 + lane; const unsigned kk = fkey(sc[i]);
        const bool gt = kk > prefix, eq = kk == prefix;
        const unsigned long long beq = __ballot(eq);
        const unsigned long long lt_mask = (1ull << lane) - 1ull;
        const int eqrank = eqseen + __popcll(beq & lt_mask);
        const bool sel = gt || (eq && eqrank < need);
        const unsigned long long bs = __ballot(sel);
        if (sel) idxrow[base + __popcll(bs & lt_mask)] = i;
        base += __popcll(bs); eqseen += __popcll(beq);
    }
}
__device__ __forceinline__ void p4_indexer(const Ctx& C, const Args& a, float* SCall, unsigned* qc, volatile LAS unsigned* MISC, int& cur) {
    unsigned char* ws = a.ws;
    const bf16* QIDX = (const bf16*)(ws + WS_RAW); const char* KIDXb = (const char*)(ws + WS_KIDX); const float* WIDX = (const float*)(ws + WS_WIDX);
    LAS int* sidx = (LAS int*)(C.lds + AT_SIDX) + C.wave * 256;
    float* SC = SCall + (size_t)C.wg * (8 * 8192);
    LAS unsigned* HIST = (LAS unsigned*)C.lds;
    LAS unsigned char* KBUF = C.lds + IX_KBUF;
    const int tid = C.tid, lane = C.lane, w = C.wave, quad = w & 1, kg = w >> 1, r16 = lane & 15, kq = lane >> 4;
    while (cur < 1024) {
        const int tile = 1023 - cur;
        const int q0 = tile * 8, nvis = ((q0 >> 6) + 1) * CHUNK;
        if (nvis <= TOPK) {
            for (int j = lane; j < TOPK; j += 64) sidx[j] = j < nvis ? j : 0;
            LDS_WAIT(); __syncthreads();
            unsigned nxt = 0u; if (tid == 0) nxt = xb_add(qc, 1u);
            attn_one(C, a, q0 + w, nvis);
            if (tid == 0) MISC[MISC_Q4] = nxt;
            LDS_WAIT(); __syncthreads();
            cur = __builtin_amdgcn_readfirstlane((int)MISC[MISC_Q4]);
            continue;
        }
        for (int i = tid; i < 8 * 2048; i += NTHR) HIST[i] = 0u;
        bf16x8 af[4][4];
#pragma unroll
        for (int j = 0; j < 4; ++j) {
            const bf16* qp = QIDX + (size_t)(q0 + 4 * quad + j) * 2048 + r16 * 128 + 8 * kq;
#pragma unroll
            for (int ks = 0; ks < 4; ++ks) af[j][ks] = *(const bf16x8*)(qp + 32 * ks);
        }
        u32x4 wA[2][2];
        { const int grp = r16 >> 2, mem = r16 & 3;
          const f32x4 wv = mem < 2 ? *(const f32x4*)(WIDX + (size_t)(q0 + 4 * quad + 2 * (grp & 1) + mem) * IDXH + 4 * kq) : (f32x4){0.f, 0.f, 0.f, 0.f};
          const unsigned w01 = pk2(wv[0], wv[1]), w23 = pk2(wv[2], wv[3]);
#pragma unroll
          for (int p = 0; p < 2; ++p)
#pragma unroll
              for (int T = 0; T < 2; ++T) { const bool on = (grp == 2 * T + p) && mem < 2;
                  wA[p][T] = (u32x4){(on && mem == 0) ? w01 : 0u, (on && mem == 0) ? w23 : 0u, (on && mem == 1) ? w01 : 0u, (on && mem == 1) ? w23 : 0u}; } }
        const int ntile = nvis >> 5, nstep = (ntile + 3) >> 2;
        const unsigned soffA = (unsigned)((16 * quad + (lane >> 4)) * 256 + (((lane & 15) ^ (lane >> 4)) << 4));
#define IX_STAGE(step_, buf_) do { const int kt_ = 4 * (step_) + kg; if (kt_ < ntile) { const char* sb_ = KIDXb + (size_t)kt_ * 8192; unsigned so_ = soffA; asm volatile("" : "+v"(so_));   \
            _Pragma("unroll") for (int i_ = 0; i_ < 4; ++i_) { \
            __builtin_amdgcn_global_load_lds((const unsigned*)(sb_ + ((so_ ^ (unsigned)(64 * i_)) + (unsigned)(1024 * i_))), (LAS unsigned*)(KBUF + (buf_) * 32768 + kg * 8192 + (4 * quad + i_) * 1024), 16, 0, 0); } } } while (0)
        const unsigned flane = (unsigned)((4 * quad + 2 * (kq & 1)) * 8192 + 16 * (kq >> 1) + r16);
        LAS unsigned* const hlane = HIST + (4 * quad + 2 * (kq & 1)) * 2048;
#define IX_FLUSH(yv, kt_) do { if ((kt_) < ntile) { _Pragma("unroll") for (int j = 0; j < 2; ++j) { float* scb_ = SC + (size_t)((kt_) * 32 + j * 8192); scb_[flane] = yv[j]; \
            const unsigned bin = fkey(yv[j]) >> 20; lds_add_u32(hlane + j * 2048 + (bin >> 1), 1u << (16 * (bin & 1u))); } } } while (0)
        IX_STAGE(0, 0);
        VM_WAIT(); LDS_WAIT(); __builtin_amdgcn_s_barrier();
        float yp[2] = {0.f, 0.f};
        for (int step = 0; step < nstep; ++step) {
            if (step > 0) IX_FLUSH(yp, 4 * (step - 1) + kg);
            if (step + 1 < nstep) IX_STAGE(step + 1, (step + 1) & 1);
            const unsigned tb = (unsigned)(size_t)(KBUF + (step & 1) * 32768 + kg * 8192) + (unsigned)(r16 * 256 + ((kq ^ r16) << 4));
            bf16x8 bfr[2][4];
#pragma unroll
            for (int T = 0; T < 2; ++T)
#pragma unroll
                for (int ks = 0; ks < 4; ++ks) bfr[T][ks] = *(const LAS bf16x8*)(size_t)((tb ^ (unsigned)(64 * ks)) + 4096 * T);
            f32x4 acc[4][2];
#pragma unroll
            for (int j = 0; j < 4; ++j)
#pragma unroll
                for (int T = 0; T < 2; ++T) acc[j][T] = (f32x4){0.f, 0.f, 0.f, 0.f};
#pragma unroll
            for (int ks = 0; ks < 4; ++ks)
#pragma unroll
                for (int j = 0; j < 4; ++j)
#pragma unroll
                    for (int T = 0; T < 2; ++T) acc[j][T] = __builtin_amdgcn_mfma_f32_16x16x32_bf16(af[j][ks], bfr[T][ks], acc[j][T], 0, 0, 0);
            f32x4 y = {0.f, 0.f, 0.f, 0.f};
#pragma unroll
            for (int p = 0; p < 2; ++p)
#pragma unroll
                for (int T = 0; T < 2; ++T) { const f32x4 xa = acc[2 * p][T], xb = acc[2 * p + 1][T];
                    const u32x4 fr4 = {pk2_relu(xa.x, xa.y), pk2_relu(xa.z, xa.w), pk2_relu(xb.x, xb.y), pk2_relu(xb.z, xb.w)};
                    y = __builtin_amdgcn_mfma_f32_16x16x32_bf16(__builtin_bit_cast(bf16x8, wA[p][T]), __builtin_bit_cast(bf16x8, fr4), y, 0, 0, 0); }
            yp[0] = y.x; yp[1] = y.y;
            VM_WAIT(); LDS_WAIT(); __builtin_amdgcn_s_barrier();
        }
        IX_FLUSH(yp, 4 * (nstep - 1) + kg);
        VM_WAIT(); LDS_WAIT();
        __builtin_amdgcn_s_barrier();
#undef IX_STAGE
#undef IX_FLUSH
        for (int rep_q = 0; rep_q < (PROBE_REP == 42 ? 2 : 1); ++rep_q)
        {
            const float* sc = SC + (size_t)w * 8192; LAS int* idxrow = sidx; const unsigned long long lt_mask = (1ull << lane) - 1ull;
            LAS unsigned* hq = HIST + w * 2048;
            unsigned tl = 0u;
#pragma unroll 8
            for (int i = 0; i < 32; ++i) { const unsigned v = hq[lane * 32 + ((i + lane) & 31)]; tl += (v & 0xffffu) + (v >> 16); }
            unsigned incl = tl;
#pragma unroll
            for (int o = 1; o < 64; o <<= 1) { const unsigned v = __shfl_down(incl, o); if (lane + o < 64) incl += v; }
            const unsigned above_l = incl - tl;
            const unsigned long long own = __ballot(above_l < (unsigned)TOPK && above_l + tl >= (unsigned)TOPK);
            const int lo = __ffsll((long long)own) - 1;
            const unsigned above_o = __shfl(above_l, lo);
            const unsigned vw = hq[lo * 32 + (lane >> 1)]; const unsigned cb = (lane & 1) ? (vw >> 16) : (vw & 0xffffu);
            unsigned incl2 = cb;
#pragma unroll
            for (int o = 1; o < 64; o <<= 1) { const unsigned v = __shfl_down(incl2, o); if (lane + o < 64) incl2 += v; }
            const unsigned above_b = above_o + incl2 - cb;
            const unsigned long long ownb = __ballot(above_b < (unsigned)TOPK && above_b + cb >= (unsigned)TOPK);
            const int lb = __ffsll((long long)ownb) - 1;
            const int b1 = lo * 64 + lb; const unsigned ab1 = __shfl(above_b, lb), cn1 = __shfl(cb, lb);
            if (cn1 > (unsigned)IX_CAP) { __builtin_amdgcn_fence(__ATOMIC_ACQUIRE, "agent"); VM_WAIT(); select_slow(sc, nvis, idxrow, hq, lane); }
            else {
                LAS unsigned* cand = (LAS unsigned*)KBUF + w * (2 * IX_CAP);
                const auto scrs = __builtin_amdgcn_make_buffer_rsrc((void*)sc, 0, 8192 * 4, 0x00020000);
                const unsigned klo = (unsigned)b1 << 20, khi = klo + (1u << 20);
                int selbase = 0, cbase = 0;
                for (int i0 = 0; i0 < nvis; i0 += 2048) {
                    f32x4 v[8];
#pragma unroll
                    for (int j = 0; j < 8; ++j) v[j] = __builtin_bit_cast(f32x4, __builtin_amdgcn_raw_buffer_load_b128(scrs, (unsigned)(((i0 + j * 256 + 4 * lane) & 8191) * 4), 0, 16));
#pragma unroll
                    for (int j = 0; j < 8; ++j) { const int e0 = i0 + j * 256 + 4 * lane; const bool valid = e0 < nvis;
#pragma unroll
                        for (int e = 0; e < 4; ++e) { const unsigned kk = fkey(v[j][e]);
                            const bool ge = valid && kk >= klo; const bool sel = ge && (b1 < 4095) && kk >= khi, cd = ge && !sel;
                            const unsigned long long bs = __ballot(sel), bc = __ballot(cd);
                            if (sel) idxrow[selbase + __popcll(bs & lt_mask)] = e0 + e;
                            if (cd) { const int pos = cbase + __popcll(bc & lt_mask); cand[2 * pos] = kk; cand[2 * pos + 1] = (unsigned)(e0 + e); }
                            selbase += __popcll(bs); cbase += __popcll(bc); } }
                }
                LDS_WAIT();
                const int nc = (int)cn1; int need = TOPK - (int)ab1;
                LAS unsigned* h2 = hq;
                unsigned prefix = klo;
#pragma unroll 1
                for (int pass = 0; pass < 3; ++pass) {
                    const int shift = pass == 0 ? 12 : pass == 1 ? 4 : 0; const unsigned dmask = pass == 2 ? 15u : 255u; const unsigned himask = 0xffffffffu << (pass == 0 ? 20 : pass == 1 ? 12 : 4);
#pragma unroll
                    for (int j = 0; j < 4; ++j) h2[lane * 4 + j] = 0u;
                    LDS_WAIT();
                    for (int i = lane; i < nc; i += 64) { const unsigned kk = cand[2 * i]; if ((kk & himask) == (prefix & himask)) __hip_atomic_fetch_add(&h2[(kk >> shift) & dmask], 1u, __ATOMIC_RELAXED, __HIP_MEMORY_SCOPE_WORKGROUP); }
                    LDS_WAIT();
                    unsigned cnt[4]; unsigned tl2 = 0u;
#pragma unroll
                    for (int j = 0; j < 4; ++j) { cnt[j] = h2[lane * 4 + j]; tl2 += cnt[j]; }
                    unsigned inc3 = tl2;
#pragma unroll
                    for (int o = 1; o < 64; o <<= 1) { const unsigned v2 = __shfl_down(inc3, o); if (lane + o < 64) inc3 += v2; }
                    unsigned above = inc3 - tl2; int dsel = -1; unsigned asel = 0u;
#pragma unroll
                    for (int j = 3; j >= 0; --j) { if (dsel < 0 && above < (unsigned)need && above + cnt[j] >= (unsigned)need) { dsel = lane * 4 + j; asel = above; } above += cnt[j]; }
                    const unsigned long long bal = __ballot(dsel >= 0); const int src = __ffsll((long long)bal) - 1;
                    const int d = __shfl(dsel, src); const unsigned ab = __shfl(asel, src);
                    need -= (int)ab; prefix |= ((unsigned)d) << shift;
                }
                int eqseen = 0;
                for (int i0 = 0; i0 < nc; i0 += 64) {
                    const int i = i0 + lane; const bool vi = i < nc; const unsigned kk = vi ? cand[2 * i] : 0u;
                    const bool gt = vi && kk > prefix, eq = vi && kk == prefix;
                    const unsigned long long beq = __ballot(eq);
                    const int eqrank = eqseen + __popcll(beq & lt_mask);
                    const bool sel = gt || (eq && eqrank < need);
                    const unsigned long long bs = __ballot(sel);
                    if (sel) idxrow[selbase + __popcll(bs & lt_mask)] = (int)cand[2 * i + 1];
                    selbase += __popcll(bs); eqseen += __popcll(beq);
                }
            }
        }
        VM_WAIT(); LDS_WAIT(); __syncthreads();
        unsigned nxt = 0u; if (tid == 0) nxt = xb_add(qc, 1u);
        attn_one(C, a, q0 + w, TOPK);
        if (tid == 0) MISC[MISC_Q4] = nxt;
        LDS_WAIT(); __syncthreads();
        cur = __builtin_amdgcn_readfirstlane((int)MISC[MISC_Q4]);
    }
}

__device__ __forceinline__ void p4_hgrn_out(const Ctx& C, const Args& a, unsigned* qc, volatile LAS unsigned* MISC, int& cur) {
    unsigned char* ws = a.ws;
    const float* G = (const float*)(ws + WS_G); bf16* QA = (bf16*)(ws + WS_QA); const bf16* VA = (const bf16*)(ws + WS_VA); const bf16* GA = (const bf16*)(ws + WS_GA);
    const bf16* SPT = (const bf16*)(ws + WS_SPT);
    LAS unsigned char* QI = C.lds;
    LAS unsigned char* QM = QI + 64 * R128;
    LAS unsigned char* KM = QM + 64 * R128;
    LAS unsigned char* vT = KM + 64 * R128;
    LAS unsigned char* SCb = vT + 128 * R64;
    LAS float* segtot = (LAS float*)(SCb + 64 * R64);
    LAS float* rsp = segtot + 8 * 128;
    const int tid = C.tid, lane = C.lane, w = C.wave, fr = lane & 15, fq = lane >> 4;
    while (cur < 1024 + NCH * BH) {
        const int it = cur - 1024;
        unsigned nxt = 0u; if (tid == 0) nxt = xb_add(qc, 1u);
        const int c = it >> 3, h = it & 7;
        bf16x8 sfr[4][4];
        { const bf16* sp0 = SPT + (size_t)it * 16384 + (size_t)(64 * (w & 1) + fr) * 128 + 8 * fq;
#pragma unroll
          for (int ks = 0; ks < 4; ++ks)
#pragma unroll
              for (int ni = 0; ni < 4; ++ni) sfr[ks][ni] = *(const bf16x8*)(sp0 + (size_t)(16 * ni) * 128 + 32 * ks); }
        unsigned short gav[4][4];
#pragma unroll
        for (int r = 0; r < 4; ++r)
#pragma unroll
            for (int ni = 0; ni < 4; ++ni) gav[r][ni] = GA[(size_t)(c * CHUNK + 16 * (w >> 1) + 4 * fq + r) * AW + h * 128 + 64 * (w & 1) + 16 * ni + fr];
        {
            const int k2 = tid & 63, seg = tid >> 6, t0 = c * CHUNK + seg * 8;
            f32x2 g[8], cum[8]; f32x2 run = {0.f, 0.f};
#pragma unroll
            for (int i = 0; i < 8; ++i) { g[i] = *(const f32x2*)(G + (size_t)(t0 + i) * AW + h * 128 + 2 * k2); run += g[i]; cum[i] = run; }
            unsigned qv[8];
#pragma unroll
            for (int i = 0; i < 8; ++i) qv[i] = *(const unsigned*)(QA + (size_t)(t0 + i) * AW + h * 128 + 2 * k2);
            segtot[seg * 128 + 2 * k2] = run.x; segtot[seg * 128 + 2 * k2 + 1] = run.y;
            { const int v = tid & 127, sg = tid >> 7, tv = c * CHUNK + sg * 16; unsigned vp[8];
#pragma unroll
              for (int i = 0; i < 8; ++i) vp[i] = (unsigned)VA[(size_t)(tv + 2 * i) * AW + h * 128 + v] | ((unsigned)VA[(size_t)(tv + 2 * i + 1) * AW + h * 128 + v] << 16);
              *(LAS u32x4*)(vT + v * R64 + sg * 32) = (u32x4){vp[0], vp[1], vp[2], vp[3]}; *(LAS u32x4*)(vT + v * R64 + sg * 32 + 16) = (u32x4){vp[4], vp[5], vp[6], vp[7]}; }
            __syncthreads();
            f32x2 pre = {0.f, 0.f}, cmid = {0.f, 0.f};
#pragma unroll
            for (int s2 = 0; s2 < 8; ++s2) { const f32x2 st = {segtot[s2 * 128 + 2 * k2], segtot[s2 * 128 + 2 * k2 + 1]}; if (s2 < seg) pre += st; if (s2 < 4) cmid += st; }
#pragma unroll
            for (int i = 0; i < 8; ++i) {
                const f32x2 cm = cum[i] + pre; const float q0 = bflo(qv[i]), q1 = bfhi(qv[i]);
                const int row = seg * 8 + i;
                *(LAS unsigned*)(QI + row * R128 + 4 * k2) = pk2(q0 * __expf(cm.x), q1 * __expf(cm.y));
                *(LAS unsigned*)(QM + row * R128 + 4 * k2) = pk2(q0 * __expf(cm.x - cmid.x), q1 * __expf(cm.y - cmid.y));
                *(LAS unsigned*)(KM + row * R128 + 4 * k2) = pk2(-expm1f(g[i].x) * __expf(cmid.x - cm.x), -expm1f(g[i].y) * __expf(cmid.y - cm.y));
            }
        }
        __syncthreads();
        const int tt = w >> 1;
        {
            f32x4 sa[2] = {{0.f, 0.f, 0.f, 0.f}, {0.f, 0.f, 0.f, 0.f}};
#pragma unroll
            for (int ks = 0; ks < 4; ++ks) {
                const bf16x8 qf = *(const LAS bf16x8*)(QM + (16 * tt + fr) * R128 + (32 * ks + 8 * fq) * 2);
#pragma unroll
                for (int si = 0; si < 2; ++si) { const bf16x8 kf = *(const LAS bf16x8*)(KM + (16 * (2 * (w & 1) + si) + fr) * R128 + (32 * ks + 8 * fq) * 2);
                    sa[si] = __builtin_amdgcn_mfma_f32_16x16x32_bf16(qf, kf, sa[si], 0, 0, 0); }
            }
#pragma unroll
            for (int si = 0; si < 2; ++si)
#pragma unroll
                for (int r = 0; r < 4; ++r) { const int t = 16 * tt + 4 * fq + r, s = 16 * (2 * (w & 1) + si) + fr;
                    *(LAS unsigned short*)(SCb + t * R64 + s * 2) = (unsigned short)f2bf(s <= t ? sa[si][r] : 0.f); }
        }
        __syncthreads();
        f32x4 acc[4];
#pragma unroll
        for (int ni = 0; ni < 4; ++ni) acc[ni] = (f32x4){0.f, 0.f, 0.f, 0.f};
        {
#pragma unroll
            for (int ks = 0; ks < 4; ++ks) {
                const bf16x8 qf = *(const LAS bf16x8*)(QI + (16 * tt + fr) * R128 + (32 * ks + 8 * fq) * 2);
#pragma unroll
                for (int ni = 0; ni < 4; ++ni) acc[ni] = __builtin_amdgcn_mfma_f32_16x16x32_bf16(qf, sfr[ks][ni], acc[ni], 0, 0, 0);
            }
#pragma unroll
            for (int ks = 0; ks < 2; ++ks) {
                const bf16x8 pf = *(const LAS bf16x8*)(SCb + (16 * tt + fr) * R64 + (32 * ks + 8 * fq) * 2);
#pragma unroll
                for (int ni = 0; ni < 4; ++ni) { const bf16x8 vf = *(const LAS bf16x8*)(vT + (64 * (w & 1) + 16 * ni + fr) * R64 + (32 * ks + 8 * fq) * 2);
                    acc[ni] = __builtin_amdgcn_mfma_f32_16x16x32_bf16(pf, vf, acc[ni], 0, 0, 0); }
            }
        }
        float ss[4];
#pragma unroll
        for (int r = 0; r < 4; ++r) { float s = 0.f;
#pragma unroll
            for (int ni = 0; ni < 4; ++ni) s += acc[ni][r] * acc[ni][r];
            s += __shfl_xor(s, 1); s += __shfl_xor(s, 2); s += __shfl_xor(s, 4); s += __shfl_xor(s, 8); ss[r] = s; }
        if (fr == 0) {
#pragma unroll
            for (int r = 0; r < 4; ++r) rsp[(16 * tt + 4 * fq + r) * 2 + (w & 1)] = ss[r]; }
        __syncthreads();
#pragma unroll
        for (int r = 0; r < 4; ++r) {
            const int tl = 16 * tt + 4 * fq + r; const float rstd = rsqrtf((rsp[tl * 2] + rsp[tl * 2 + 1]) * (1.f / 128.f) + EPS);
            const size_t rowoff = (size_t)(c * CHUNK + tl) * AW + h * 128;
#pragma unroll
            for (int ni = 0; ni < 4; ++ni) { const int v = 64 * (w & 1) + 16 * ni + fr;
                const unsigned short yv = (unsigned short)f2bf(acc[ni][r] * rstd * a.gnorm_a[v] * bf2f(gav[r][ni])); QA[rowoff + v] = yv; }
        }
        if (tid == 0) MISC[MISC_Q4] = nxt;
        LDS_WAIT(); __syncthreads();
        cur = __builtin_amdgcn_readfirstlane((int)MISC[MISC_Q4]);
    }
}

struct SchedUV {
    pg8::TileOrder T; const char* Ab; const char* Bb;
    __device__ __forceinline__ bool next(int i, pg8::Unit& u) const { u.sub = 0; return T.tile(i, u.pm, u.pn); }
    __device__ __forceinline__ const char* A(const pg8::Unit& u) const { return Ab + ((size_t)u.pm * 256 * 2048 + (size_t)u.pn * 512) * 2; }
    __device__ __forceinline__ const char* B(const pg8::Unit& u) const { return Bb + (size_t)u.pn * 256 * 512 * 2; }
    __device__ __forceinline__ bool keep(const pg8::Unit&) const { return false; }
};
struct EpiUV {
    unsigned char* ws;
    __device__ __forceinline__ void operator()(f32x4 (&acc)[2][2][4][2], const pg8::Unit& u, int wr, int wc, int fr, int fq) const {
        bf16* O = (bf16*)(ws + WS_GB);
        EPI_FOREACH({ const u32x4 gv = *(const u32x4*)(O + (size_t)row * AW + col); u32x4 w;
            w.x = pk2(v0[0] * bflo(gv.x), v0[1] * bfhi(gv.x)); w.y = pk2(v0[2] * bflo(gv.y), v0[3] * bfhi(gv.y)); w.z = pk2(v1[0] * bflo(gv.z), v1[1] * bfhi(gv.z)); w.w = pk2(v1[2] * bflo(gv.w), v1[3] * bfhi(gv.w));
            *(u32x4*)(O + (size_t)row * AW + col) = w; })
    }
};
struct SchedMerge {
    pg8::TileOrder T; const char* Aa; const char* Ab; const char* Ba; const char* Bb;
    __device__ __forceinline__ bool next(int i, pg8::Unit& u) const { u.sub = i & 1; return T.tile(i >> 1, u.pm, u.pn); }
    __device__ __forceinline__ const char* A(const pg8::Unit& u) const { return (u.sub ? Ab : Aa) + (size_t)u.pm * 256 * AW * 2; }
    __device__ __forceinline__ const char* B(const pg8::Unit& u) const { return (u.sub ? Bb : Ba) + (size_t)u.pn * 256 * AW * 2; }
    __device__ __forceinline__ bool keep(const pg8::Unit& u) const { return u.sub == 0; }
};
struct EpiMerge {
    unsigned char* ws;
    __device__ __forceinline__ void operator()(f32x4 (&acc)[2][2][4][2], const pg8::Unit& u, int wr, int wc, int fr, int fq) const {
        const bf16* SA = (const bf16*)(ws + WS_SA); bf16* SB = (bf16*)(ws + WS_SB);
        if (u.sub == 0) {
            EPI_FOREACH({ const u32x4 av = *(const u32x4*)(SA + (size_t)row * D_ + col); const u32x4 bv = *(const u32x4*)(SB + (size_t)row * D_ + col);
                v0[0] *= bflo(av.x) * __builtin_amdgcn_rcpf(bflo(bv.x)); v0[1] *= bfhi(av.x) * __builtin_amdgcn_rcpf(bfhi(bv.x)); v0[2] *= bflo(av.y) * __builtin_amdgcn_rcpf(bflo(bv.y)); v0[3] *= bfhi(av.y) * __builtin_amdgcn_rcpf(bfhi(bv.y));
                v1[0] *= bflo(av.z) * __builtin_amdgcn_rcpf(bflo(bv.z)); v1[1] *= bfhi(av.z) * __builtin_amdgcn_rcpf(bfhi(bv.z)); v1[2] *= bflo(av.w) * __builtin_amdgcn_rcpf(bflo(bv.w)); v1[3] *= bfhi(av.w) * __builtin_amdgcn_rcpf(bfhi(bv.w)); })
        } else {
            EPI_FOREACH({ const u32x4 bv = *(const u32x4*)(SB + (size_t)row * D_ + col); u32x4 w;
                w.x = pk2(v0[0] * bflo(bv.x), v0[1] * bfhi(bv.x)); w.y = pk2(v0[2] * bflo(bv.y), v0[3] * bfhi(bv.y)); w.z = pk2(v1[0] * bflo(bv.z), v1[1] * bfhi(bv.z)); w.w = pk2(v1[2] * bflo(bv.w), v1[3] * bfhi(bv.w));
                *(u32x4*)(SB + (size_t)row * D_ + col) = w; })
        }
    }
};
struct EpiOut {
    const float* x; bf16* ybf; float* RS;
    __device__ __forceinline__ void operator()(f32x4 (&acc)[2][2][4][2], const pg8::Unit& u, int wr, int wc, int fr, int fq) const {
#pragma unroll
        for (int ai = 0; ai < 2; ++ai)
#pragma unroll
            for (int m = 0; m < 4; ++m) { const int row = u.pm * 256 + ai * 128 + wr * 64 + m * 16 + fr; float ss = 0.f;
#pragma unroll
                for (int bj = 0; bj < 2; ++bj) { const int col = u.pn * 256 + bj * 128 + wc * 32 + 8 * fq; const size_t off = (size_t)row * D_ + col;
                    const f32x4 x0 = *(const f32x4*)(x + off), x1 = *(const f32x4*)(x + off + 4); const f32x4 y0 = x0 + acc[ai][bj][m][0], y1 = x1 + acc[ai][bj][m][1];
                    u32x4 pw; pw.x = pk2(y0[0], y0[1]); pw.y = pk2(y0[2], y0[3]); pw.z = pk2(y1[0], y1[1]); pw.w = pk2(y1[2], y1[3]);
                    *(u32x4*)(ybf + off) = pw;
                    ss += (y0[0] * y0[0] + y0[1] * y0[1]) + (y0[2] * y0[2] + y0[3] * y0[3]) + (y1[0] * y1[0] + y1[1] * y1[1]) + (y1[2] * y1[2] + y1[3] * y1[3]); }
                ss += __shfl_xor(ss, 16); ss += __shfl_xor(ss, 32);
                if (fq == 0) atomicAdd(RS + row, ss); }
    }
};
__device__ __forceinline__ void p9_final_norm(const Ctx& C, const Args& a) {
    const float* RS = (const float*)(a.ws + WS_CTL) + RS_WORD; const bf16* YBF = (const bf16*)(a.ws + WS_G);
    const int gw = C.wg * NWAVES + C.wave, NGW = C.G * NWAVES;
    for (int m = gw; m < S_; m += NGW) {
        const float rs = rsqrtf(RS[m] * (1.f / D_) + EPS);
        const u32x4* yr = (const u32x4*)(YBF + (size_t)m * D_) + C.lane; f32x4* orow = (f32x4*)(a.out + (size_t)m * D_); const f32x4* wr = (const f32x4*)a.final_norm_w;
#pragma unroll
        for (int j = 0; j < 4; ++j) { const u32x4 yv = yr[64 * j]; const int c4 = 2 * (C.lane + 64 * j);
            const f32x4 w0 = wr[c4], w1 = wr[c4 + 1];
            f32x4 o0, o1; o0.x = bflo(yv.x) * rs * w0.x; o0.y = bfhi(yv.x) * rs * w0.y; o0.z = bflo(yv.y) * rs * w0.z; o0.w = bfhi(yv.y) * rs * w0.w;
            o1.x = bflo(yv.z) * rs * w1.x; o1.y = bfhi(yv.z) * rs * w1.y; o1.z = bflo(yv.w) * rs * w1.z; o1.w = bfhi(yv.w) * rs * w1.w;
            orow[c4] = o0; orow[c4 + 1] = o1; }
    }
}

#ifndef MK_N_LAUNCHES
#define MK_N_LAUNCHES 1
#endif
constexpr int N_PHASES = 10;
__global__ void __launch_bounds__(NTHR, 2) mega_fwd(Args a) {
    extern __shared__ __attribute__((aligned(16))) unsigned char lds_raw[];
    Ctx C; C.lds = (LAS unsigned char*)lds_raw; C.tid = threadIdx.x; C.lane = C.tid & 63; C.wave = __builtin_amdgcn_readfirstlane(C.tid >> 6); C.wg = blockIdx.x; C.G = gridDim.x;
    volatile LAS unsigned* MISC = (volatile LAS unsigned*)(C.lds + MISC_OFF);
    if (C.tid < 32) MISC[C.tid] = 0u;
    __syncthreads();
    unsigned char* ws = a.ws;
    XcdBarrier bar; bar.bar = (unsigned*)(ws + WS_CTL) + CW_BAR; bar.x = 0; bar.st = nullptr;
    const int lo = a.ph_lo, hi = a.ph_hi;
    if (hi - lo > 1) bar = xcd_barrier_post((unsigned*)(ws + WS_CTL) + CW_BAR, MISC + 8);
#define IN(k) (lo <= (k) && (k) < hi)
#define SEAM(k) do { if (IN(k) && IN((k) + 1)) xcd_barrier(bar); } while (0)
    float* dscr = a.out;
    if (IN(0)) { REP(0) p0_prep(C, a); } SEAM(0);
    if (IN(1)) {
        SchedPlain S; S.T.init(S_, NIN, C.G, C.wg); S.Ab = (const char*)(ws + WS_H); S.Bb = (const char*)(ws + WS_WIN); S.tA = (size_t)256 * D_ * 2; S.tB = (size_t)256 * D_ * 2;
        EpiProj E{ws}; REP(1) pg8::gemm_phase(C.lds, D_, D_, D_, S, E);
    } SEAM(1);
    if (IN(2)) { REP(2) p2_norms(C, a); REP(12) p2_hgrn_states(C, a, dscr); } SEAM(2);
    if (IN(3)) {
        SchedPlain S; S.T.init(S_, 4096, C.G, C.wg); S.Ab = (const char*)(ws + WS_CQN); S.Bb = (const char*)(ws + WS_WQ); S.tA = (size_t)256 * QR * 2; S.tB = (size_t)256 * QR * 2;
        EpiQ E{ws}; REP(3) pg8::gemm_phase(C.lds, QR, QR, QR, S, E);
        REP(13) p3_scan(C, a, dscr);
    } SEAM(3);
    if (IN(4)) {
        unsigned* qc = (unsigned*)(ws + WS_CTL) + CW_Q4;
        if (C.tid == 0) MISC[MISC_Q4] = xb_add(qc, 1u);
        attn_setup(C, a);
        int cur = __builtin_amdgcn_readfirstlane((int)MISC[MISC_Q4]);
        p4_indexer(C, a, dscr, qc, MISC, cur); p4_hgrn_out(C, a, qc, MISC, cur);
    } SEAM(4);
    if (IN(6)) {
        SchedUV S; S.T.init(S_, AW, C.G, C.wg); S.Ab = (const char*)(ws + WS_RAW); S.Bb = (const char*)(ws + WS_WUV);
        EpiUV E{ws}; pg8::gemm_phase(C.lds, 2048, 512, 512, S, E);
    } SEAM(6);
    if (IN(7)) {
        SchedMerge S; S.T.init(S_, D_, C.G, C.wg); S.Aa = (const char*)(ws + WS_QA); S.Ab = (const char*)(ws + WS_GB); S.Ba = (const char*)(ws + WS_WPA); S.Bb = (const char*)(ws + WS_WPB);
        EpiMerge E{ws}; pg8::gemm_phase(C.lds, AW, AW, AW, S, E);
    } SEAM(7);
    if (IN(8)) {
        SchedPlain S; S.T.init(S_, D_, C.G, C.wg); S.Ab = (const char*)(ws + WS_SB); S.Bb = (const char*)(ws + WS_WOUT); S.tA = (size_t)256 * D_ * 2; S.tB = (size_t)256 * D_ * 2;
        EpiOut E{a.x, (bf16*)(ws + WS_G), (float*)(ws + WS_CTL) + RS_WORD}; pg8::gemm_phase(C.lds, D_, D_, D_, S, E);
    } SEAM(8);
    if (IN(9)) { p9_final_norm(C, a); }
#undef IN
#undef SEAM
}

extern "C" void kernel_launch(void* const* d_in, const int* in_sizes, int n_in, void* d_out, int out_size, void* d_ws, size_t ws_size, hipStream_t stream) {
    static int grid = 0;
    if (grid == 0) {
        if (n_in != 17 || in_sizes[0] != S_ * D_ || out_size != S_ * D_ || ws_size < WS_END) {
            fprintf(stderr, "kernel_launch: unexpected shapes / workspace (n_in %d, in0 %d, out %d, ws %zu < %zu); nothing launched\n", n_in, n_in > 0 ? in_sizes[0] : -1, out_size, ws_size, (size_t)WS_END); grid = -1; return; }
        int dev = 0, cus = 0;
        if (hipGetDevice(&dev) != hipSuccess || hipDeviceGetAttribute(&cus, hipDeviceAttributeMultiprocessorCount, dev) != hipSuccess) { grid = -1; return; }
        if (hipFuncSetAttribute((const void*)mega_fwd, hipFuncAttributeMaxDynamicSharedMemorySize, LDS_BYTES) != hipSuccess) { fprintf(stderr, "kernel_launch: hipFuncSetAttribute failed\n"); grid = -1; return; }
        (void)hipGetLastError();
        grid = cus;
    }
    if (grid < 0) return;
    (void)hipMemsetAsync((char*)d_ws + WS_CTL, 0, CTL_ZERO_BYTES, stream);
    Args a{};
    const float** ip = (const float**)&a;
    for (int i = 0; i < 17; ++i) ip[i] = (const float*)d_in[i];
    a.out = (float*)d_out; a.ws = (unsigned char*)d_ws;
    constexpr int NL = MK_N_LAUNCHES;
    for (int li = 0; li < NL; ++li) {
        a.ph_lo = li * N_PHASES / NL; a.ph_hi = (li + 1) * N_PHASES / NL;
        hipLaunchKernelGGL(mega_fwd, dim3(grid), dim3(NTHR), LDS_BYTES, stream, a);
    }
}
```

```cpp
#include <hip/hip_runtime.h>
#include <cstdio>

#define LAS __attribute__((address_space(3)))
#define GAS __attribute__((address_space(1)))
typedef unsigned short bf16;
typedef short bf16x8 __attribute__((ext_vector_type(8)));
typedef short s16x4 __attribute__((ext_vector_type(4)));
typedef float f32x4 __attribute__((ext_vector_type(4)));
typedef float f32x2 __attribute__((ext_vector_type(2)));
typedef float f32x16 __attribute__((ext_vector_type(16)));
typedef unsigned u32x4 __attribute__((ext_vector_type(4)));
typedef unsigned u32x2 __attribute__((ext_vector_type(2)));

namespace pg8 {
constexpr int BM = 256, BK = 64, HALF = 128, HTB = HALF * BK * 2, STAGE_BYTES = 8 * HTB, NXCD = 8, WGM = 8;
__device__ __forceinline__ int lds_byte(int r, int c) { const int st = (r >> 4) * 2 + (c >> 5), rr = r & 15, cc = c & 31, ob = rr * 64 + cc * 2; return st * 1024 + (ob ^ (((ob >> 9) & 1) << 5)); }
__device__ __forceinline__ void stage_rc(int b, int& R, int& C) { const int st = b / 1024, sb = b % 1024, swz = sb ^ (((sb >> 9) & 1) << 5); R = (st >> 1) * 16 + swz / 64; C = (st & 1) * 32 + (swz % 64) / 2; }
__device__ __forceinline__ int perm32(int rho) { const int n = rho >> 4, i = rho & 15; return 8 * (i >> 2) + 4 * n + (i & 3); }
struct Unit { int pm, pn, sub; };
struct TileOrder {
    int nM, nN, nwg, G, c;
    __device__ void init(int M, int N, int G_, int c_) { nM = M / BM; nN = N / BM; nwg = nM * nN; G = G_; c = c_; }
    __device__ bool tile(int i, int& pm, int& pn) const {
        const long L = (long)i * G + c; if (L >= nwg) return false;
        int wgid = (int)L; { const int q = nwg / NXCD, r = nwg % NXCD, xcd = wgid % NXCD, off = wgid / NXCD; wgid = (xcd < r ? xcd * (q + 1) : r * (q + 1) + (xcd - r) * q) + off; }
        const int nig = WGM * nN, gid = wgid / nig, fm = gid * WGM, gsz = (nM - fm) < WGM ? (nM - fm) : WGM;
        pm = fm + ((wgid % nig) % gsz); pn = (wgid % nig) / gsz; return true;
    }
};
template <class Epi, class Sched, bool ALIGN_EPI = true, bool SP2 = true>
__device__ __forceinline__ void gemm_phase(LAS unsigned char* lds, const int lda, const int ldb, const int K, const Sched& S, const Epi& E) {
    const int tid = threadIdx.x, wid = __builtin_amdgcn_readfirstlane(tid >> 6), lane = tid & 63, wr = wid >> 2, wc = wid & 3, fr = lane & 15, fq = lane >> 4;
    const int nt = K / BK;
    unsigned voffA[2], voffB[2];
#pragma unroll
    for (int i = 0; i < 2; ++i) { int R, C; stage_rc(tid * 16 + i * 8192, R, C); const int Rb = (R & ~31) + perm32(R & 31);
        voffA[i] = (unsigned)(R * lda + C) * 2u; voffB[i] = (unsigned)(Rb * ldb + C) * 2u; }
    const size_t kstep = (size_t)(BK * 2);
    const size_t hstepA = (size_t)HALF * lda * 2, hstepB = (size_t)HALF * ldb * 2;
    const unsigned ldsw = (unsigned)wid * 1024u;
    const int aoff = lds_byte(wr * 64 + fr, fq * 8), boff = lds_byte(wc * 32 + fr, fq * 8);
#define PG8_SA(b, h) (((b) * 2 + (h)) * HTB)
#define PG8_SB(b, h) ((4 + (b) * 2 + (h)) * HTB)
#define PG8_STAGE(bufoff, gbase, voff) do { _Pragma("unroll") for (int _i = 0; _i < 2; ++_i) \
        __builtin_amdgcn_global_load_lds((const unsigned*)((const char*)(gbase) + (voff)[_i]), (LAS unsigned*)(lds + (bufoff) + ldsw + _i * 8192), 16, 0, 0); } while (0)
#define PG8_LDA(dst, b, h) do { _Pragma("unroll") for (int m = 0; m < 4; ++m) _Pragma("unroll") for (int k = 0; k < 2; ++k) dst[m][k] = *(const LAS bf16x8*)(lds + PG8_SA(b, h) + aoff + m * 2048 + k * 1024); } while (0)
#define PG8_LDB(dst, b, h) do { _Pragma("unroll") for (int n = 0; n < 2; ++n) _Pragma("unroll") for (int k = 0; k < 2; ++k) dst[n][k] = *(const LAS bf16x8*)(lds + PG8_SB(b, h) + boff + n * 2048 + k * 1024); } while (0)
#define PG8_MMA(ai, bj, At, Bt) do { __builtin_amdgcn_s_setprio(1); _Pragma("unroll") for (int m = 0; m < 4; ++m) _Pragma("unroll") for (int n = 0; n < 2; ++n) _Pragma("unroll") for (int k = 0; k < 2; ++k) \
        acc[ai][bj][m][n] = __builtin_amdgcn_mfma_f32_16x16x32_bf16(Bt[n][k], At[m][k], acc[ai][bj][m][n], 0, 0, 0); __builtin_amdgcn_s_setprio(0); } while (0)
#define PG8_WAIT_V(n) asm volatile("s_waitcnt vmcnt(" #n ")" ::: "memory")
#define PG8_WAIT_L(n) asm volatile("s_waitcnt lgkmcnt(" #n ")" ::: "memory")
#define PG8_BAR __builtin_amdgcn_s_barrier()
#define PG8_SCHED __builtin_amdgcn_sched_barrier(0)
    Unit cur, nxt; int ui = 0;
    if (!S.next(0, cur)) return;
    f32x4 acc[2][2][4][2];
#pragma unroll
    for (int a = 0; a < 2; ++a)
#pragma unroll
        for (int b = 0; b < 2; ++b)
#pragma unroll
            for (int m = 0; m < 4; ++m)
#pragma unroll
                for (int n = 0; n < 2; ++n) acc[a][b][m][n] = (f32x4){0.f, 0.f, 0.f, 0.f};
    bf16x8 At[4][2], B0[2][2], B1[2][2];
    const char* cA = S.A(cur); const char* cB = S.B(cur);
    if constexpr (SP2) {
        PG8_STAGE(PG8_SB(0, 0), cB, voffB); PG8_STAGE(PG8_SB(0, 1), cB + hstepB, voffB); PG8_STAGE(PG8_SA(0, 0), cA, voffA); PG8_STAGE(PG8_SA(0, 1), cA + hstepA, voffA);
        if (wr == 1) PG8_BAR;
        PG8_WAIT_V(2); PG8_BAR;
        PG8_STAGE(PG8_SB(1, 0), cB + kstep, voffB); PG8_STAGE(PG8_SA(1, 0), cA + kstep, voffA); PG8_STAGE(PG8_SB(1, 1), cB + hstepB + kstep, voffB);
        PG8_WAIT_V(6); PG8_BAR;
    } else {
        PG8_STAGE(PG8_SB(0, 0), cB, voffB); PG8_STAGE(PG8_SA(0, 0), cA, voffA); PG8_STAGE(PG8_SB(0, 1), cB + hstepB, voffB); PG8_STAGE(PG8_SA(0, 1), cA + hstepA, voffA);
        if (wr == 1) PG8_BAR;
        PG8_WAIT_V(4); PG8_BAR;
        PG8_STAGE(PG8_SB(1, 0), cB + kstep, voffB); PG8_STAGE(PG8_SA(1, 0), cA + kstep, voffA); PG8_STAGE(PG8_SB(1, 1), cB + hstepB + kstep, voffB);
        PG8_WAIT_V(6); PG8_BAR;
    }
    for (;;) {
        const bool has_next = S.next(ui + 1, nxt);
        const char* nA = has_next ? S.A(nxt) : cA; const char* nB = has_next ? S.B(nxt) : cB;
        for (int t = 0; t < nt; t += 2) {
            const bool last = (t == nt - 2);
            const char* a1 = cA + (size_t)(t + 1) * kstep;
            const char* a2 = last ? nA : cA + (size_t)(t + 2) * kstep; const char* b2 = last ? nB : cB + (size_t)(t + 2) * kstep;
            const char* a3 = a2 + kstep; const char* b3 = b2 + kstep;
            if constexpr (SP2) {
            PG8_LDB(B0, 0, 0); PG8_LDB(B1, 0, 1); PG8_SCHED; PG8_LDA(At, 0, 0); PG8_STAGE(PG8_SA(1, 1), a1 + hstepA, voffA);
            PG8_WAIT_V(8); PG8_WAIT_L(0); PG8_BAR; PG8_MMA(0, 0, At, B0); PG8_MMA(0, 1, At, B1); PG8_BAR; PG8_SCHED;
            PG8_LDA(At, 0, 1); PG8_STAGE(PG8_SB(0, 0), b2, voffB); PG8_STAGE(PG8_SB(0, 1), b2 + hstepB, voffB); PG8_STAGE(PG8_SA(0, 0), a2, voffA);
            PG8_WAIT_V(8); PG8_WAIT_L(0); PG8_BAR; PG8_MMA(1, 0, At, B0); PG8_MMA(1, 1, At, B1); PG8_BAR; PG8_SCHED;
            PG8_LDB(B0, 1, 0); PG8_LDB(B1, 1, 1); PG8_SCHED; PG8_LDA(At, 1, 0); PG8_STAGE(PG8_SA(0, 1), a2 + hstepA, voffA);
            PG8_WAIT_V(8); PG8_WAIT_L(0); PG8_BAR; PG8_MMA(0, 0, At, B0); PG8_MMA(0, 1, At, B1); PG8_BAR; PG8_SCHED;
            PG8_LDA(At, 1, 1); PG8_STAGE(PG8_SB(1, 0), b3, voffB); PG8_STAGE(PG8_SB(1, 1), b3 + hstepB, voffB); PG8_STAGE(PG8_SA(1, 0), a3, voffA);
            PG8_WAIT_V(8); PG8_WAIT_L(0); PG8_BAR; PG8_MMA(1, 0, At, B0); PG8_MMA(1, 1, At, B1); PG8_BAR; PG8_SCHED;
            } else {
            PG8_LDB(B0, 0, 0); PG8_SCHED; PG8_LDA(At, 0, 0); PG8_STAGE(PG8_SA(1, 1), a1 + hstepA, voffA);
            PG8_WAIT_L(8); PG8_BAR; PG8_WAIT_L(0); PG8_MMA(0, 0, At, B0); PG8_BAR; PG8_SCHED;
            PG8_LDB(B1, 0, 1); PG8_STAGE(PG8_SB(0, 0), b2, voffB);
            PG8_BAR; PG8_WAIT_L(0); PG8_MMA(0, 1, At, B1); PG8_BAR;
            PG8_LDA(At, 0, 1); PG8_STAGE(PG8_SA(0, 0), a2, voffA);
            PG8_BAR; PG8_WAIT_L(0); PG8_MMA(1, 0, At, B0); PG8_BAR; PG8_SCHED;
            PG8_STAGE(PG8_SB(0, 1), b2 + hstepB, voffB);
            PG8_WAIT_V(6); PG8_BAR; PG8_MMA(1, 1, At, B1); PG8_BAR;
            PG8_LDB(B0, 1, 0); PG8_SCHED; PG8_LDA(At, 1, 0); PG8_STAGE(PG8_SA(0, 1), a2 + hstepA, voffA);
            PG8_WAIT_L(8); PG8_BAR; PG8_WAIT_L(0); PG8_MMA(0, 0, At, B0); PG8_BAR; PG8_SCHED;
            PG8_LDB(B1, 1, 1); PG8_STAGE(PG8_SB(1, 0), b3, voffB);
            PG8_BAR; PG8_WAIT_L(0); PG8_MMA(0, 1, At, B1); PG8_BAR;
            PG8_LDA(At, 1, 1); PG8_STAGE(PG8_SA(1, 0), a3, voffA);
            PG8_BAR; PG8_WAIT_L(0); PG8_MMA(1, 0, At, B0); PG8_BAR; PG8_SCHED;
            PG8_STAGE(PG8_SB(1, 1), b3 + hstepB, voffB);
            PG8_WAIT_V(6); PG8_BAR; PG8_MMA(1, 1, At, B1); PG8_BAR;
            }
        }
        if constexpr (ALIGN_EPI) { if (wr == 0) PG8_BAR; }
        E(acc, cur, wr, wc, fr, fq);
        if (!has_next) break;
        if (!S.keep(cur)) {
#pragma unroll
            for (int a = 0; a < 2; ++a)
#pragma unroll
                for (int b = 0; b < 2; ++b)
#pragma unroll
                    for (int m = 0; m < 4; ++m)
#pragma unroll
                        for (int n = 0; n < 2; ++n) acc[a][b][m][n] = (f32x4){0.f, 0.f, 0.f, 0.f};
        }
        cur = nxt; cA = nA; cB = nB; ++ui;
        if constexpr (ALIGN_EPI) { if (wr == 1) PG8_BAR; }
    }
    PG8_WAIT_V(0);
    if constexpr (!ALIGN_EPI) { if (wr == 0) PG8_BAR; }
    PG8_BAR;
#undef PG8_SA
#undef PG8_SB
#undef PG8_STAGE
#undef PG8_LDA
#undef PG8_LDB
#undef PG8_MMA
#undef PG8_WAIT_V
#undef PG8_WAIT_L
#undef PG8_BAR
#undef PG8_SCHED
}
}

#ifndef PROBE_REP
#define PROBE_REP -1
#endif
#define REP(k) for (int _r = 0; _r < ((k) == PROBE_REP ? 2 : 1); ++_r)
constexpr int S_ = 8192, D_ = 2048, AW = 1024, QR = 512, KVR = 256, IDXD = 128, IDXH = 16, BH = 8, TOPK = 256, CHUNK = 64, NCH = S_ / CHUNK;
constexpr int IN_W = 10128, NIN = 10240;
constexpr float EPS = 1e-6f;
constexpr int NWAVES = 8, NTHR = 512;

constexpr size_t MiB = 1u << 20;
constexpr size_t WS_CTL = 0, CTL_ZERO_BYTES = 1 * MiB;
constexpr size_t WS_LB = 1 * MiB;
constexpr size_t WS_NCNT = 1 * MiB + 64 * 1024;
constexpr size_t WS_DLAST = 1 * MiB + 128 * 1024;
constexpr size_t WS_WIDX = 2 * MiB;
constexpr size_t WS_WQ = 4 * MiB;
constexpr size_t WS_WUV = 8 * MiB;
constexpr size_t WS_WPA = 9 * MiB, WS_WPB = 13 * MiB;
constexpr size_t WS_WOUT = 17 * MiB;
constexpr size_t WS_QA = 25 * MiB;
constexpr size_t WS_G = 41 * MiB;
constexpr size_t WS_VA = 73 * MiB;
constexpr size_t WS_GA = 89 * MiB;
constexpr size_t WS_GB = 105 * MiB;
constexpr size_t WS_SA = 121 * MiB;
constexpr size_t WS_SB = 153 * MiB;
constexpr size_t WS_RAW = 185 * MiB;
constexpr size_t WS_H = 217 * MiB;
constexpr size_t WS_CQN = 217 * MiB, WS_CKVN = 225 * MiB, WS_KIDX = 229 * MiB, WS_IDX = 231 * MiB;
constexpr size_t WS_WIN = 249 * MiB;
constexpr size_t WS_QABS = 249 * MiB;
constexpr size_t WS_SPT = 281 * MiB;
constexpr size_t WS_END = 313 * MiB;
constexpr int RS_WORD = 65536;
constexpr int CW_BAR = 4096;
constexpr int CW_Q4 = 8192;
constexpr int MISC_Q4 = 16;

typedef __bf16 bf16x2_t __attribute__((ext_vector_type(2)));
typedef short s16x2 __attribute__((ext_vector_type(2)));
__device__ __forceinline__ unsigned pk2(float lo, float hi) { const f32x2 v = {lo, hi}; return __builtin_bit_cast(unsigned, __builtin_convertvector(v, bf16x2_t)); }
__device__ __forceinline__ unsigned f2bf(float f) { return pk2(f, 0.f) & 0xffffu; }
__device__ __forceinline__ unsigned pk2_relu(float lo, float hi) { const f32x2 v = {lo, hi}; const s16x2 z = {0, 0};
    return __builtin_bit_cast(unsigned, __builtin_elementwise_max(__builtin_bit_cast(s16x2, __builtin_convertvector(v, bf16x2_t)), z)); }
__device__ __forceinline__ float bf2f(unsigned short b) { return __builtin_bit_cast(float, ((unsigned)b) << 16); }
__device__ __forceinline__ float bflo(unsigned w) { return __builtin_bit_cast(float, w << 16); }
__device__ __forceinline__ float bfhi(unsigned w) { return __builtin_bit_cast(float, w & 0xffff0000u); }
__device__ __forceinline__ float wave_sum(float v) {
#pragma unroll
    for (int o = 1; o < 64; o <<= 1) v += __shfl_xor(v, o);
    return v;
}
__device__ __forceinline__ float sigmoidf_(float x) { return __builtin_amdgcn_rcpf(1.0f + __expf(-x)); }
__device__ __forceinline__ float siluf_(float x) { return x * __builtin_amdgcn_rcpf(1.0f + __expf(-x)); }
#define LDS_WAIT() asm volatile("s_waitcnt lgkmcnt(0)" ::: "memory")
#define VM_WAIT() asm volatile("s_waitcnt vmcnt(0)" ::: "memory")

#define XB_TMO      128
#define XB_XCNT(j)  (256  + 64 * (j))
#define XB_XSUB(j)  (1280 + 64 * (j))
#define XB_XGEN(j)  (2304 + 64 * (j))
#define XB_TOP      3328
#define XB_TOPGEN   3392
#define XCD_BAR_WORDS 3456
#define XB_SPIN_CAP (1u << 22)
__device__ __forceinline__ unsigned xb_ld(unsigned* p)              { return __hip_atomic_load(p, __ATOMIC_RELAXED, __HIP_MEMORY_SCOPE_AGENT); }
__device__ __forceinline__ unsigned xb_add(unsigned* p, unsigned v) { return __hip_atomic_fetch_add(p, v, __ATOMIC_RELAXED, __HIP_MEMORY_SCOPE_AGENT); }
__device__ __forceinline__ unsigned xb_xcc_id() { return (unsigned)__builtin_amdgcn_s_getreg((3 << 11) | 20) & 0xFu; }
#define XB_SPIN(cond, bar) do { unsigned _sp = 0; while (cond) { __builtin_amdgcn_s_sleep(1); \
    if ((++_sp & 255u) == 0u) { if (xb_ld(&(bar)[XB_TMO])) break; if (_sp > XB_SPIN_CAP) { atomicAdd(&(bar)[XB_TMO], 1u); break; } } } } while (0)
struct XcdBarrier { unsigned* bar; unsigned x; volatile LAS unsigned* st; };
__device__ __forceinline__ XcdBarrier xcd_barrier_post(unsigned* bar, volatile LAS unsigned* st) {
    XcdBarrier b; b.bar = bar; b.x = xb_xcc_id(); b.st = st;
    if (threadIdx.x == 0) (void)xb_add(&bar[XB_XCNT(b.x)], 1u);
    return b;
}
__device__ __forceinline__ void xcd_barrier_complete(unsigned* bar, unsigned x, unsigned& nloc, unsigned& nx) {
    const unsigned G = gridDim.x * gridDim.y * gridDim.z;
    unsigned sum, cnt, mine, sp = 0u;
    for (;;) {
        sum = 0u; cnt = 0u; mine = 0u;
#pragma unroll
        for (unsigned j = 0; j < 16; ++j) { const unsigned c = xb_ld(&bar[XB_XCNT(j)]); sum += c; cnt += (c > 0u) ? 1u : 0u; mine = (j == x) ? c : mine; }
        if (sum == G) break;
        __builtin_amdgcn_s_sleep(1);
        if ((++sp & 255u) == 0u) { if (xb_ld(&bar[XB_TMO])) break; if (sp > XB_SPIN_CAP) { atomicAdd(&bar[XB_TMO], 1u); break; } }
    }
    nloc = mine > 0u ? mine : 1u; nx = cnt > 0u ? cnt : 1u;
}
__device__ __forceinline__ void xcd_barrier(const XcdBarrier& b) {
    asm volatile("s_waitcnt vmcnt(0)" ::: "memory");
    __syncthreads();
    if (threadIdx.x == 0) {
        unsigned* bar = b.bar;
        __builtin_amdgcn_s_waitcnt(0);
        unsigned nloc = b.st[0], nx = b.st[1];
        if (nloc == 0u) { xcd_barrier_complete(bar, b.x, nloc, nx); b.st[0] = nloc; b.st[1] = nx; }
        const unsigned old = xb_add(&bar[XB_XSUB(b.x)], 1u);
        const unsigned gen = old / nloc;
        if (old + 1u == (gen + 1u) * nloc) {
            __builtin_amdgcn_fence(__ATOMIC_RELEASE, "agent");
            asm volatile("s_waitcnt vmcnt(0)" ::: "memory");
            const unsigned og = xb_add(&bar[XB_TOP], 1u);
            const unsigned tg = og / nx;
            if (og + 1u == (tg + 1u) * nx) xb_add(&bar[XB_TOPGEN], 1u);
            else XB_SPIN(xb_ld(&bar[XB_TOPGEN]) == tg, bar);
            __builtin_amdgcn_fence(__ATOMIC_ACQUIRE, "agent");
            xb_add(&bar[XB_XGEN(b.x)], 1u);
            asm volatile("s_waitcnt vmcnt(0)" ::: "memory");
        } else {
            XB_SPIN(xb_ld(&bar[XB_XGEN(b.x)]) == gen, bar);
            __builtin_amdgcn_fence(__ATOMIC_ACQUIRE, "agent");
            asm volatile("s_waitcnt vmcnt(0)" ::: "memory");
        }
    }
    __syncthreads();
}

struct Args {
    const float *x, *norm_w, *w_in, *lb_table, *gnorm_a, *q_norm_w, *kv_norm_w, *w_uq, *w_qidx, *w_ukv, *kidx_norm_w, *kidx_norm_b, *w_pa, *w_pb, *w_out, *rel_bias, *final_norm_w;
    float* out; unsigned char* ws; int ph_lo, ph_hi;
};
constexpr int LDS_BYTES = 155648;
constexpr int MISC_OFF = 154624;
struct Ctx { LAS unsigned char* lds; int tid, lane, wave, wg, G; };

struct P0Item { const float* src; bf16* dst; int N, ldk, sc; };
__device__ __forceinline__ P0Item p0_decode(const Args& a, unsigned char* ws, int it, int lane) {
    constexpr int I_IN = (D_ / 64) * (NIN / 32), I_QI = (QR / 64) * (2048 / 32), I_PA = (AW / 64) * (D_ / 32), I_OUT = (D_ / 64) * (D_ / 32);
    const int c4 = lane & 7; P0Item d; int r = it;
    if (r < I_IN) { const int kb = r / (NIN / 32), nb = r % (NIN / 32), np = 32 * nb + 4 * c4;
        d.src = a.w_in + (size_t)(64 * kb) * IN_W; d.N = IN_W; d.sc = np < 5008 ? np : (np < 5120 ? -1 : np - 112); d.dst = (bf16*)(ws + WS_WIN) + (size_t)(32 * nb) * D_ + 64 * kb; d.ldk = D_; return d; } r -= I_IN;
    if (r < I_QI) { const int kb = r / 64, nb = r % 64; d.src = a.w_qidx + (size_t)(64 * kb) * 2048; d.N = 2048; d.sc = 32 * nb + 4 * c4; d.dst = (bf16*)(ws + WS_WQ) + (size_t)(2048 + 32 * nb) * QR + 64 * kb; d.ldk = QR; return d; } r -= I_QI;
    if (r < 2 * I_PA) { const bool pb = r >= I_PA; if (pb) r -= I_PA; const int kb = r / 64, nb = r % 64;
        d.src = (pb ? a.w_pb : a.w_pa) + (size_t)(64 * kb) * D_; d.N = D_; d.sc = 32 * nb + 4 * c4; d.dst = (bf16*)(ws + (pb ? WS_WPB : WS_WPA)) + (size_t)(32 * nb) * AW + 64 * kb; d.ldk = AW; return d; } r -= 2 * I_PA;
    if (r < I_OUT) { const int kb = r / 64, nb = r % 64; d.src = a.w_out + (size_t)(64 * kb) * D_; d.N = D_; d.sc = 32 * nb + 4 * c4; d.dst = (bf16*)(ws + WS_WOUT) + (size_t)(32 * nb) * D_ + 64 * kb; d.ldk = D_; return d; } r -= I_OUT;
    {
        const int kb = r / 32, nb = r % 32, k0 = 64 * kb, hh = k0 >> 8, c0 = k0 & 255, np = 32 * nb + 4 * c4, h = np >> 7, dd = np & 127;
        d.src = a.w_ukv + (size_t)c0 * 2048; d.N = 2048; d.sc = (hh == (h & 1)) ? h * 256 + 128 + dd : -1; d.dst = (bf16*)(ws + WS_WUV) + (size_t)(32 * nb) * 512 + k0; d.ldk = 512; return d; }
}
__device__ __forceinline__ void p0_item_load(const P0Item& d, int lane, f32x4 (&v)[8]) {
    const int kr = lane >> 3;
#pragma unroll
    for (int i = 0; i < 8; ++i) v[i] = d.sc >= 0 ? *(const f32x4*)(d.src + (size_t)(kr + 8 * i) * d.N + d.sc) : (f32x4){0.f, 0.f, 0.f, 0.f};
}
__device__ __forceinline__ void p0_item_put(const P0Item& d, int lane, const f32x4 (&v)[8], LAS float* scr) {
    const int c4 = lane & 7, kr = lane >> 3;
#pragma unroll
    for (int i = 0; i < 8; ++i) { LAS float* p = scr + (kr + 8 * i) * 33 + 4 * c4; p[0] = v[i].x; p[1] = v[i].y; p[2] = v[i].z; p[3] = v[i].w; }
    LDS_WAIT(); asm volatile("" ::: "memory");
    const int c = lane & 7;
#pragma unroll
    for (int j = 0; j < 4; ++j) { const int n = (lane >> 3) + 8 * j; const LAS float* sp = scr + (8 * c) * 33 + n;
        u32x4 o; o.x = pk2(sp[0 * 33], sp[1 * 33]); o.y = pk2(sp[2 * 33], sp[3 * 33]); o.z = pk2(sp[4 * 33], sp[5 * 33]); o.w = pk2(sp[6 * 33], sp[7 * 33]);
        *(u32x4*)(d.dst + (size_t)n * d.ldk + 8 * c) = o; }
    LDS_WAIT(); asm volatile("" ::: "memory");
}
__device__ __forceinline__ void p0_prep(const Ctx& C, const Args& a) {
    unsigned char* ws = a.ws;
    LAS float* scr = (LAS float*)(C.lds + C.wave * 16384);
    const int gw = C.wg * NWAVES + C.wave, NGW = C.G * NWAVES;
    constexpr int NITEMS = (D_ / 64) * (NIN / 32) + (QR / 64) * (2048 / 32) + 2 * (AW / 64) * (D_ / 32) + (D_ / 64) * (D_ / 32) + (512 / 64) * (1024 / 32);
    {
        f32x4 va[8], vb[8]; int it = gw;
        P0Item da, db;
        if (it < NITEMS) { da = p0_decode(a, ws, it, C.lane); p0_item_load(da, C.lane, va); }
        while (it < NITEMS) {
            const int i1 = it + NGW; if (i1 < NITEMS) { db = p0_decode(a, ws, i1, C.lane); p0_item_load(db, C.lane, vb); }
            p0_item_put(da, C.lane, va, scr);
            if (i1 >= NITEMS) break;
            const int i2 = i1 + NGW; if (i2 < NITEMS) { da = p0_decode(a, ws, i2, C.lane); p0_item_load(da, C.lane, va); }
            p0_item_put(db, C.lane, vb, scr);
            it = i2;
        }
    }
    for (int m = gw; m < S_; m += NGW) {
        const f32x4* xr = (const f32x4*)(a.x + (size_t)m * D_) + C.lane; const f32x4* wr = (const f32x4*)a.norm_w + C.lane;
        f32x4 v[8]; float s = 0.f;
#pragma unroll
        for (int j = 0; j < 8; ++j) { v[j] = xr[64 * j]; s += (v[j].x * v[j].x + v[j].y * v[j].y) + (v[j].z * v[j].z + v[j].w * v[j].w); }
        const float rs = rsqrtf(wave_sum(s) * (1.f / D_) + EPS);
        u32x2* o8 = (u32x2*)((bf16*)(ws + WS_H) + (size_t)m * D_) + C.lane;
#pragma unroll
        for (int j = 0; j < 8; ++j) { const f32x4 w = wr[64 * j]; u32x2 o; o.x = pk2(v[j].x * rs * w.x, v[j].y * rs * w.y); o.y = pk2(v[j].z * rs * w.z, v[j].w * rs * w.w); o8[64 * j] = o; }
    }
    { const int g = C.wg * NTHR + C.tid; if (g < AW) { const float l0 = a.lb_table[g], l1 = a.lb_table[AW + g], mx = fmaxf(l0, l1), e0 = __expf(l0 - mx), e1 = __expf(l1 - mx); ((float*)(ws + WS_LB))[g] = e0 / (e0 + e1); } }
    __syncthreads();
    {
        LAS float* As = (LAS float*)C.lds;
        LAS float* Bs = As + 64 * 129;
        bf16* WqT = (bf16*)(ws + WS_WQ);
        for (int it = C.wg; it < 256; it += C.G) {
            const int h = it >> 5, cb = (it >> 3) & 3, rb = it & 7, c0 = cb * 64, r0 = rb * 64;
            { const int rr = C.tid >> 3, seg = C.tid & 7;
#pragma unroll
              for (int j = 0; j < 4; ++j) { const f32x4 va = *(const f32x4*)(a.w_uq + (size_t)(r0 + rr) * 1024 + h * 128 + seg * 16 + 4 * j); const f32x4 vb = *(const f32x4*)(a.w_ukv + (size_t)(c0 + rr) * 2048 + h * 256 + seg * 16 + 4 * j);
                  LAS float* pa = As + rr * 129 + seg * 16 + 4 * j; pa[0] = va.x; pa[1] = va.y; pa[2] = va.z; pa[3] = va.w;
                  LAS float* pb = Bs + rr * 129 + seg * 16 + 4 * j; pb[0] = vb.x; pb[1] = vb.y; pb[2] = vb.z; pb[3] = vb.w; } }
            __syncthreads();
            { const int r = C.tid & 63, cg = C.tid >> 6; float o[8];
#pragma unroll
              for (int i = 0; i < 8; ++i) o[i] = 0.f;
              for (int d = 0; d < 128; ++d) { const float av = As[r * 129 + d];
#pragma unroll
                  for (int i = 0; i < 8; ++i) o[i] += av * Bs[(cg * 8 + i) * 129 + d]; }
#pragma unroll
              for (int i = 0; i < 8; ++i) WqT[(size_t)(h * 256 + c0 + cg * 8 + i) * QR + r0 + r] = (bf16)f2bf(o[i] * 0.08838834764831845f); }
            __syncthreads();
        }
    }
}

struct SchedPlain {
    pg8::TileOrder T; const char* Ab; const char* Bb; size_t tA, tB;
    __device__ __forceinline__ bool next(int i, pg8::Unit& u) const { u.sub = 0; return T.tile(i, u.pm, u.pn); }
    __device__ __forceinline__ const char* A(const pg8::Unit& u) const { return Ab + (size_t)u.pm * tA; }
    __device__ __forceinline__ const char* B(const pg8::Unit& u) const { return Bb + (size_t)u.pn * tB; }
    __device__ __forceinline__ bool keep(const pg8::Unit&) const { return false; }
};
#define EPI_FOREACH(...) \
    _Pragma("unroll") for (int ai = 0; ai < 2; ++ai) _Pragma("unroll") for (int m = 0; m < 4; ++m) { const int row = u.pm * 256 + ai * 128 + wr * 64 + m * 16 + fr; \
    _Pragma("unroll") for (int bj = 0; bj < 2; ++bj) { const int col = u.pn * 256 + bj * 128 + wc * 32 + 8 * fq; f32x4& v0 = acc[ai][bj][m][0]; f32x4& v1 = acc[ai][bj][m][1]; __VA_ARGS__ } }

struct EpiProj {
    unsigned char* ws;
    __device__ __forceinline__ void operator()(f32x4 (&acc)[2][2][4][2], const pg8::Unit& u, int wr, int wc, int fr, int fq) const {
        const int pn = u.pn;
        if (pn < 4) {
            bf16* O = (bf16*)(ws + WS_QA);
            EPI_FOREACH({ u32x4 w; const float s = 0.08838834764831845f; w.x = pk2(siluf_(v0[0]) * s, siluf_(v0[1]) * s); w.y = pk2(siluf_(v0[2]) * s, siluf_(v0[3]) * s); w.z = pk2(siluf_(v1[0]) * s, siluf_(v1[1]) * s); w.w = pk2(siluf_(v1[2]) * s, siluf_(v1[3]) * s);
                *(u32x4*)(O + (size_t)row * AW + col) = w; })
        } else if (pn < 8) {
            float* O = (float*)(ws + WS_G); const float* lb = (const float*)(ws + WS_LB);
            EPI_FOREACH({ const int c = col - 1024; const f32x4 l0 = *(const f32x4*)(lb + c), l1 = *(const f32x4*)(lb + c + 4); f32x4 o0, o1;
                _Pragma("unroll") for (int j = 0; j < 4; ++j) { o0[j] = __logf(l0[j] + (1.f - l0[j]) * sigmoidf_(v0[j])); o1[j] = __logf(l1[j] + (1.f - l1[j]) * sigmoidf_(v1[j])); }
                *(f32x4*)(O + (size_t)row * AW + c) = o0; *(f32x4*)(O + (size_t)row * AW + c + 4) = o1; })
        } else if (pn < 12) {
            bf16* O = (bf16*)(ws + WS_VA);
            EPI_FOREACH({ u32x4 w; w.x = pk2(v0[0], v0[1]); w.y = pk2(v0[2], v0[3]); w.z = pk2(v1[0], v1[1]); w.w = pk2(v1[2], v1[3]); *(u32x4*)(O + (size_t)row * AW + col - 2048) = w; })
        } else if (pn < 16 || (pn >= 20 && pn < 24)) {
            bf16* O = (bf16*)(ws + (pn < 16 ? WS_GA : WS_GB)); const int cb = pn < 16 ? 3072 : 5120;
            EPI_FOREACH({ u32x4 w; w.x = pk2(siluf_(v0[0]), siluf_(v0[1])); w.y = pk2(siluf_(v0[2]), siluf_(v0[3])); w.z = pk2(siluf_(v1[0]), siluf_(v1[1])); w.w = pk2(siluf_(v1[2]), siluf_(v1[3]));
                *(u32x4*)(O + (size_t)row * AW + col - cb) = w; })
        } else if (pn < 20) {
            float* O = (float*)(ws + WS_RAW);
            EPI_FOREACH({ *(f32x4*)(O + (size_t)row * 1024 + col - 4096) = v0; *(f32x4*)(O + (size_t)row * 1024 + col - 4096 + 4) = v1; })
        } else {
            bf16* O = (bf16*)(ws + (pn < 32 ? WS_SA : WS_SB)); const int cb = pn < 32 ? 6144 : 8192;
            EPI_FOREACH({ u32x4 w; w.x = pk2(sigmoidf_(v0[0]), sigmoidf_(v0[1])); w.y = pk2(sigmoidf_(v0[2]), sigmoidf_(v0[3])); w.z = pk2(sigmoidf_(v1[0]), sigmoidf_(v1[1])); w.w = pk2(sigmoidf_(v1[2]), sigmoidf_(v1[3]));
                *(u32x4*)(O + (size_t)row * D_ + col - cb) = w; })
        }
    }
};

__device__ __forceinline__ void p2_norms(const Ctx& C, const Args& a) {
    unsigned char* ws = a.ws;
    const int gw = C.wg * NWAVES + C.wave, NGW = C.G * NWAVES, lane = C.lane;
    const float* RAW = (const float*)(ws + WS_RAW);
    for (int t = gw; t < S_; t += NGW) {
        const float* r = RAW + (size_t)t * 1024;
        { const f32x4 v0 = *(const f32x4*)(r + 4 * lane), v1 = *(const f32x4*)(r + 256 + 4 * lane);
          const float ss = wave_sum((v0.x * v0.x + v0.y * v0.y) + (v0.z * v0.z + v0.w * v0.w) + (v1.x * v1.x + v1.y * v1.y) + (v1.z * v1.z + v1.w * v1.w));
          const float rs = rsqrtf(ss * (1.f / QR) + EPS);
          const f32x4 w0 = *(const f32x4*)(a.q_norm_w + 4 * lane), w1 = *(const f32x4*)(a.q_norm_w + 256 + 4 * lane);
          bf16* o = (bf16*)(ws + WS_CQN) + (size_t)t * QR;
          u32x2 p0, p1; p0.x = pk2(v0.x * rs * w0.x, v0.y * rs * w0.y); p0.y = pk2(v0.z * rs * w0.z, v0.w * rs * w0.w); p1.x = pk2(v1.x * rs * w1.x, v1.y * rs * w1.y); p1.y = pk2(v1.z * rs * w1.z, v1.w * rs * w1.w);
          *(u32x2*)(o + 4 * lane) = p0; *(u32x2*)(o + 256 + 4 * lane) = p1; }
        { const f32x4 v0 = *(const f32x4*)(r + 512 + 4 * lane);
          const float ss = wave_sum((v0.x * v0.x + v0.y * v0.y) + (v0.z * v0.z + v0.w * v0.w));
          const float rs = rsqrtf(ss * (1.f / KVR) + EPS);
          const f32x4 w0 = *(const f32x4*)(a.kv_norm_w + 4 * lane);
          u32x2 p0; p0.x = pk2(v0.x * rs * w0.x, v0.y * rs * w0.y); p0.y = pk2(v0.z * rs * w0.z, v0.w * rs * w0.w);
          *(u32x2*)((bf16*)(ws + WS_CKVN) + (size_t)t * KVR + 4 * lane) = p0; }
        { const f32x2 v = *(const f32x2*)(r + 768 + 2 * lane);
          const float mu = wave_sum(v.x + v.y) * (1.f / IDXD); const float d0 = v.x - mu, d1 = v.y - mu;
          const float var = wave_sum(d0 * d0 + d1 * d1) * (1.f / IDXD); const float rs = rsqrtf(var + EPS);
          const f32x2 w = *(const f32x2*)(a.kidx_norm_w + 2 * lane), b = *(const f32x2*)(a.kidx_norm_b + 2 * lane);
          *(unsigned*)((bf16*)(ws + WS_KIDX) + (size_t)t * IDXD + 2 * lane) = pk2(d0 * rs * w.x + b.x, d1 * rs * w.y + b.y); }
        if (lane < IDXH) ((float*)(ws + WS_WIDX))[(size_t)t * IDXH + lane] = r[896 + lane] * 0.02209708691207961f;
    }
}
constexpr int R64 = 144, R128 = 272;
__device__ __forceinline__ void p2_hgrn_states(const Ctx& C, const Args& a, float* UT) {
    unsigned char* ws = a.ws;
    const float* G = (const float*)(ws + WS_G); const bf16* VA = (const bf16*)(ws + WS_VA); float* DL = (float*)(ws + WS_DLAST);
    LAS unsigned char* kdT = C.lds;
    LAS unsigned char* vT = C.lds + 128 * R64;
    LAS float* segtot = (LAS float*)(C.lds + 2 * 128 * R64);
    const int tid = C.tid, lane = C.lane, w = C.wave;
    for (int it = C.wg; it < NCH * BH; it += C.G) {
        const int c = it >> 3, h = it & 7;
        const int k = tid & 127, seg = tid >> 7, t0 = c * CHUNK + seg * 16;
        float g[16], cum[16]; float run = 0.f;
#pragma unroll
        for (int i = 0; i < 16; ++i) { g[i] = G[(size_t)(t0 + i) * AW + h * 128 + k]; run += g[i]; cum[i] = run; }
        segtot[seg * 128 + k] = run;
        unsigned short vv[16];
#pragma unroll
        for (int i = 0; i < 16; ++i) vv[i] = VA[(size_t)(t0 + i) * AW + h * 128 + k];
        __syncthreads();
        float pre = 0.f, last = 0.f;
#pragma unroll
        for (int s2 = 0; s2 < 4; ++s2) { const float st = segtot[s2 * 128 + k]; if (s2 < seg) pre += st; last += st; }
        unsigned kd[8], vp[8];
#pragma unroll
        for (int i = 0; i < 8; ++i) {
            const float c0 = cum[2 * i] + pre, c1 = cum[2 * i + 1] + pre;
            const float k0 = -expm1f(g[2 * i]) * __expf(last - c0), k1 = -expm1f(g[2 * i + 1]) * __expf(last - c1);
            kd[i] = pk2(k0, k1); vp[i] = (unsigned)vv[2 * i] | ((unsigned)vv[2 * i + 1] << 16);
        }
        *(LAS u32x4*)(kdT + k * R64 + seg * 32) = (u32x4){kd[0], kd[1], kd[2], kd[3]}; *(LAS u32x4*)(kdT + k * R64 + seg * 32 + 16) = (u32x4){kd[4], kd[5], kd[6], kd[7]};
        *(LAS u32x4*)(vT + k * R64 + seg * 32) = (u32x4){vp[0], vp[1], vp[2], vp[3]}; *(LAS u32x4*)(vT + k * R64 + seg * 32 + 16) = (u32x4){vp[4], vp[5], vp[6], vp[7]};
        if (seg == 0) DL[(size_t)it * 128 + k] = __expf(last);
        __syncthreads();
        f32x4 acc[2][4];
#pragma unroll
        for (int mi = 0; mi < 2; ++mi)
#pragma unroll
            for (int ni = 0; ni < 4; ++ni) acc[mi][ni] = (f32x4){0.f, 0.f, 0.f, 0.f};
        const int fr = lane & 15, fq = lane >> 4;
#pragma unroll
        for (int ks = 0; ks < 2; ++ks) {
            bf16x8 af[2], bfr[4];
#pragma unroll
            for (int mi = 0; mi < 2; ++mi) af[mi] = *(const LAS bf16x8*)(vT + (32 * (w >> 1) + 16 * mi + fr) * R64 + (32 * ks + 8 * fq) * 2);
#pragma unroll
            for (int ni = 0; ni < 4; ++ni) bfr[ni] = *(const LAS bf16x8*)(kdT + (64 * (w & 1) + 16 * ni + fr) * R64 + (32 * ks + 8 * fq) * 2);
#pragma unroll
            for (int mi = 0; mi < 2; ++mi)
#pragma unroll
                for (int ni = 0; ni < 4; ++ni) acc[mi][ni] = __builtin_amdgcn_mfma_f32_16x16x32_bf16(af[mi], bfr[ni], acc[mi][ni], 0, 0, 0);
        }
        float* U = UT + (size_t)it * 16384;
#pragma unroll
        for (int mi = 0; mi < 2; ++mi)
#pragma unroll
            for (int ni = 0; ni < 4; ++ni)
#pragma unroll
                for (int r = 0; r < 4; ++r) U[(32 * (w >> 1) + 16 * mi + 4 * fq + r) * 128 + 64 * (w & 1) + 16 * ni + fr] = acc[mi][ni][r];
        __syncthreads();
    }
}

struct EpiQ {
    unsigned char* ws;
    __device__ __forceinline__ void operator()(f32x4 (&acc)[2][2][4][2], const pg8::Unit& u, int wr, int wc, int fr, int fq) const {
        bf16* O = (bf16*)(ws + (u.pn < 8 ? WS_QABS : WS_RAW)); const int cb = u.pn < 8 ? 0 : 2048;
        EPI_FOREACH({ u32x4 w; w.x = pk2(v0[0], v0[1]); w.y = pk2(v0[2], v0[3]); w.z = pk2(v1[0], v1[1]); w.w = pk2(v1[2], v1[3]); *(u32x4*)(O + (size_t)row * 2048 + col - cb) = w; })
    }
};
__device__ __forceinline__ void p3_scan(const Ctx& C, const Args& a, const float* UT) {
    unsigned char* ws = a.ws;
    const float* DL = (const float*)(ws + WS_DLAST); bf16* SPT = (bf16*)(ws + WS_SPT);
    for (int e = C.wg * NTHR + C.tid; e < BH * 128 * 128; e += C.G * NTHR) {
        const int h = e >> 14, k = e & 127;
        float Sv = 0.f;
        for (int c0 = 0; c0 < NCH; c0 += 16) {
            float u[16], d[16];
#pragma unroll
            for (int j = 0; j < 16; ++j) { u[j] = UT[(size_t)(c0 + j) * (BH * 16384) + e]; d[j] = DL[(size_t)((c0 + j) * BH + h) * 128 + k]; }
#pragma unroll
            for (int j = 0; j < 16; ++j) { SPT[(size_t)(c0 + j) * (BH * 16384) + e] = (bf16)f2bf(Sv); Sv = d[j] * Sv + u[j]; }
        }
    }
}

__device__ __forceinline__ float rows_max(float v) {
    { const auto r = __builtin_amdgcn_permlane32_swap(__builtin_bit_cast(unsigned, v), __builtin_bit_cast(unsigned, v), false, false); const unsigned a0 = r[0], a1 = r[1];
      v = fmaxf(__builtin_bit_cast(float, a0), __builtin_bit_cast(float, a1)); }
    { const auto r = __builtin_amdgcn_permlane16_swap(__builtin_bit_cast(unsigned, v), __builtin_bit_cast(unsigned, v), false, false); const unsigned a0 = r[0], a1 = r[1];
      v = fmaxf(__builtin_bit_cast(float, a0), __builtin_bit_cast(float, a1)); }
    return v;
}
__device__ __forceinline__ float rows_sum(float v) {
    { const auto r = __builtin_amdgcn_permlane32_swap(__builtin_bit_cast(unsigned, v), __builtin_bit_cast(unsigned, v), false, false); const unsigned a0 = r[0], a1 = r[1];
      v = __builtin_bit_cast(float, a0) + __builtin_bit_cast(float, a1); }
    { const auto r = __builtin_amdgcn_permlane16_swap(__builtin_bit_cast(unsigned, v), __builtin_bit_cast(unsigned, v), false, false); const unsigned a0 = r[0], a1 = r[1];
      v = __builtin_bit_cast(float, a0) + __builtin_bit_cast(float, a1); }
    return v;
}
__device__ __forceinline__ int t5_bucket(int rel) {
    const int n = rel < 0 ? -rel : rel; int b = rel > 0 ? 16 : 0;
    const int large = n < 12 ? 8 : n < 16 ? 9 : n < 23 ? 10 : n < 32 ? 11 : n < 46 ? 12 : n < 64 ? 13 : n < 91 ? 14 : 15;
    return b + (n < 8 ? n : large);
}
__device__ __forceinline__ int swz_sigma(int r) { return ((r & 3) << 1) | ((((r >> 3) ^ (r >> 2)) & 1) << 3) | ((r >> 2) & 1); }
__device__ __forceinline__ int lat_off(int row, int c) { return row * 512 + ((((c & 15) ^ swz_sigma(row & 15)) | (c & 16)) << 4); }
constexpr int AT_SIDX = 131072, AT_BIAS = 139264;
__device__ __forceinline__ void attn_setup(const Ctx& C, const Args& a) {
    LAS float* bias2 = (LAS float*)(C.lds + AT_BIAS);
    for (int e = C.tid; e < 2 * 92 * 8; e += NTHR) { const int sg = e / (92 * 8), nn = (e / 8) % 92, h = e & 7; bias2[e] = a.rel_bias[t5_bucket(sg ? nn : -nn) * BH + h]; }
    __syncthreads();
}
__device__ __forceinline__ void attn_one(const Ctx& C, const Args& a, const int t, const int n) {
    unsigned char* ws = a.ws;
    const bf16* QABS = (const bf16*)(ws + WS_QABS); const char* CKVNb = (const char*)(ws + WS_CKVN);
    bf16* OL = (bf16*)(ws + WS_RAW);
    int lane = C.lane; asm volatile("" : "+v"(lane));
    const int w = C.wave, fr = lane & 15, fq = lane >> 4;
    LAS unsigned char* L = C.lds + w * 16384;
    const LAS int* sidx = (const LAS int*)(C.lds + AT_SIDX) + w * 256;
    const LAS float* bias2 = (const LAS float*)(C.lds + AT_BIAS);
    const int q4 = fr >> 2, p4 = fr & 3;
    unsigned aqk[4], apv[8];
    { const int s = swz_sigma(fr); const unsigned b0 = (unsigned)(fr * 512 + 16 * (fq ^ (s & 3))) | (unsigned)(64 * (s >> 2));
#pragma unroll
      for (int k = 0; k < 4; ++k) aqk[k] = (unsigned)(size_t)L + (b0 ^ (unsigned)(64 * k)); }
    { const int rr = 4 * fq + q4, s = swz_sigma(rr & 15); const unsigned b0 = (unsigned)(rr * 512 + 16 * ((p4 >> 1) ^ (s & 1)) + 8 * (p4 & 1)) | (unsigned)(32 * (s >> 1));
#pragma unroll
      for (int k = 0; k < 8; ++k) apv[k] = (unsigned)(size_t)L + (b0 ^ (unsigned)(32 * k)); }
    unsigned c16[16];
#pragma unroll
    for (int i = 0; i < 16; ++i) { const int row = 2 * i + (lane >> 5), pos = lane & 31; c16[i] = (unsigned)(((pos & 16) | ((pos & 15) ^ swz_sigma(row & 15))) << 4); }
    {
        bf16x8 qf[8];
#pragma unroll
        for (int ks = 0; ks < 8; ++ks) { if (fr < BH) qf[ks] = *(const bf16x8*)(QABS + (size_t)t * 2048 + fr * 256 + 32 * ks + 8 * fq); else qf[ks] = (bf16x8){0, 0, 0, 0, 0, 0, 0, 0}; }
        f32x4 oa[16];
#pragma unroll
        for (int i = 0; i < 16; ++i) oa[i] = (f32x4){0.f, 0.f, 0.f, 0.f};
        float m_run = -INFINITY, l_run = 0.f;
        LDS_WAIT();
        for (int ch = 0; ch * 32 < n; ++ch) {
            int sjv[16];
#pragma unroll
            for (int i = 0; i < 16; ++i) sjv[i] = sidx[32 * ch + 2 * i + (lane >> 5)];
#pragma unroll
            for (int i = 0; i < 16; ++i)
                __builtin_amdgcn_global_load_lds((const unsigned*)(CKVNb + (unsigned)(sjv[i] * 512 + (int)c16[i])), (LAS unsigned*)(L + i * 1024), 16, 0, 0);
            const u32x4 s0 = *(const LAS u32x4*)(sidx + 32 * ch + 4 * fq), s1 = *(const LAS u32x4*)(sidx + 32 * ch + 16 + 4 * fq);
            float bv[2][4];
#pragma unroll
            for (int T = 0; T < 2; ++T)
#pragma unroll
                for (int r = 0; r < 4; ++r) { const int rel = (int)(T ? s1[r] : s0[r]) - t; const int nn = rel < 0 ? -rel : rel; bv[T][r] = bias2[((rel > 0 ? 92 : 0) + (nn < 91 ? nn : 91)) * 8 + (fr & 7)]; }
            VM_WAIT();
            f32x4 lg[2] = {{0.f, 0.f, 0.f, 0.f}, {0.f, 0.f, 0.f, 0.f}};
            {
                u32x4 kf[8][2];
#define AT_KRD(ks) do { _Pragma("unroll") for (int T = 0; T < 2; ++T) asm volatile("ds_read_b128 %0, %1 offset:%2" : "=v"(kf[ks][T]) : "v"(aqk[(ks) & 3]), "n"(256 * ((ks) >> 2) + 8192 * T)); } while (0)
                AT_KRD(0); AT_KRD(1); AT_KRD(2); AT_KRD(3); AT_KRD(4); AT_KRD(5);
                asm volatile("s_waitcnt lgkmcnt(4)" : "+v"(kf[0][0]), "+v"(kf[0][1]), "+v"(kf[1][0]), "+v"(kf[1][1]), "+v"(kf[2][0]), "+v"(kf[2][1]), "+v"(kf[3][0]), "+v"(kf[3][1]));
                AT_KRD(6); AT_KRD(7);
#undef AT_KRD
#pragma unroll
                for (int ks = 0; ks < 4; ++ks)
#pragma unroll
                    for (int T = 0; T < 2; ++T) lg[T] = __builtin_amdgcn_mfma_f32_16x16x32_bf16(__builtin_bit_cast(bf16x8, kf[ks][T]), qf[ks], lg[T], 0, 0, 0);
                asm volatile("s_waitcnt lgkmcnt(0)" : "+v"(kf[4][0]), "+v"(kf[4][1]), "+v"(kf[5][0]), "+v"(kf[5][1]), "+v"(kf[6][0]), "+v"(kf[6][1]), "+v"(kf[7][0]), "+v"(kf[7][1]));
#pragma unroll
                for (int ks = 4; ks < 8; ++ks)
#pragma unroll
                    for (int T = 0; T < 2; ++T) lg[T] = __builtin_amdgcn_mfma_f32_16x16x32_bf16(__builtin_bit_cast(bf16x8, kf[ks][T]), qf[ks], lg[T], 0, 0, 0);
            }
            float mx = -INFINITY;
#pragma unroll
            for (int T = 0; T < 2; ++T)
#pragma unroll
                for (int r = 0; r < 4; ++r) { const int j = 32 * ch + 16 * T + 4 * fq + r; float v = lg[T][r] + bv[T][r];
                    v = (j < n) ? v : -INFINITY; lg[T][r] = v; mx = fmaxf(mx, v); }
            mx = rows_max(mx);
            const float m_new = fmaxf(m_run, mx), scale = __expf(m_run - m_new);
            float sm = 0.f;
#pragma unroll
            for (int T = 0; T < 2; ++T)
#pragma unroll
                for (int r = 0; r < 4; ++r) { const float p = __expf(lg[T][r] - m_new); lg[T][r] = p; sm += p; }
            l_run = l_run * scale + sm; m_run = m_new;
            bf16x8 pf; { const unsigned w0 = pk2(lg[0][0], lg[0][1]), w1 = pk2(lg[0][2], lg[0][3]), w2 = pk2(lg[1][0], lg[1][1]), w3 = pk2(lg[1][2], lg[1][3]);
                pf = __builtin_bit_cast(bf16x8, (u32x4){w0, w1, w2, w3}); }
            if (__any(scale != 1.f)) {
#pragma unroll
                for (int ct = 0; ct < 16; ++ct) oa[ct] *= scale; }
            {
                u32x2 lo[16], hi[16];
#define AT_VRD(ct) do { asm volatile("ds_read_b64_tr_b16 %0, %1 offset:%2" : "=v"(lo[ct]) : "v"(apv[(ct) & 7]), "n"(256 * ((ct) >> 3))); \
                        asm volatile("ds_read_b64_tr_b16 %0, %1 offset:%2" : "=v"(hi[ct]) : "v"(apv[(ct) & 7]), "n"(256 * ((ct) >> 3) + 8192)); } while (0)
#define AT_VWAIT(g, cnt) asm volatile("s_waitcnt lgkmcnt(" #cnt ")" : "+v"(lo[4 * (g)]), "+v"(hi[4 * (g)]), "+v"(lo[4 * (g) + 1]), "+v"(hi[4 * (g) + 1]), "+v"(lo[4 * (g) + 2]), "+v"(hi[4 * (g) + 2]), "+v"(lo[4 * (g) + 3]), "+v"(hi[4 * (g) + 3]))
#define AT_VMMA(g) do { _Pragma("unroll") for (int c4 = 4 * (g); c4 < 4 * (g) + 4; ++c4) { const u32x4 cw = {lo[c4].x, lo[c4].y, hi[c4].x, hi[c4].y}; \
                        oa[c4] = __builtin_amdgcn_mfma_f32_16x16x32_bf16(__builtin_bit_cast(bf16x8, cw), pf, oa[c4], 0, 0, 0); } } while (0)
                AT_VRD(0); AT_VRD(1); AT_VRD(2); AT_VRD(3); AT_VRD(4); AT_VRD(5);
                AT_VWAIT(0, 4); AT_VRD(6); AT_VRD(7); AT_VRD(8); AT_VRD(9); AT_VMMA(0);
                AT_VWAIT(1, 4); AT_VRD(10); AT_VRD(11); AT_VRD(12); AT_VRD(13); AT_VMMA(1);
                AT_VWAIT(2, 4); AT_VRD(14); AT_VRD(15); AT_VMMA(2);
                AT_VWAIT(3, 0); AT_VMMA(3);
#undef AT_VRD
#undef AT_VWAIT
#undef AT_VMMA
            }
            LDS_WAIT();
        }
        l_run = rows_sum(l_run);
        if (fr < BH) { const float inv = __builtin_amdgcn_rcpf(l_run); bf16* o = OL + (size_t)t * 2048 + fr * 256 + 4 * fq;
#pragma unroll
            for (int ct = 0; ct < 16; ++ct) { u32x2 pw; pw.x = pk2(oa[ct][0] * inv, oa[ct][1] * inv); pw.y = pk2(oa[ct][2] * inv, oa[ct][3] * inv); *(u32x2*)(o + 16 * ct) = pw; } }
    }
}

__device__ __forceinline__ unsigned fkey(float f) { const unsigned u = __builtin_bit_cast(unsigned, f); return (u & 0x80000000u) ? ~u : (u | 0x80000000u); }
__device__ __forceinline__ void lds_add_u32(LAS unsigned* p, unsigned v) { asm volatile("ds_add_u32 %0, %1" :: "v"((unsigned)(size_t)p), "v"(v) : "memory"); }
constexpr int IX_KBUF = 65536, IX_CAP = 512;
__device__ __noinline__ void select_slow(const float* sc, int nvis, LAS int* idxrow, LAS unsigned* hist, int lane) {
    unsigned prefix = 0u; int need = TOPK;
#pragma unroll 1
    for (int pass = 0; pass < 4; ++pass) {
        const int shift = 24 - 8 * pass;
#pragma unroll
        for (int j = 0; j < 4; ++j) hist[lane * 4 + j] = 0u;
        LDS_WAIT();
        const unsigned himask = pass == 0 ? 0u : (0xffffffffu << (shift + 8));
        for (int i = lane; i < nvis; i += 64) { const unsigned kk = fkey(sc[i]); if ((kk & himask) == (prefix & himask)) __hip_atomic_fetch_add(&hist[(kk >> shift) & 255u], 1u, __ATOMIC_RELAXED, __HIP_MEMORY_SCOPE_WORKGROUP); }
        LDS_WAIT();
        unsigned cnt[4]; unsigned tl = 0u;
#pragma unroll
        for (int j = 0; j < 4; ++j) { cnt[j] = hist[lane * 4 + j]; tl += cnt[j]; }
        unsigned incl = tl;
#pragma unroll
        for (int o = 1; o < 64; o <<= 1) { const unsigned v = __shfl_down(incl, o); if (lane + o < 64) incl += v; }
        unsigned above = incl - tl;
        int dsel = -1; unsigned asel = 0u;
#pragma unroll
        for (int j = 3; j >= 0; --j) { if (dsel < 0 && above < (unsigned)need && above + cnt[j] >= (unsigned)need) { dsel = lane * 4 + j; asel = above; } above += cnt[j]; }
        const unsigned long long bal = __ballot(dsel >= 0);
        const int src = __ffsll((long long)bal) - 1;
        const int d = __shfl(dsel, src); const unsigned ab = __shfl(asel, src);
        need -= (int)ab; prefix |= ((unsigned)d) << shift;
    }
    int base = 0, eqseen = 0;
    for (int i0 = 0; i0 < nvis; i0 += 64) {
        const int i = i0 + lane; const unsigned kk = fkey(sc[i]);
        const bool gt = kk > prefix, eq = kk == prefix;
        const unsigned long long beq = __ballot(eq);
        const unsigned long long lt_mask = (1ull << lane) - 1ull;
        const int eqrank = eqseen + __popcll(beq & lt_mask);
        const bool sel = gt || (eq && eqrank < need);
        const unsigned long long bs = __ballot(sel);
        if (sel) idxrow[base + __popcll(bs & lt_mask)] = i;
        base += __popcll(bs); eqseen += __popcll(beq);
    }
}
__device__ __forceinline__ void p4_indexer(const Ctx& C, const Args& a, float* SCall, unsigned* qc, volatile LAS unsigned* MISC, int& cur) {
    unsigned char* ws = a.ws;
    const bf16* QIDX = (const bf16*)(ws + WS_RAW); const char* KIDXb = (const char*)(ws + WS_KIDX); const float* WIDX = (const float*)(ws + WS_WIDX);
    LAS int* sidx = (LAS int*)(C.lds + AT_SIDX) + C.wave * 256;
    float* SC = SCall + (size_t)C.wg * (8 * 8192);
    LAS unsigned* HIST = (LAS unsigned*)C.lds;
    LAS unsigned char* KBUF = C.lds + IX_KBUF;
    const int tid = C.tid, w = C.wave, quad = w & 1, kg = w >> 1;
    while (cur < 1024) {
        int lane = C.lane; asm volatile("" : "+v"(lane));
        const int r16 = lane & 15, kq = lane >> 4;
        const int tile = 1023 - cur;
        const int q0 = tile * 8, nvis = ((q0 >> 6) + 1) * CHUNK;
        if (nvis <= TOPK) {
            for (int j = lane; j < TOPK; j += 64) sidx[j] = j < nvis ? j : 0;
            LDS_WAIT(); __syncthreads();
            unsigned nxt = 0u; if (tid == 0) nxt = xb_add(qc, 1u);
            attn_one(C, a, q0 + w, nvis);
            if (tid == 0) MISC[MISC_Q4] = nxt;
            LDS_WAIT(); __syncthreads();
            cur = __builtin_amdgcn_readfirstlane((int)MISC[MISC_Q4]);
            continue;
        }
        for (int i = tid; i < 8 * 2048; i += NTHR) HIST[i] = 0u;
        bf16x8 af[4][4];
#pragma unroll
        for (int j = 0; j < 4; ++j) {
            const bf16* qp = QIDX + (size_t)(q0 + 4 * quad + j) * 2048 + r16 * 128 + 8 * kq;
#pragma unroll
            for (int ks = 0; ks < 4; ++ks) af[j][ks] = *(const bf16x8*)(qp + 32 * ks);
        }
        u32x4 wA[2][2];
        { const int grp = r16 >> 2, mem = r16 & 3;
          const f32x4 wv = mem < 2 ? *(const f32x4*)(WIDX + (size_t)(q0 + 4 * quad + 2 * (grp & 1) + mem) * IDXH + 4 * kq) : (f32x4){0.f, 0.f, 0.f, 0.f};
          const unsigned w01 = pk2(wv[0], wv[1]), w23 = pk2(wv[2], wv[3]);
#pragma unroll
          for (int p = 0; p < 2; ++p)
#pragma unroll
              for (int T = 0; T < 2; ++T) { const bool on = (grp == 2 * T + p) && mem < 2;
                  wA[p][T] = (u32x4){(on && mem == 0) ? w01 : 0u, (on && mem == 0) ? w23 : 0u, (on && mem == 1) ? w01 : 0u, (on && mem == 1) ? w23 : 0u}; } }
        const int ntile = nvis >> 5, nstep = (ntile + 3) >> 2;
        const unsigned soffA = (unsigned)((16 * quad + (lane >> 4)) * 256 + (((lane & 15) ^ (lane >> 4)) << 4));
#define IX_STAGE(step_, buf_) do { const int kt_ = 4 * (step_) + kg; if (kt_ < ntile) { const char* sb_ = KIDXb + (size_t)kt_ * 8192; unsigned so_ = soffA; asm volatile("" : "+v"(so_));   \
            _Pragma("unroll") for (int i_ = 0; i_ < 4; ++i_) { \
            __builtin_amdgcn_global_load_lds((const unsigned*)(sb_ + ((so_ ^ (unsigned)(64 * i_)) + (unsigned)(1024 * i_))), (LAS unsigned*)(KBUF + (buf_) * 32768 + kg * 8192 + (4 * quad + i_) * 1024), 16, 0, 0); } } } while (0)
        const unsigned flane = (unsigned)((4 * quad + 2 * (kq & 1)) * 8192 + 16 * (kq >> 1) + r16);
        LAS unsigned* const hlane = HIST + (4 * quad + 2 * (kq & 1)) * 2048;
#define IX_FLUSH(yv, kt_) do { if ((kt_) < ntile) { _Pragma("unroll") for (int j = 0; j < 2; ++j) { float* scb_ = SC + (size_t)((kt_) * 32 + j * 8192); scb_[flane] = yv[j]; \
            const unsigned bin = fkey(yv[j]) >> 20; lds_add_u32(hlane + j * 2048 + (bin >> 1), 1u << (16 * (bin & 1u))); } } } while (0)
        IX_STAGE(0, 0);
        VM_WAIT(); LDS_WAIT(); __builtin_amdgcn_s_barrier();
        float yp[2] = {0.f, 0.f};
        for (int step = 0; step < nstep; ++step) {
            if (step > 0) IX_FLUSH(yp, 4 * (step - 1) + kg);
            if (step + 1 < nstep) IX_STAGE(step + 1, (step + 1) & 1);
            const unsigned tb = (unsigned)(size_t)(KBUF + (step & 1) * 32768 + kg * 8192) + (unsigned)(r16 * 256 + ((kq ^ r16) << 4));
            bf16x8 bfr[2][4];
#pragma unroll
            for (int T = 0; T < 2; ++T)
#pragma unroll
                for (int ks = 0; ks < 4; ++ks) bfr[T][ks] = *(const LAS bf16x8*)(size_t)((tb ^ (unsigned)(64 * ks)) + 4096 * T);
            f32x4 acc[4][2];
#pragma unroll
            for (int j = 0; j < 4; ++j)
#pragma unroll
                for (int T = 0; T < 2; ++T) acc[j][T] = (f32x4){0.f, 0.f, 0.f, 0.f};
#pragma unroll
            for (int ks = 0; ks < 4; ++ks)
#pragma unroll
                for (int j = 0; j < 4; ++j)
#pragma unroll
                    for (int T = 0; T < 2; ++T) acc[j][T] = __builtin_amdgcn_mfma_f32_16x16x32_bf16(af[j][ks], bfr[T][ks], acc[j][T], 0, 0, 0);
            f32x4 y = {0.f, 0.f, 0.f, 0.f};
#pragma unroll
            for (int p = 0; p < 2; ++p)
#pragma unroll
                for (int T = 0; T < 2; ++T) { const f32x4 xa = acc[2 * p][T], xb = acc[2 * p + 1][T];
                    const u32x4 fr4 = {pk2_relu(xa.x, xa.y), pk2_relu(xa.z, xa.w), pk2_relu(xb.x, xb.y), pk2_relu(xb.z, xb.w)};
                    y = __builtin_amdgcn_mfma_f32_16x16x32_bf16(__builtin_bit_cast(bf16x8, wA[p][T]), __builtin_bit_cast(bf16x8, fr4), y, 0, 0, 0); }
            yp[0] = y.x; yp[1] = y.y;
            VM_WAIT(); LDS_WAIT(); __builtin_amdgcn_s_barrier();
        }
        IX_FLUSH(yp, 4 * (nstep - 1) + kg);
        VM_WAIT(); LDS_WAIT();
        __builtin_amdgcn_s_barrier();
#undef IX_STAGE
#undef IX_FLUSH
        for (int rep_q = 0; rep_q < (PROBE_REP == 42 ? 2 : 1); ++rep_q)
        {
            const float* sc = SC + (size_t)w * 8192; LAS int* idxrow = sidx; const unsigned long long lt_mask = (1ull << lane) - 1ull;
            LAS unsigned* hq = HIST + w * 2048;
            unsigned tl = 0u;
#pragma unroll 8
            for (int i = 0; i < 32; ++i) { const unsigned v = hq[lane * 32 + ((i + lane) & 31)]; tl += (v & 0xffffu) + (v >> 16); }
            unsigned incl = tl;
#pragma unroll
            for (int o = 1; o < 64; o <<= 1) { const unsigned v = __shfl_down(incl, o); if (lane + o < 64) incl += v; }
            const unsigned above_l = incl - tl;
            const unsigned long long own = __ballot(above_l < (unsigned)TOPK && above_l + tl >= (unsigned)TOPK);
            const int lo = __ffsll((long long)own) - 1;
            const unsigned above_o = __shfl(above_l, lo);
            const unsigned vw = hq[lo * 32 + (lane >> 1)]; const unsigned cb = (lane & 1) ? (vw >> 16) : (vw & 0xffffu);
            unsigned incl2 = cb;
#pragma unroll
            for (int o = 1; o < 64; o <<= 1) { const unsigned v = __shfl_down(incl2, o); if (lane + o < 64) incl2 += v; }
            const unsigned above_b = above_o + incl2 - cb;
            const unsigned long long ownb = __ballot(above_b < (unsigned)TOPK && above_b + cb >= (unsigned)TOPK);
            const int lb = __ffsll((long long)ownb) - 1;
            const int b1 = lo * 64 + lb; const unsigned ab1 = __shfl(above_b, lb), cn1 = __shfl(cb, lb);
            if (cn1 > (unsigned)IX_CAP) { __builtin_amdgcn_fence(__ATOMIC_ACQUIRE, "agent"); VM_WAIT(); select_slow(sc, nvis, idxrow, hq, lane); }
            else {
                LAS unsigned* cand = (LAS unsigned*)KBUF + w * (2 * IX_CAP);
                const auto scrs = __builtin_amdgcn_make_buffer_rsrc((void*)sc, 0, 8192 * 4, 0x00020000);
                const unsigned klo = (unsigned)b1 << 20, khi = klo + (1u << 20);
                int selbase = 0, cbase = 0;
                for (int i0 = 0; i0 < nvis; i0 += 2048) {
                    f32x4 v[8];
#pragma unroll
                    for (int j = 0; j < 8; ++j) v[j] = __builtin_bit_cast(f32x4, __builtin_amdgcn_raw_buffer_load_b128(scrs, (unsigned)(((i0 + j * 256 + 4 * lane) & 8191) * 4), 0, 16));
#pragma unroll
                    for (int j = 0; j < 8; ++j) { const int e0 = i0 + j * 256 + 4 * lane; const bool valid = e0 < nvis;
#pragma unroll
                        for (int e = 0; e < 4; ++e) { const unsigned kk = fkey(v[j][e]);
                            const bool ge = valid && kk >= klo; const bool sel = ge && (b1 < 4095) && kk >= khi, cd = ge && !sel;
                            const unsigned long long bs = __ballot(sel), bc = __ballot(cd);
                            if (sel) idxrow[selbase + __popcll(bs & lt_mask)] = e0 + e;
                            if (cd) { const int pos = cbase + __popcll(bc & lt_mask); cand[2 * pos] = kk; cand[2 * pos + 1] = (unsigned)(e0 + e); }
                            selbase += __popcll(bs); cbase += __popcll(bc); } }
                }
                LDS_WAIT();
                const int nc = (int)cn1; int need = TOPK - (int)ab1;
                LAS unsigned* h2 = hq;
                unsigned prefix = klo;
#pragma unroll 1
                for (int pass = 0; pass < 3; ++pass) {
                    const int shift = pass == 0 ? 12 : pass == 1 ? 4 : 0; const unsigned dmask = pass == 2 ? 15u : 255u; const unsigned himask = 0xffffffffu << (pass == 0 ? 20 : pass == 1 ? 12 : 4);
#pragma unroll
                    for (int j = 0; j < 4; ++j) h2[lane * 4 + j] = 0u;
                    LDS_WAIT();
                    for (int i = lane; i < nc; i += 64) { const unsigned kk = cand[2 * i]; if ((kk & himask) == (prefix & himask)) __hip_atomic_fetch_add(&h2[(kk >> shift) & dmask], 1u, __ATOMIC_RELAXED, __HIP_MEMORY_SCOPE_WORKGROUP); }
                    LDS_WAIT();
                    unsigned cnt[4]; unsigned tl2 = 0u;
#pragma unroll
                    for (int j = 0; j < 4; ++j) { cnt[j] = h2[lane * 4 + j]; tl2 += cnt[j]; }
                    unsigned inc3 = tl2;
#pragma unroll
                    for (int o = 1; o < 64; o <<= 1) { const unsigned v2 = __shfl_down(inc3, o); if (lane + o < 64) inc3 += v2; }
                    unsigned above = inc3 - tl2; int dsel = -1; unsigned asel = 0u;
#pragma unroll
                    for (int j = 3; j >= 0; --j) { if (dsel < 0 && above < (unsigned)need && above + cnt[j] >= (unsigned)need) { dsel = lane * 4 + j; asel = above; } above += cnt[j]; }
                    const unsigned long long bal = __ballot(dsel >= 0); const int src = __ffsll((long long)bal) - 1;
                    const int d = __shfl(dsel, src); const unsigned ab = __shfl(asel, src);
                    need -= (int)ab; prefix |= ((unsigned)d) << shift;
                }
                int eqseen = 0;
                for (int i0 = 0; i0 < nc; i0 += 64) {
                    const int i = i0 + lane; const bool vi = i < nc; const unsigned kk = vi ? cand[2 * i] : 0u;
                    const bool gt = vi && kk > prefix, eq = vi && kk == prefix;
                    const unsigned long long beq = __ballot(eq);
                    const int eqrank = eqseen + __popcll(beq & lt_mask);
                    const bool sel = gt || (eq && eqrank < need);
                    const unsigned long long bs = __ballot(sel);
                    if (sel) idxrow[selbase + __popcll(bs & lt_mask)] = (int)cand[2 * i + 1];
                    selbase += __popcll(bs); eqseen += __popcll(beq);
                }
            }
        }
        VM_WAIT(); LDS_WAIT(); __syncthreads();
        unsigned nxt = 0u; if (tid == 0) nxt = xb_add(qc, 1u);
        attn_one(C, a, q0 + w, TOPK);
        if (tid == 0) MISC[MISC_Q4] = nxt;
        LDS_WAIT(); __syncthreads();
        cur = __builtin_amdgcn_readfirstlane((int)MISC[MISC_Q4]);
    }
}

__device__ __forceinline__ void p4_hgrn_out(const Ctx& C, const Args& a, unsigned* qc, volatile LAS unsigned* MISC, int& cur) {
    unsigned char* ws = a.ws;
    const float* G = (const float*)(ws + WS_G); bf16* QA = (bf16*)(ws + WS_QA); const bf16* VA = (const bf16*)(ws + WS_VA); const bf16* GA = (const bf16*)(ws + WS_GA);
    const bf16* SPT = (const bf16*)(ws + WS_SPT);
    LAS unsigned char* QI = C.lds;
    LAS unsigned char* QM = QI + 64 * R128;
    LAS unsigned char* KM = QM + 64 * R128;
    LAS unsigned char* vT = KM + 64 * R128;
    LAS unsigned char* SCb = vT + 128 * R64;
    LAS float* segtot = (LAS float*)(SCb + 64 * R64);
    LAS float* rsp = segtot + 8 * 128;
    const int tid = C.tid, lane = C.lane, w = C.wave, fr = lane & 15, fq = lane >> 4;
    while (cur < 1024 + NCH * BH) {
        const int it = cur - 1024;
        unsigned nxt = 0u; if (tid == 0) nxt = xb_add(qc, 1u);
        const int c = it >> 3, h = it & 7;
        bf16x8 sfr[4][4];
        { const bf16* sp0 = SPT + (size_t)it * 16384 + (size_t)(64 * (w & 1) + fr) * 128 + 8 * fq;
#pragma unroll
          for (int ks = 0; ks < 4; ++ks)
#pragma unroll
              for (int ni = 0; ni < 4; ++ni) sfr[ks][ni] = *(const bf16x8*)(sp0 + (size_t)(16 * ni) * 128 + 32 * ks); }
        unsigned short gav[4][4];
#pragma unroll
        for (int r = 0; r < 4; ++r)
#pragma unroll
            for (int ni = 0; ni < 4; ++ni) gav[r][ni] = GA[(size_t)(c * CHUNK + 16 * (w >> 1) + 4 * fq + r) * AW + h * 128 + 64 * (w & 1) + 16 * ni + fr];
        {
            const int k2 = tid & 63, seg = tid >> 6, t0 = c * CHUNK + seg * 8;
            f32x2 g[8], cum[8]; f32x2 run = {0.f, 0.f};
#pragma unroll
            for (int i = 0; i < 8; ++i) { g[i] = *(const f32x2*)(G + (size_t)(t0 + i) * AW + h * 128 + 2 * k2); run += g[i]; cum[i] = run; }
            unsigned qv[8];
#pragma unroll
            for (int i = 0; i < 8; ++i) qv[i] = *(const unsigned*)(QA + (size_t)(t0 + i) * AW + h * 128 + 2 * k2);
            segtot[seg * 128 + 2 * k2] = run.x; segtot[seg * 128 + 2 * k2 + 1] = run.y;
            { const int v = tid & 127, sg = tid >> 7, tv = c * CHUNK + sg * 16; unsigned vp[8];
#pragma unroll
              for (int i = 0; i < 8; ++i) vp[i] = (unsigned)VA[(size_t)(tv + 2 * i) * AW + h * 128 + v] | ((unsigned)VA[(size_t)(tv + 2 * i + 1) * AW + h * 128 + v] << 16);
              *(LAS u32x4*)(vT + v * R64 + sg * 32) = (u32x4){vp[0], vp[1], vp[2], vp[3]}; *(LAS u32x4*)(vT + v * R64 + sg * 32 + 16) = (u32x4){vp[4], vp[5], vp[6], vp[7]}; }
            __syncthreads();
            f32x2 pre = {0.f, 0.f}, cmid = {0.f, 0.f};
#pragma unroll
            for (int s2 = 0; s2 < 8; ++s2) { const f32x2 st = {segtot[s2 * 128 + 2 * k2], segtot[s2 * 128 + 2 * k2 + 1]}; if (s2 < seg) pre += st; if (s2 < 4) cmid += st; }
#pragma unroll
            for (int i = 0; i < 8; ++i) {
                const f32x2 cm = cum[i] + pre; const float q0 = bflo(qv[i]), q1 = bfhi(qv[i]);
                const int row = seg * 8 + i;
                *(LAS unsigned*)(QI + row * R128 + 4 * k2) = pk2(q0 * __expf(cm.x), q1 * __expf(cm.y));
                *(LAS unsigned*)(QM + row * R128 + 4 * k2) = pk2(q0 * __expf(cm.x - cmid.x), q1 * __expf(cm.y - cmid.y));
                *(LAS unsigned*)(KM + row * R128 + 4 * k2) = pk2(-expm1f(g[i].x) * __expf(cmid.x - cm.x), -expm1f(g[i].y) * __expf(cmid.y - cm.y));
            }
        }
        __syncthreads();
        const int tt = w >> 1;
        {
            f32x4 sa[2] = {{0.f, 0.f, 0.f, 0.f}, {0.f, 0.f, 0.f, 0.f}};
#pragma unroll
            for (int ks = 0; ks < 4; ++ks) {
                const bf16x8 qf = *(const LAS bf16x8*)(QM + (16 * tt + fr) * R128 + (32 * ks + 8 * fq) * 2);
#pragma unroll
                for (int si = 0; si < 2; ++si) { const bf16x8 kf = *(const LAS bf16x8*)(KM + (16 * (2 * (w & 1) + si) + fr) * R128 + (32 * ks + 8 * fq) * 2);
                    sa[si] = __builtin_amdgcn_mfma_f32_16x16x32_bf16(qf, kf, sa[si], 0, 0, 0); }
            }
#pragma unroll
            for (int si = 0; si < 2; ++si)
#pragma unroll
                for (int r = 0; r < 4; ++r) { const int t = 16 * tt + 4 * fq + r, s = 16 * (2 * (w & 1) + si) + fr;
                    *(LAS unsigned short*)(SCb + t * R64 + s * 2) = (unsigned short)f2bf(s <= t ? sa[si][r] : 0.f); }
        }
        __syncthreads();
        f32x4 acc[4];
#pragma unroll
        for (int ni = 0; ni < 4; ++ni) acc[ni] = (f32x4){0.f, 0.f, 0.f, 0.f};
        {
#pragma unroll
            for (int ks = 0; ks < 4; ++ks) {
                const bf16x8 qf = *(const LAS bf16x8*)(QI + (16 * tt + fr) * R128 + (32 * ks + 8 * fq) * 2);
#pragma unroll
                for (int ni = 0; ni < 4; ++ni) acc[ni] = __builtin_amdgcn_mfma_f32_16x16x32_bf16(qf, sfr[ks][ni], acc[ni], 0, 0, 0);
            }
#pragma unroll
            for (int ks = 0; ks < 2; ++ks) {
                const bf16x8 pf = *(const LAS bf16x8*)(SCb + (16 * tt + fr) * R64 + (32 * ks + 8 * fq) * 2);
#pragma unroll
                for (int ni = 0; ni < 4; ++ni) { const bf16x8 vf = *(const LAS bf16x8*)(vT + (64 * (w & 1) + 16 * ni + fr) * R64 + (32 * ks + 8 * fq) * 2);
                    acc[ni] = __builtin_amdgcn_mfma_f32_16x16x32_bf16(pf, vf, acc[ni], 0, 0, 0); }
            }
        }
        float ss[4];
#pragma unroll
        for (int r = 0; r < 4; ++r) { float s = 0.f;
#pragma unroll
            for (int ni = 0; ni < 4; ++ni) s += acc[ni][r] * acc[ni][r];
            s += __shfl_xor(s, 1); s += __shfl_xor(s, 2); s += __shfl_xor(s, 4); s += __shfl_xor(s, 8); ss[r] = s; }
        if (fr == 0) {
#pragma unroll
            for (int r = 0; r < 4; ++r) rsp[(16 * tt + 4 * fq + r) * 2 + (w & 1)] = ss[r]; }
        __syncthreads();
#pragma unroll
        for (int r = 0; r < 4; ++r) {
            const int tl = 16 * tt + 4 * fq + r; const float rstd = rsqrtf((rsp[tl * 2] + rsp[tl * 2 + 1]) * (1.f / 128.f) + EPS);
            const size_t rowoff = (size_t)(c * CHUNK + tl) * AW + h * 128;
#pragma unroll
            for (int ni = 0; ni < 4; ++ni) { const int v = 64 * (w & 1) + 16 * ni + fr;
                const unsigned short yv = (unsigned short)f2bf(acc[ni][r] * rstd * a.gnorm_a[v] * bf2f(gav[r][ni])); QA[rowoff + v] = yv; }
        }
        if (tid == 0) MISC[MISC_Q4] = nxt;
        LDS_WAIT(); __syncthreads();
        cur = __builtin_amdgcn_readfirstlane((int)MISC[MISC_Q4]);
    }
}

struct SchedUV {
    pg8::TileOrder T; const char* Ab; const char* Bb;
    __device__ __forceinline__ bool next(int i, pg8::Unit& u) const { u.sub = 0; return T.tile(i, u.pm, u.pn); }
    __device__ __forceinline__ const char* A(const pg8::Unit& u) const { return Ab + ((size_t)u.pm * 256 * 2048 + (size_t)u.pn * 512) * 2; }
    __device__ __forceinline__ const char* B(const pg8::Unit& u) const { return Bb + (size_t)u.pn * 256 * 512 * 2; }
    __device__ __forceinline__ bool keep(const pg8::Unit&) const { return false; }
};
struct EpiUV {
    unsigned char* ws;
    __device__ __forceinline__ void operator()(f32x4 (&acc)[2][2][4][2], const pg8::Unit& u, int wr, int wc, int fr, int fq) const {
        bf16* O = (bf16*)(ws + WS_GB);
        EPI_FOREACH({ const u32x4 gv = *(const u32x4*)(O + (size_t)row * AW + col); u32x4 w;
            w.x = pk2(v0[0] * bflo(gv.x), v0[1] * bfhi(gv.x)); w.y = pk2(v0[2] * bflo(gv.y), v0[3] * bfhi(gv.y)); w.z = pk2(v1[0] * bflo(gv.z), v1[1] * bfhi(gv.z)); w.w = pk2(v1[2] * bflo(gv.w), v1[3] * bfhi(gv.w));
            *(u32x4*)(O + (size_t)row * AW + col) = w; })
    }
};
struct SchedMerge {
    pg8::TileOrder T; const char* Aa; const char* Ab; const char* Ba; const char* Bb;
    __device__ __forceinline__ bool next(int i, pg8::Unit& u) const { u.sub = i & 1; return T.tile(i >> 1, u.pm, u.pn); }
    __device__ __forceinline__ const char* A(const pg8::Unit& u) const { return (u.sub ? Ab : Aa) + (size_t)u.pm * 256 * AW * 2; }
    __device__ __forceinline__ const char* B(const pg8::Unit& u) const { return (u.sub ? Bb : Ba) + (size_t)u.pn * 256 * AW * 2; }
    __device__ __forceinline__ bool keep(const pg8::Unit& u) const { return u.sub == 0; }
};
struct EpiMerge {
    unsigned char* ws;
    __device__ __forceinline__ void operator()(f32x4 (&acc)[2][2][4][2], const pg8::Unit& u, int wr, int wc, int fr, int fq) const {
        const bf16* SA = (const bf16*)(ws + WS_SA); bf16* SB = (bf16*)(ws + WS_SB);
        if (u.sub == 0) {
            EPI_FOREACH({ const u32x4 av = *(const u32x4*)(SA + (size_t)row * D_ + col); const u32x4 bv = *(const u32x4*)(SB + (size_t)row * D_ + col);
                v0[0] *= bflo(av.x) * __builtin_amdgcn_rcpf(bflo(bv.x)); v0[1] *= bfhi(av.x) * __builtin_amdgcn_rcpf(bfhi(bv.x)); v0[2] *= bflo(av.y) * __builtin_amdgcn_rcpf(bflo(bv.y)); v0[3] *= bfhi(av.y) * __builtin_amdgcn_rcpf(bfhi(bv.y));
                v1[0] *= bflo(av.z) * __builtin_amdgcn_rcpf(bflo(bv.z)); v1[1] *= bfhi(av.z) * __builtin_amdgcn_rcpf(bfhi(bv.z)); v1[2] *= bflo(av.w) * __builtin_amdgcn_rcpf(bflo(bv.w)); v1[3] *= bfhi(av.w) * __builtin_amdgcn_rcpf(bfhi(bv.w)); })
        } else {
            EPI_FOREACH({ const u32x4 bv = *(const u32x4*)(SB + (size_t)row * D_ + col); u32x4 w;
                w.x = pk2(v0[0] * bflo(bv.x), v0[1] * bfhi(bv.x)); w.y = pk2(v0[2] * bflo(bv.y), v0[3] * bfhi(bv.y)); w.z = pk2(v1[0] * bflo(bv.z), v1[1] * bfhi(bv.z)); w.w = pk2(v1[2] * bflo(bv.w), v1[3] * bfhi(bv.w));
                *(u32x4*)(SB + (size_t)row * D_ + col) = w; })
        }
    }
};
struct EpiOut {
    const float* x; bf16* ybf; float* RS;
    __device__ __forceinline__ void operator()(f32x4 (&acc)[2][2][4][2], const pg8::Unit& u, int wr, int wc, int fr, int fq) const {
#pragma unroll
        for (int ai = 0; ai < 2; ++ai)
#pragma unroll
            for (int m = 0; m < 4; ++m) { const int row = u.pm * 256 + ai * 128 + wr * 64 + m * 16 + fr; float ss = 0.f;
#pragma unroll
                for (int bj = 0; bj < 2; ++bj) { const int col = u.pn * 256 + bj * 128 + wc * 32 + 8 * fq; const size_t off = (size_t)row * D_ + col;
                    const f32x4 x0 = *(const f32x4*)(x + off), x1 = *(const f32x4*)(x + off + 4); const f32x4 y0 = x0 + acc[ai][bj][m][0], y1 = x1 + acc[ai][bj][m][1];
                    u32x4 pw; pw.x = pk2(y0[0], y0[1]); pw.y = pk2(y0[2], y0[3]); pw.z = pk2(y1[0], y1[1]); pw.w = pk2(y1[2], y1[3]);
                    *(u32x4*)(ybf + off) = pw;
                    ss += (y0[0] * y0[0] + y0[1] * y0[1]) + (y0[2] * y0[2] + y0[3] * y0[3]) + (y1[0] * y1[0] + y1[1] * y1[1]) + (y1[2] * y1[2] + y1[3] * y1[3]); }
                ss += __shfl_xor(ss, 16); ss += __shfl_xor(ss, 32);
                if (fq == 0) atomicAdd(RS + row, ss); }
    }
};
__device__ __forceinline__ void p9_final_norm(const Ctx& C, const Args& a) {
    const float* RS = (const float*)(a.ws + WS_CTL) + RS_WORD; const bf16* YBF = (const bf16*)(a.ws + WS_G);
    const int gw = C.wg * NWAVES + C.wave, NGW = C.G * NWAVES;
    for (int m = gw; m < S_; m += NGW) {
        const float rs = rsqrtf(RS[m] * (1.f / D_) + EPS);
        const u32x4* yr = (const u32x4*)(YBF + (size_t)m * D_) + C.lane; f32x4* orow = (f32x4*)(a.out + (size_t)m * D_); const f32x4* wr = (const f32x4*)a.final_norm_w;
#pragma unroll
        for (int j = 0; j < 4; ++j) { const u32x4 yv = yr[64 * j]; const int c4 = 2 * (C.lane + 64 * j);
            const f32x4 w0 = wr[c4], w1 = wr[c4 + 1];
            f32x4 o0, o1; o0.x = bflo(yv.x) * rs * w0.x; o0.y = bfhi(yv.x) * rs * w0.y; o0.z = bflo(yv.y) * rs * w0.z; o0.w = bfhi(yv.y) * rs * w0.w;
            o1.x = bflo(yv.z) * rs * w1.x; o1.y = bfhi(yv.z) * rs * w1.y; o1.z = bflo(yv.w) * rs * w1.z; o1.w = bfhi(yv.w) * rs * w1.w;
            orow[c4] = o0; orow[c4 + 1] = o1; }
    }
}

#ifndef MK_N_LAUNCHES
#define MK_N_LAUNCHES 1
#endif
constexpr int N_PHASES = 10;
__global__ void __launch_bounds__(NTHR, 2) mega_fwd(Args a) {
    extern __shared__ __attribute__((aligned(16))) unsigned char lds_raw[];
    Ctx C; C.lds = (LAS unsigned char*)lds_raw; C.tid = threadIdx.x; C.lane = C.tid & 63; C.wave = __builtin_amdgcn_readfirstlane(C.tid >> 6); C.wg = blockIdx.x; C.G = gridDim.x;
    volatile LAS unsigned* MISC = (volatile LAS unsigned*)(C.lds + MISC_OFF);
    if (C.tid < 32) MISC[C.tid] = 0u;
    __syncthreads();
    unsigned char* ws = a.ws;
    XcdBarrier bar; bar.bar = (unsigned*)(ws + WS_CTL) + CW_BAR; bar.x = 0; bar.st = nullptr;
    const int lo = a.ph_lo, hi = a.ph_hi;
    if (hi - lo > 1) bar = xcd_barrier_post((unsigned*)(ws + WS_CTL) + CW_BAR, MISC + 8);
#define IN(k) (lo <= (k) && (k) < hi)
#define SEAM(k) do { if (IN(k) && IN((k) + 1)) xcd_barrier(bar); } while (0)
    float* dscr = a.out;
    if (IN(0)) { REP(0) p0_prep(C, a); } SEAM(0);
    if (IN(1)) {
        SchedPlain S; S.T.init(S_, NIN, C.G, C.wg); S.Ab = (const char*)(ws + WS_H); S.Bb = (const char*)(ws + WS_WIN); S.tA = (size_t)256 * D_ * 2; S.tB = (size_t)256 * D_ * 2;
        EpiProj E{ws}; REP(1) pg8::gemm_phase(C.lds, D_, D_, D_, S, E);
    } SEAM(1);
    if (IN(2)) { REP(2) p2_norms(C, a); REP(12) p2_hgrn_states(C, a, dscr); } SEAM(2);
    if (IN(3)) {
        SchedPlain S; S.T.init(S_, 4096, C.G, C.wg); S.Ab = (const char*)(ws + WS_CQN); S.Bb = (const char*)(ws + WS_WQ); S.tA = (size_t)256 * QR * 2; S.tB = (size_t)256 * QR * 2;
        EpiQ E{ws}; REP(3) pg8::gemm_phase(C.lds, QR, QR, QR, S, E);
        REP(13) p3_scan(C, a, dscr);
    } SEAM(3);
    if (IN(4)) {
        unsigned* qc = (unsigned*)(ws + WS_CTL) + CW_Q4;
        if (C.tid == 0) MISC[MISC_Q4] = xb_add(qc, 1u);
        attn_setup(C, a);
        int cur = __builtin_amdgcn_readfirstlane((int)MISC[MISC_Q4]);
        p4_indexer(C, a, dscr, qc, MISC, cur); p4_hgrn_out(C, a, qc, MISC, cur);
    } SEAM(4);
    if (IN(6)) {
        SchedUV S; S.T.init(S_, AW, C.G, C.wg); S.Ab = (const char*)(ws + WS_RAW); S.Bb = (const char*)(ws + WS_WUV);
        EpiUV E{ws}; pg8::gemm_phase(C.lds, 2048, 512, 512, S, E);
    } SEAM(6);
    if (IN(7)) {
        SchedMerge S; S.T.init(S_, D_, C.G, C.wg); S.Aa = (const char*)(ws + WS_QA); S.Ab = (const char*)(ws + WS_GB); S.Ba = (const char*)(ws + WS_WPA); S.Bb = (const char*)(ws + WS_WPB);
        EpiMerge E{ws}; pg8::gemm_phase(C.lds, AW, AW, AW, S, E);
    } SEAM(7);
    if (IN(8)) {
        SchedPlain S; S.T.init(S_, D_, C.G, C.wg); S.Ab = (const char*)(ws + WS_SB); S.Bb = (const char*)(ws + WS_WOUT); S.tA = (size_t)256 * D_ * 2; S.tB = (size_t)256 * D_ * 2;
        EpiOut E{a.x, (bf16*)(ws + WS_G), (float*)(ws + WS_CTL) + RS_WORD}; pg8::gemm_phase(C.lds, D_, D_, D_, S, E);
    } SEAM(8);
    if (IN(9)) { p9_final_norm(C, a); }
#undef IN
#undef SEAM
}

extern "C" void kernel_launch(void* const* d_in, const int* in_sizes, int n_in, void* d_out, int out_size, void* d_ws, size_t ws_size, hipStream_t stream) {
    static int grid = 0;
    if (grid == 0) {
        if (n_in != 17 || in_sizes[0] != S_ * D_ || out_size != S_ * D_ || ws_size < WS_END) {
            fprintf(stderr, "kernel_launch: unexpected shapes / workspace (n_in %d, in0 %d, out %d, ws %zu < %zu); nothing launched\n", n_in, n_in > 0 ? in_sizes[0] : -1, out_size, ws_size, (size_t)WS_END); grid = -1; return; }
        int dev = 0, cus = 0;
        if (hipGetDevice(&dev) != hipSuccess || hipDeviceGetAttribute(&cus, hipDeviceAttributeMultiprocessorCount, dev) != hipSuccess) { grid = -1; return; }
        if (hipFuncSetAttribute((const void*)mega_fwd, hipFuncAttributeMaxDynamicSharedMemorySize, LDS_BYTES) != hipSuccess) { fprintf(stderr, "kernel_launch: hipFuncSetAttribute failed\n"); grid = -1; return; }
        (void)hipGetLastError();
        grid = cus;
    }
    if (grid < 0) return;
    (void)hipMemsetAsync((char*)d_ws + WS_CTL, 0, CTL_ZERO_BYTES, stream);
    Args a{};
    const float** ip = (const float**)&a;
    for (int i = 0; i < 17; ++i) ip[i] = (const float*)d_in[i];
    a.out = (float*)d_out; a.ws = (unsigned char*)d_ws;
    constexpr int NL = MK_N_LAUNCHES;
    for (int li = 0; li < NL; ++li) {
        a.ph_lo = li * N_PHASES / NL; a.ph_hi = (li + 1) * N_PHASES / NL;
        hipLaunchKernelGGL(mega_fwd, dim3(grid), dim3(NTHR), LDS_BYTES, stream, a);
    }
}
```

```cpp
#include <hip/hip_runtime.h>
#include <cstdio>

#define LAS __attribute__((address_space(3)))
#define GAS __attribute__((address_space(1)))
typedef unsigned short bf16;
typedef short bf16x8 __attribute__((ext_vector_type(8)));
typedef short s16x4 __attribute__((ext_vector_type(4)));
typedef float f32x4 __attribute__((ext_vector_type(4)));
typedef float f32x2 __attribute__((ext_vector_type(2)));
typedef float f32x16 __attribute__((ext_vector_type(16)));
typedef unsigned u32x4 __attribute__((ext_vector_type(4)));
typedef unsigned u32x2 __attribute__((ext_vector_type(2)));

namespace pg8 {
constexpr int BM = 256, BK = 64, HALF = 128, HTB = HALF * BK * 2, STAGE_BYTES = 8 * HTB, NXCD = 8, WGM = 8;
__device__ __forceinline__ int lds_byte(int r, int c) { const int st = (r >> 4) * 2 + (c >> 5), rr = r & 15, cc = c & 31, ob = rr * 64 + cc * 2; return st * 1024 + (ob ^ (((ob >> 9) & 1) << 5)); }
__device__ __forceinline__ void stage_rc(int b, int& R, int& C) { const int st = b / 1024, sb = b % 1024, swz = sb ^ (((sb >> 9) & 1) << 5); R = (st >> 1) * 16 + swz / 64; C = (st & 1) * 32 + (swz % 64) / 2; }
__device__ __forceinline__ int perm32(int rho) { const int n = rho >> 4, i = rho & 15; return 8 * (i >> 2) + 4 * n + (i & 3); }
struct Unit { int pm, pn, sub; };
struct TileOrder {
    int nM, nN, nwg, G, c;
    __device__ void init(int M, int N, int G_, int c_) { nM = M / BM; nN = N / BM; nwg = nM * nN; G = G_; c = c_; }
    __device__ bool tile(int i, int& pm, int& pn) const {
        const long L = (long)i * G + c; if (L >= nwg) return false;
        int wgid = (int)L; { const int q = nwg / NXCD, r = nwg % NXCD, xcd = wgid % NXCD, off = wgid / NXCD; wgid = (xcd < r ? xcd * (q + 1) : r * (q + 1) + (xcd - r) * q) + off; }
        const int nig = WGM * nN, gid = wgid / nig, fm = gid * WGM, gsz = (nM - fm) < WGM ? (nM - fm) : WGM;
        pm = fm + ((wgid % nig) % gsz); pn = (wgid % nig) / gsz; return true;
    }
};
template <class Epi, class Sched, bool ALIGN_EPI = true, bool SP2 = true>
__device__ __forceinline__ void gemm_phase(LAS unsigned char* lds, const int lda, const int ldb, const int K, const Sched& S, const Epi& E) {
    const int tid = threadIdx.x, wid = __builtin_amdgcn_readfirstlane(tid >> 6), lane = tid & 63, wr = wid >> 2, wc = wid & 3, fr = lane & 15, fq = lane >> 4;
    const int nt = K / BK;
    unsigned voffA[2], voffB[2];
#pragma unroll
    for (int i = 0; i < 2; ++i) { int R, C; stage_rc(tid * 16 + i * 8192, R, C); const int Rb = (R & ~31) + perm32(R & 31);
        voffA[i] = (unsigned)(R * lda + C) * 2u; voffB[i] = (unsigned)(Rb * ldb + C) * 2u; }
    const size_t kstep = (size_t)(BK * 2);
    const size_t hstepA = (size_t)HALF * lda * 2, hstepB = (size_t)HALF * ldb * 2;
    const unsigned ldsw = (unsigned)wid * 1024u;
    const int aoff = lds_byte(wr * 64 + fr, fq * 8), boff = lds_byte(wc * 32 + fr, fq * 8);
#define PG8_SA(b, h) (((b) * 2 + (h)) * HTB)
#define PG8_SB(b, h) ((4 + (b) * 2 + (h)) * HTB)
#define PG8_STAGE(bufoff, gbase, voff) do { _Pragma("unroll") for (int _i = 0; _i < 2; ++_i) \
        __builtin_amdgcn_global_load_lds((const unsigned*)((const char*)(gbase) + (voff)[_i]), (LAS unsigned*)(lds + (bufoff) + ldsw + _i * 8192), 16, 0, 0); } while (0)
#define PG8_LDA(dst, b, h) do { _Pragma("unroll") for (int m = 0; m < 4; ++m) _Pragma("unroll") for (int k = 0; k < 2; ++k) dst[m][k] = *(const LAS bf16x8*)(lds + PG8_SA(b, h) + aoff + m * 2048 + k * 1024); } while (0)
#define PG8_LDB(dst, b, h) do { _Pragma("unroll") for (int n = 0; n < 2; ++n) _Pragma("unroll") for (int k = 0; k < 2; ++k) dst[n][k] = *(const LAS bf16x8*)(lds + PG8_SB(b, h) + boff + n * 2048 + k * 1024); } while (0)
#define PG8_MMA(ai, bj, At, Bt) do { __builtin_amdgcn_s_setprio(1); _Pragma("unroll") for (int m = 0; m < 4; ++m) _Pragma("unroll") for (int n = 0; n < 2; ++n) _Pragma("unroll") for (int k = 0; k < 2; ++k) \
        acc[ai][bj][m][n] = __builtin_amdgcn_mfma_f32_16x16x32_bf16(Bt[n][k], At[m][k], acc[ai][bj][m][n], 0, 0, 0); __builtin_amdgcn_s_setprio(0); } while (0)
#define PG8_WAIT_V(n) asm volatile("s_waitcnt vmcnt(" #n ")" ::: "memory")
#define PG8_WAIT_L(n) asm volatile("s_waitcnt lgkmcnt(" #n ")" ::: "memory")
#define PG8_BAR __builtin_amdgcn_s_barrier()
#define PG8_SCHED __builtin_amdgcn_sched_barrier(0)
    Unit cur, nxt; int ui = 0;
    if (!S.next(0, cur)) return;
    f32x4 acc[2][2][4][2];
#pragma unroll
    for (int a = 0; a < 2; ++a)
#pragma unroll
        for (int b = 0; b < 2; ++b)
#pragma unroll
            for (int m = 0; m < 4; ++m)
#pragma unroll
                for (int n = 0; n < 2; ++n) acc[a][b][m][n] = (f32x4){0.f, 0.f, 0.f, 0.f};
    bf16x8 At[4][2], B0[2][2], B1[2][2];
    const char* cA = S.A(cur); const char* cB = S.B(cur);
    if constexpr (SP2) {
        PG8_STAGE(PG8_SB(0, 0), cB, voffB); PG8_STAGE(PG8_SB(0, 1), cB + hstepB, voffB); PG8_STAGE(PG8_SA(0, 0), cA, voffA); PG8_STAGE(PG8_SA(0, 1), cA + hstepA, voffA);
        if (wr == 1) PG8_BAR;
        PG8_WAIT_V(2); PG8_BAR;
        PG8_STAGE(PG8_SB(1, 0), cB + kstep, voffB); PG8_STAGE(PG8_SA(1, 0), cA + kstep, voffA); PG8_STAGE(PG8_SB(1, 1), cB + hstepB + kstep, voffB);
        PG8_WAIT_V(6); PG8_BAR;
    } else {
        PG8_STAGE(PG8_SB(0, 0), cB, voffB); PG8_STAGE(PG8_SA(0, 0), cA, voffA); PG8_STAGE(PG8_SB(0, 1), cB + hstepB, voffB); PG8_STAGE(PG8_SA(0, 1), cA + hstepA, voffA);
        if (wr == 1) PG8_BAR;
        PG8_WAIT_V(4); PG8_BAR;
        PG8_STAGE(PG8_SB(1, 0), cB + kstep, voffB); PG8_STAGE(PG8_SA(1, 0), cA + kstep, voffA); PG8_STAGE(PG8_SB(1, 1), cB + hstepB + kstep, voffB);
        PG8_WAIT_V(6); PG8_BAR;
    }
    for (;;) {
        const bool has_next = S.next(ui + 1, nxt);
        const char* nA = has_next ? S.A(nxt) : cA; const char* nB = has_next ? S.B(nxt) : cB;
        for (int t = 0; t < nt; t += 2) {
            const bool last = (t == nt - 2);
            const char* a1 = cA + (size_t)(t + 1) * kstep;
            const char* a2 = last ? nA : cA + (size_t)(t + 2) * kstep; const char* b2 = last ? nB : cB + (size_t)(t + 2) * kstep;
            const char* a3 = a2 + kstep; const char* b3 = b2 + kstep;
            if constexpr (SP2) {
            PG8_LDB(B0, 0, 0); PG8_LDB(B1, 0, 1); PG8_SCHED; PG8_LDA(At, 0, 0); PG8_STAGE(PG8_SA(1, 1), a1 + hstepA, voffA);
            PG8_WAIT_V(8); PG8_WAIT_L(0); PG8_BAR; PG8_MMA(0, 0, At, B0); PG8_MMA(0, 1, At, B1); PG8_BAR; PG8_SCHED;
            PG8_LDA(At, 0, 1); PG8_STAGE(PG8_SB(0, 0), b2, voffB); PG8_STAGE(PG8_SB(0, 1), b2 + hstepB, voffB); PG8_STAGE(PG8_SA(0, 0), a2, voffA);
            PG8_WAIT_V(8); PG8_WAIT_L(0); PG8_BAR; PG8_MMA(1, 0, At, B0); PG8_MMA(1, 1, At, B1); PG8_BAR; PG8_SCHED;
            PG8_LDB(B0, 1, 0); PG8_LDB(B1, 1, 1); PG8_SCHED; PG8_LDA(At, 1, 0); PG8_STAGE(PG8_SA(0, 1), a2 + hstepA, voffA);
            PG8_WAIT_V(8); PG8_WAIT_L(0); PG8_BAR; PG8_MMA(0, 0, At, B0); PG8_MMA(0, 1, At, B1); PG8_BAR; PG8_SCHED;
            PG8_LDA(At, 1, 1); PG8_STAGE(PG8_SB(1, 0), b3, voffB); PG8_STAGE(PG8_SB(1, 1), b3 + hstepB, voffB); PG8_STAGE(PG8_SA(1, 0), a3, voffA);
            PG8_WAIT_V(8); PG8_WAIT_L(0); PG8_BAR; PG8_MMA(1, 0, At, B0); PG8_MMA(1, 1, At, B1); PG8_BAR; PG8_SCHED;
            } else {
            PG8_LDB(B0, 0, 0); PG8_SCHED; PG8_LDA(At, 0, 0); PG8_STAGE(PG8_SA(1, 1), a1 + hstepA, voffA);
            PG8_WAIT_L(8); PG8_BAR; PG8_WAIT_L(0); PG8_MMA(0, 0, At, B0); PG8_BAR; PG8_SCHED;
            PG8_LDB(B1, 0, 1); PG8_STAGE(PG8_SB(0, 0), b2, voffB);
            PG8_BAR; PG8_WAIT_L(0); PG8_MMA(0, 1, At, B1); PG8_BAR;
            PG8_LDA(At, 0, 1); PG8_STAGE(PG8_SA(0, 0), a2, voffA);
            PG8_BAR; PG8_WAIT_L(0); PG8_MMA(1, 0, At, B0); PG8_BAR; PG8_SCHED;
            PG8_STAGE(PG8_SB(0, 1), b2 + hstepB, voffB);
            PG8_WAIT_V(6); PG8_BAR; PG8_MMA(1, 1, At, B1); PG8_BAR;
            PG8_LDB(B0, 1, 0); PG8_SCHED; PG8_LDA(At, 1, 0); PG8_STAGE(PG8_SA(0, 1), a2 + hstepA, voffA);
            PG8_WAIT_L(8); PG8_BAR; PG8_WAIT_L(0); PG8_MMA(0, 0, At, B0); PG8_BAR; PG8_SCHED;
            PG8_LDB(B1, 1, 1); PG8_STAGE(PG8_SB(1, 0), b3, voffB);
            PG8_BAR; PG8_WAIT_L(0); PG8_MMA(0, 1, At, B1); PG8_BAR;
            PG8_LDA(At, 1, 1); PG8_STAGE(PG8_SA(1, 0), a3, voffA);
            PG8_BAR; PG8_WAIT_L(0); PG8_MMA(1, 0, At, B0); PG8_BAR; PG8_SCHED;
            PG8_STAGE(PG8_SB(1, 1), b3 + hstepB, voffB);
            PG8_WAIT_V(6); PG8_BAR; PG8_MMA(1, 1, At, B1); PG8_BAR;
            }
        }
        if constexpr (ALIGN_EPI) { if (wr == 0) PG8_BAR; }
        E(acc, cur, wr, wc, fr, fq);
        if (!has_next) break;
        if (!S.keep(cur)) {
#pragma unroll
            for (int a = 0; a < 2; ++a)
#pragma unroll
                for (int b = 0; b < 2; ++b)
#pragma unroll
                    for (int m = 0; m < 4; ++m)
#pragma unroll
                        for (int n = 0; n < 2; ++n) acc[a][b][m][n] = (f32x4){0.f, 0.f, 0.f, 0.f};
        }
        cur = nxt; cA = nA; cB = nB; ++ui;
        if constexpr (ALIGN_EPI) { if (wr == 1) PG8_BAR; }
    }
    PG8_WAIT_V(0);
    if constexpr (!ALIGN_EPI) { if (wr == 0) PG8_BAR; }
    PG8_BAR;
#undef PG8_SA
#undef PG8_SB
#undef PG8_STAGE
#undef PG8_LDA
#undef PG8_LDB
#undef PG8_MMA
#undef PG8_WAIT_V
#undef PG8_WAIT_L
#undef PG8_BAR
#undef PG8_SCHED
}
}

#ifndef PROBE_REP
#define PROBE_REP -1
#endif
#define REP(k) for (int _r = 0; _r < ((k) == PROBE_REP ? 2 : 1); ++_r)
constexpr int S_ = 8192, D_ = 2048, AW = 1024, QR = 512, KVR = 256, IDXD = 128, IDXH = 16, BH = 8, TOPK = 256, CHUNK = 64, NCH = S_ / CHUNK;
constexpr int IN_W = 10128, NIN = 10240;
constexpr float EPS = 1e-6f;
constexpr int NWAVES = 8, NTHR = 512;

constexpr size_t MiB = 1u << 20;
constexpr size_t WS_CTL = 0, CTL_ZERO_BYTES = 1 * MiB;
constexpr size_t WS_LB = 1 * MiB;
constexpr size_t WS_NCNT = 1 * MiB + 64 * 1024;
constexpr size_t WS_DLAST = 1 * MiB + 128 * 1024;
constexpr size_t WS_WIDX = 2 * MiB;
constexpr size_t WS_WQ = 4 * MiB;
constexpr size_t WS_WUV = 8 * MiB;
constexpr size_t WS_WPA = 9 * MiB, WS_WPB = 13 * MiB;
constexpr size_t WS_WOUT = 17 * MiB;
constexpr size_t WS_QA = 25 * MiB;
constexpr size_t WS_G = 41 * MiB;
constexpr size_t WS_VA = 73 * MiB;
constexpr size_t WS_GA = 89 * MiB;
constexpr size_t WS_GB = 105 * MiB;
constexpr size_t WS_SA = 121 * MiB;
constexpr size_t WS_SB = 153 * MiB;
constexpr size_t WS_RAW = 185 * MiB;
constexpr size_t WS_H = 217 * MiB;
constexpr size_t WS_CQN = 217 * MiB, WS_CKVN = 225 * MiB, WS_KIDX = 229 * MiB, WS_IDX = 231 * MiB;
constexpr size_t WS_WIN = 249 * MiB;
constexpr size_t WS_QABS = 249 * MiB;
constexpr size_t WS_SPT = 281 * MiB;
constexpr size_t WS_END = 313 * MiB;
constexpr int RS_WORD = 65536;
constexpr int CW_BAR = 4096;
constexpr int CW_Q4 = 8192;
constexpr int MISC_Q4 = 16;

typedef __bf16 bf16x2_t __attribute__((ext_vector_type(2)));
typedef short s16x2 __attribute__((ext_vector_type(2)));
__device__ __forceinline__ unsigned pk2(float lo, float hi) { const f32x2 v = {lo, hi}; return __builtin_bit_cast(unsigned, __builtin_convertvector(v, bf16x2_t)); }
__device__ __forceinline__ unsigned f2bf(float f) { return pk2(f, 0.f) & 0xffffu; }
__device__ __forceinline__ unsigned pk2_relu(float lo, float hi) { const f32x2 v = {lo, hi}; const s16x2 z = {0, 0};
    return __builtin_bit_cast(unsigned, __builtin_elementwise_max(__builtin_bit_cast(s16x2, __builtin_convertvector(v, bf16x2_t)), z)); }
__device__ __forceinline__ float bf2f(unsigned short b) { return __builtin_bit_cast(float, ((unsigned)b) << 16); }
__device__ __forceinline__ float bflo(unsigned w) { return __builtin_bit_cast(float, w << 16); }
__device__ __forceinline__ float bfhi(unsigned w) { return __builtin_bit_cast(float, w & 0xffff0000u); }
template <int CTRL, int ROWMASK, bool BOUND> __device__ __forceinline__ unsigned dpp_mov(unsigned x) { return (unsigned)__builtin_amdgcn_update_dpp(0, (int)x, CTRL, ROWMASK, 0xf, BOUND); }
__device__ __forceinline__ float row16_sum(float v) {
    v += __builtin_bit_cast(float, dpp_mov<0x128, 0xf, false>(__builtin_bit_cast(unsigned, v)));
    v += __builtin_bit_cast(float, dpp_mov<0x124, 0xf, false>(__builtin_bit_cast(unsigned, v)));
    v += __builtin_bit_cast(float, dpp_mov<0x122, 0xf, false>(__builtin_bit_cast(unsigned, v)));
    v += __builtin_bit_cast(float, dpp_mov<0x121, 0xf, false>(__builtin_bit_cast(unsigned, v)));
    return v;
}
__device__ __forceinline__ float rows_sum(float v) {
    { const auto r = __builtin_amdgcn_permlane32_swap(__builtin_bit_cast(unsigned, v), __builtin_bit_cast(unsigned, v), false, false); const unsigned a0 = r[0], a1 = r[1];
      v = __builtin_bit_cast(float, a0) + __builtin_bit_cast(float, a1); }
    { const auto r = __builtin_amdgcn_permlane16_swap(__builtin_bit_cast(unsigned, v), __builtin_bit_cast(unsigned, v), false, false); const unsigned a0 = r[0], a1 = r[1];
      v = __builtin_bit_cast(float, a0) + __builtin_bit_cast(float, a1); }
    return v;
}
__device__ __forceinline__ float rows_max(float v) {
    { const auto r = __builtin_amdgcn_permlane32_swap(__builtin_bit_cast(unsigned, v), __builtin_bit_cast(unsigned, v), false, false); const unsigned a0 = r[0], a1 = r[1];
      v = fmaxf(__builtin_bit_cast(float, a0), __builtin_bit_cast(float, a1)); }
    { const auto r = __builtin_amdgcn_permlane16_swap(__builtin_bit_cast(unsigned, v), __builtin_bit_cast(unsigned, v), false, false); const unsigned a0 = r[0], a1 = r[1];
      v = fmaxf(__builtin_bit_cast(float, a0), __builtin_bit_cast(float, a1)); }
    return v;
}
__device__ __forceinline__ float wave_sum(float v) { return rows_sum(row16_sum(v)); }
__device__ __forceinline__ unsigned wave_scan_incl(unsigned x) {
    x += dpp_mov<0x111, 0xf, true>(x); x += dpp_mov<0x112, 0xf, true>(x); x += dpp_mov<0x114, 0xf, true>(x); x += dpp_mov<0x118, 0xf, true>(x);
    x += dpp_mov<0x142, 0xa, false>(x); x += dpp_mov<0x143, 0xc, false>(x);
    return x;
}
__device__ __forceinline__ unsigned wave_above(unsigned x) { const unsigned pi = wave_scan_incl(x); return (unsigned)__builtin_amdgcn_readlane((int)pi, 63) - pi; }
__device__ __forceinline__ unsigned lane_get(unsigned x, int l) { return (unsigned)__builtin_amdgcn_readlane((int)x, l); }
__device__ __forceinline__ float sigmoidf_(float x) { return __builtin_amdgcn_rcpf(1.0f + __expf(-x)); }
__device__ __forceinline__ float siluf_(float x) { return x * __builtin_amdgcn_rcpf(1.0f + __expf(-x)); }
#define LDS_WAIT() asm volatile("s_waitcnt lgkmcnt(0)" ::: "memory")
#define VM_WAIT() asm volatile("s_waitcnt vmcnt(0)" ::: "memory")

#define XB_TMO      128
#define XB_XCNT(j)  (256  + 64 * (j))
#define XB_XSUB(j)  (1280 + 64 * (j))
#define XB_XGEN(j)  (2304 + 64 * (j))
#define XB_TOP      3328
#define XB_TOPGEN   3392
#define XCD_BAR_WORDS 3456
#define XB_SPIN_CAP (1u << 22)
__device__ __forceinline__ unsigned xb_ld(unsigned* p)              { return __hip_atomic_load(p, __ATOMIC_RELAXED, __HIP_MEMORY_SCOPE_AGENT); }
__device__ __forceinline__ unsigned xb_add(unsigned* p, unsigned v) { return __hip_atomic_fetch_add(p, v, __ATOMIC_RELAXED, __HIP_MEMORY_SCOPE_AGENT); }
__device__ __forceinline__ unsigned xb_xcc_id() { return (unsigned)__builtin_amdgcn_s_getreg((3 << 11) | 20) & 0xFu; }
#define XB_SPIN(cond, bar) do { unsigned _sp = 0; while (cond) { __builtin_amdgcn_s_sleep(1); \
    if ((++_sp & 255u) == 0u) { if (xb_ld(&(bar)[XB_TMO])) break; if (_sp > XB_SPIN_CAP) { atomicAdd(&(bar)[XB_TMO], 1u); break; } } } } while (0)
struct XcdBarrier { unsigned* bar; unsigned x; volatile LAS unsigned* st; };
__device__ __forceinline__ XcdBarrier xcd_barrier_post(unsigned* bar, volatile LAS unsigned* st) {
    XcdBarrier b; b.bar = bar; b.x = xb_xcc_id(); b.st = st;
    if (threadIdx.x == 0) (void)xb_add(&bar[XB_XCNT(b.x)], 1u);
    return b;
}
__device__ __forceinline__ void xcd_barrier_complete(unsigned* bar, unsigned x, unsigned& nloc, unsigned& nx) {
    const unsigned G = gridDim.x * gridDim.y * gridDim.z;
    unsigned sum, cnt, mine, sp = 0u;
    for (;;) {
        sum = 0u; cnt = 0u; mine = 0u;
#pragma unroll
        for (unsigned j = 0; j < 16; ++j) { const unsigned c = xb_ld(&bar[XB_XCNT(j)]); sum += c; cnt += (c > 0u) ? 1u : 0u; mine = (j == x) ? c : mine; }
        if (sum == G) break;
        __builtin_amdgcn_s_sleep(1);
        if ((++sp & 255u) == 0u) { if (xb_ld(&bar[XB_TMO])) break; if (sp > XB_SPIN_CAP) { atomicAdd(&bar[XB_TMO], 1u); break; } }
    }
    nloc = mine > 0u ? mine : 1u; nx = cnt > 0u ? cnt : 1u;
}
__device__ __forceinline__ void xcd_barrier(const XcdBarrier& b) {
    asm volatile("s_waitcnt vmcnt(0)" ::: "memory");
    __syncthreads();
    if (threadIdx.x == 0) {
        unsigned* bar = b.bar;
        __builtin_amdgcn_s_waitcnt(0);
        unsigned nloc = b.st[0], nx = b.st[1];
        if (nloc == 0u) { xcd_barrier_complete(bar, b.x, nloc, nx); b.st[0] = nloc; b.st[1] = nx; }
        const unsigned old = xb_add(&bar[XB_XSUB(b.x)], 1u);
        const unsigned gen = old / nloc;
        if (old + 1u == (gen + 1u) * nloc) {
            __builtin_amdgcn_fence(__ATOMIC_RELEASE, "agent");
            asm volatile("s_waitcnt vmcnt(0)" ::: "memory");
            const unsigned og = xb_add(&bar[XB_TOP], 1u);
            const unsigned tg = og / nx;
            if (og + 1u == (tg + 1u) * nx) xb_add(&bar[XB_TOPGEN], 1u);
            else XB_SPIN(xb_ld(&bar[XB_TOPGEN]) == tg, bar);
            __builtin_amdgcn_fence(__ATOMIC_ACQUIRE, "agent");
            asm volatile("s_waitcnt vmcnt(0)" ::: "memory");
        } else {
            XB_SPIN(xb_ld(&bar[XB_TOPGEN]) == gen, bar);
            __builtin_amdgcn_fence(__ATOMIC_ACQUIRE, "agent");
            asm volatile("s_waitcnt vmcnt(0)" ::: "memory");
        }
    }
    __syncthreads();
}

struct Args {
    const float *x, *norm_w, *w_in, *lb_table, *gnorm_a, *q_norm_w, *kv_norm_w, *w_uq, *w_qidx, *w_ukv, *kidx_norm_w, *kidx_norm_b, *w_pa, *w_pb, *w_out, *rel_bias, *final_norm_w;
    float* out; unsigned char* ws; int ph_lo, ph_hi;
};
constexpr int LDS_BYTES = 155648;
constexpr int MISC_OFF = 154624;
struct Ctx { LAS unsigned char* lds; int tid, lane, wave, wg, G; };

struct P0Item { const float* src; bf16* dst; int N, ldk, sc; };
__device__ __forceinline__ P0Item p0_decode(const Args& a, unsigned char* ws, int it, int lane) {
    constexpr int I_IN = (D_ / 64) * (NIN / 32), I_QI = (QR / 64) * (2048 / 32), I_PA = (AW / 64) * (D_ / 32), I_OUT = (D_ / 64) * (D_ / 32);
    const int c4 = lane & 7; P0Item d; int r = it;
    if (r < I_IN) { const int kb = r / (NIN / 32), nb = r % (NIN / 32), np = 32 * nb + 4 * c4;
        d.src = a.w_in + (size_t)(64 * kb) * IN_W; d.N = IN_W; d.sc = np < 5008 ? np : (np < 5120 ? -1 : np - 112); d.dst = (bf16*)(ws + WS_WIN) + (size_t)(32 * nb) * D_ + 64 * kb; d.ldk = D_; return d; } r -= I_IN;
    if (r < I_QI) { const int kb = r / 64, nb = r % 64; d.src = a.w_qidx + (size_t)(64 * kb) * 2048; d.N = 2048; d.sc = 32 * nb + 4 * c4; d.dst = (bf16*)(ws + WS_WQ) + (size_t)(2048 + 32 * nb) * QR + 64 * kb; d.ldk = QR; return d; } r -= I_QI;
    if (r < 2 * I_PA) { const bool pb = r >= I_PA; if (pb) r -= I_PA; const int kb = r / 64, nb = r % 64;
        d.src = (pb ? a.w_pb : a.w_pa) + (size_t)(64 * kb) * D_; d.N = D_; d.sc = 32 * nb + 4 * c4; d.dst = (bf16*)(ws + (pb ? WS_WPB : WS_WPA)) + (size_t)(32 * nb) * AW + 64 * kb; d.ldk = AW; return d; } r -= 2 * I_PA;
    if (r < I_OUT) { const int kb = r / 64, nb = r % 64; d.src = a.w_out + (size_t)(64 * kb) * D_; d.N = D_; d.sc = 32 * nb + 4 * c4; d.dst = (bf16*)(ws + WS_WOUT) + (size_t)(32 * nb) * D_ + 64 * kb; d.ldk = D_; return d; } r -= I_OUT;
    {
        const int kb = r / 32, nb = r % 32, k0 = 64 * kb, hh = k0 >> 8, c0 = k0 & 255, np = 32 * nb + 4 * c4, h = np >> 7, dd = np & 127;
        d.src = a.w_ukv + (size_t)c0 * 2048; d.N = 2048; d.sc = (hh == (h & 1)) ? h * 256 + 128 + dd : -1; d.dst = (bf16*)(ws + WS_WUV) + (size_t)(32 * nb) * 512 + k0; d.ldk = 512; return d; }
}
__device__ __forceinline__ void p0_item_load(const P0Item& d, int lane, f32x4 (&v)[8]) {
    const int kr = lane >> 3;
#pragma unroll
    for (int i = 0; i < 8; ++i) v[i] = d.sc >= 0 ? *(const f32x4*)(d.src + (size_t)(kr + 8 * i) * d.N + d.sc) : (f32x4){0.f, 0.f, 0.f, 0.f};
}
__device__ __forceinline__ void p0_item_put(const P0Item& d, int lane, const f32x4 (&v)[8], LAS float* scr) {
    const int c4 = lane & 7, kr = lane >> 3;
#pragma unroll
    for (int i = 0; i < 8; ++i) { LAS float* p = scr + (kr + 8 * i) * 33 + 4 * c4; p[0] = v[i].x; p[1] = v[i].y; p[2] = v[i].z; p[3] = v[i].w; }
    LDS_WAIT(); asm volatile("" ::: "memory");
    const int c = lane & 7;
#pragma unroll
    for (int j = 0; j < 4; ++j) { const int n = (lane >> 3) + 8 * j; const LAS float* sp = scr + (8 * c) * 33 + n;
        u32x4 o; o.x = pk2(sp[0 * 33], sp[1 * 33]); o.y = pk2(sp[2 * 33], sp[3 * 33]); o.z = pk2(sp[4 * 33], sp[5 * 33]); o.w = pk2(sp[6 * 33], sp[7 * 33]);
        *(u32x4*)(d.dst + (size_t)n * d.ldk + 8 * c) = o; }
    LDS_WAIT(); asm volatile("" ::: "memory");
}
__device__ __forceinline__ void p0_prep(const Ctx& C, const Args& a) {
    unsigned char* ws = a.ws;
    LAS float* scr = (LAS float*)(C.lds + C.wave * 16384);
    const int gw = C.wg * NWAVES + C.wave, NGW = C.G * NWAVES;
    constexpr int NITEMS = (D_ / 64) * (NIN / 32) + (QR / 64) * (2048 / 32) + 2 * (AW / 64) * (D_ / 32) + (D_ / 64) * (D_ / 32) + (512 / 64) * (1024 / 32);
    {
        f32x4 va[8], vb[8]; int it = gw;
        P0Item da, db;
        if (it < NITEMS) { da = p0_decode(a, ws, it, C.lane); p0_item_load(da, C.lane, va); }
        while (it < NITEMS) {
            const int i1 = it + NGW; if (i1 < NITEMS) { db = p0_decode(a, ws, i1, C.lane); p0_item_load(db, C.lane, vb); }
            p0_item_put(da, C.lane, va, scr);
            if (i1 >= NITEMS) break;
            const int i2 = i1 + NGW; if (i2 < NITEMS) { da = p0_decode(a, ws, i2, C.lane); p0_item_load(da, C.lane, va); }
            p0_item_put(db, C.lane, vb, scr);
            it = i2;
        }
    }
    for (int m = gw; m < S_; m += NGW) {
        const f32x4* xr = (const f32x4*)(a.x + (size_t)m * D_) + C.lane; const f32x4* wr = (const f32x4*)a.norm_w + C.lane;
        f32x4 v[8]; float s = 0.f;
#pragma unroll
        for (int j = 0; j < 8; ++j) { v[j] = xr[64 * j]; s += (v[j].x * v[j].x + v[j].y * v[j].y) + (v[j].z * v[j].z + v[j].w * v[j].w); }
        const float rs = rsqrtf(wave_sum(s) * (1.f / D_) + EPS);
        u32x2* o8 = (u32x2*)((bf16*)(ws + WS_H) + (size_t)m * D_) + C.lane;
#pragma unroll
        for (int j = 0; j < 8; ++j) { const f32x4 w = wr[64 * j]; u32x2 o; o.x = pk2(v[j].x * rs * w.x, v[j].y * rs * w.y); o.y = pk2(v[j].z * rs * w.z, v[j].w * rs * w.w); o8[64 * j] = o; }
    }
    { const int g = C.wg * NTHR + C.tid; if (g < AW) { const float l0 = a.lb_table[g], l1 = a.lb_table[AW + g], mx = fmaxf(l0, l1), e0 = __expf(l0 - mx), e1 = __expf(l1 - mx); ((float*)(ws + WS_LB))[g] = e0 / (e0 + e1); } }
    __syncthreads();
    {
        LAS float* As = (LAS float*)C.lds;
        LAS float* Bs = As + 64 * 129;
        bf16* WqT = (bf16*)(ws + WS_WQ);
        for (int it = C.wg; it < 256; it += C.G) {
            const int h = it >> 5, cb = (it >> 3) & 3, rb = it & 7, c0 = cb * 64, r0 = rb * 64;
            { const int rr = C.tid >> 3, seg = C.tid & 7;
#pragma unroll
              for (int j = 0; j < 4; ++j) { const f32x4 va = *(const f32x4*)(a.w_uq + (size_t)(r0 + rr) * 1024 + h * 128 + seg * 16 + 4 * j); const f32x4 vb = *(const f32x4*)(a.w_ukv + (size_t)(c0 + rr) * 2048 + h * 256 + seg * 16 + 4 * j);
                  LAS float* pa = As + rr * 129 + seg * 16 + 4 * j; pa[0] = va.x; pa[1] = va.y; pa[2] = va.z; pa[3] = va.w;
                  LAS float* pb = Bs + rr * 129 + seg * 16 + 4 * j; pb[0] = vb.x; pb[1] = vb.y; pb[2] = vb.z; pb[3] = vb.w; } }
            __syncthreads();
            { const int r = C.tid & 63, cg = C.tid >> 6; float o[8];
#pragma unroll
              for (int i = 0; i < 8; ++i) o[i] = 0.f;
              for (int d = 0; d < 128; ++d) { const float av = As[r * 129 + d];
#pragma unroll
                  for (int i = 0; i < 8; ++i) o[i] += av * Bs[(cg * 8 + i) * 129 + d]; }
#pragma unroll
              for (int i = 0; i < 8; ++i) WqT[(size_t)(h * 256 + c0 + cg * 8 + i) * QR + r0 + r] = (bf16)f2bf(o[i] * 0.08838834764831845f); }
            __syncthreads();
        }
    }
}

struct SchedPlain {
    pg8::TileOrder T; const char* Ab; const char* Bb; size_t tA, tB;
    __device__ __forceinline__ bool next(int i, pg8::Unit& u) const { u.sub = 0; return T.tile(i, u.pm, u.pn); }
    __device__ __forceinline__ const char* A(const pg8::Unit& u) const { return Ab + (size_t)u.pm * tA; }
    __device__ __forceinline__ const char* B(const pg8::Unit& u) const { return Bb + (size_t)u.pn * tB; }
    __device__ __forceinline__ bool keep(const pg8::Unit&) const { return false; }
};
#define EPI_FOREACH(...) \
    _Pragma("unroll") for (int ai = 0; ai < 2; ++ai) _Pragma("unroll") for (int m = 0; m < 4; ++m) { const int row = u.pm * 256 + ai * 128 + wr * 64 + m * 16 + fr; \
    _Pragma("unroll") for (int bj = 0; bj < 2; ++bj) { const int col = u.pn * 256 + bj * 128 + wc * 32 + 8 * fq; f32x4& v0 = acc[ai][bj][m][0]; f32x4& v1 = acc[ai][bj][m][1]; __VA_ARGS__ } }

struct EpiProj {
    unsigned char* ws;
    __device__ __forceinline__ void operator()(f32x4 (&acc)[2][2][4][2], const pg8::Unit& u, int wr, int wc, int fr, int fq) const {
        const int pn = u.pn;
        if (pn < 4) {
            bf16* O = (bf16*)(ws + WS_QA);
            EPI_FOREACH({ u32x4 w; const float s = 0.08838834764831845f; w.x = pk2(siluf_(v0[0]) * s, siluf_(v0[1]) * s); w.y = pk2(siluf_(v0[2]) * s, siluf_(v0[3]) * s); w.z = pk2(siluf_(v1[0]) * s, siluf_(v1[1]) * s); w.w = pk2(siluf_(v1[2]) * s, siluf_(v1[3]) * s);
                *(u32x4*)(O + (size_t)row * AW + col) = w; })
        } else if (pn < 8) {
            float* O = (float*)(ws + WS_G); const float* lb = (const float*)(ws + WS_LB);
            EPI_FOREACH({ const int c = col - 1024; const f32x4 l0 = *(const f32x4*)(lb + c), l1 = *(const f32x4*)(lb + c + 4); f32x4 o0, o1;
                _Pragma("unroll") for (int j = 0; j < 4; ++j) { o0[j] = __logf(l0[j] + (1.f - l0[j]) * sigmoidf_(v0[j])); o1[j] = __logf(l1[j] + (1.f - l1[j]) * sigmoidf_(v1[j])); }
                *(f32x4*)(O + (size_t)row * AW + c) = o0; *(f32x4*)(O + (size_t)row * AW + c + 4) = o1; })
        } else if (pn < 12) {
            bf16* O = (bf16*)(ws + WS_VA);
            EPI_FOREACH({ u32x4 w; w.x = pk2(v0[0], v0[1]); w.y = pk2(v0[2], v0[3]); w.z = pk2(v1[0], v1[1]); w.w = pk2(v1[2], v1[3]); *(u32x4*)(O + (size_t)row * AW + col - 2048) = w; })
        } else if (pn < 16 || (pn >= 20 && pn < 24)) {
            bf16* O = (bf16*)(ws + (pn < 16 ? WS_GA : WS_GB)); const int cb = pn < 16 ? 3072 : 5120;
            EPI_FOREACH({ u32x4 w; w.x = pk2(siluf_(v0[0]), siluf_(v0[1])); w.y = pk2(siluf_(v0[2]), siluf_(v0[3])); w.z = pk2(siluf_(v1[0]), siluf_(v1[1])); w.w = pk2(siluf_(v1[2]), siluf_(v1[3]));
                *(u32x4*)(O + (size_t)row * AW + col - cb) = w; })
        } else if (pn < 20) {
            float* O = (float*)(ws + WS_RAW);
            EPI_FOREACH({ *(f32x4*)(O + (size_t)row * 1024 + col - 4096) = v0; *(f32x4*)(O + (size_t)row * 1024 + col - 4096 + 4) = v1; })
        } else {
            bf16* O = (bf16*)(ws + (pn < 32 ? WS_SA : WS_SB)); const int cb = pn < 32 ? 6144 : 8192;
            EPI_FOREACH({ u32x4 w; w.x = pk2(sigmoidf_(v0[0]), sigmoidf_(v0[1])); w.y = pk2(sigmoidf_(v0[2]), sigmoidf_(v0[3])); w.z = pk2(sigmoidf_(v1[0]), sigmoidf_(v1[1])); w.w = pk2(sigmoidf_(v1[2]), sigmoidf_(v1[3]));
                *(u32x4*)(O + (size_t)row * D_ + col - cb) = w; })
        }
    }
};

__device__ __forceinline__ void p2_norms(const Ctx& C, const Args& a) {
    unsigned char* ws = a.ws;
    const int gw = C.wg * NWAVES + C.wave, NGW = C.G * NWAVES, lane = C.lane;
    const float* RAW = (const float*)(ws + WS_RAW);
    for (int t = gw; t < S_; t += NGW) {
        const float* r = RAW + (size_t)t * 1024;
        { const f32x4 v0 = *(const f32x4*)(r + 4 * lane), v1 = *(const f32x4*)(r + 256 + 4 * lane);
          const float ss = wave_sum((v0.x * v0.x + v0.y * v0.y) + (v0.z * v0.z + v0.w * v0.w) + (v1.x * v1.x + v1.y * v1.y) + (v1.z * v1.z + v1.w * v1.w));
          const float rs = rsqrtf(ss * (1.f / QR) + EPS);
          const f32x4 w0 = *(const f32x4*)(a.q_norm_w + 4 * lane), w1 = *(const f32x4*)(a.q_norm_w + 256 + 4 * lane);
          bf16* o = (bf16*)(ws + WS_CQN) + (size_t)t * QR;
          u32x2 p0, p1; p0.x = pk2(v0.x * rs * w0.x, v0.y * rs * w0.y); p0.y = pk2(v0.z * rs * w0.z, v0.w * rs * w0.w); p1.x = pk2(v1.x * rs * w1.x, v1.y * rs * w1.y); p1.y = pk2(v1.z * rs * w1.z, v1.w * rs * w1.w);
          *(u32x2*)(o + 4 * lane) = p0; *(u32x2*)(o + 256 + 4 * lane) = p1; }
        { const f32x4 v0 = *(const f32x4*)(r + 512 + 4 * lane);
          const float ss = wave_sum((v0.x * v0.x + v0.y * v0.y) + (v0.z * v0.z + v0.w * v0.w));
          const float rs = rsqrtf(ss * (1.f / KVR) + EPS);
          const f32x4 w0 = *(const f32x4*)(a.kv_norm_w + 4 * lane);
          u32x2 p0; p0.x = pk2(v0.x * rs * w0.x, v0.y * rs * w0.y); p0.y = pk2(v0.z * rs * w0.z, v0.w * rs * w0.w);
          *(u32x2*)((bf16*)(ws + WS_CKVN) + (size_t)t * KVR + 4 * lane) = p0; }
        { const f32x2 v = *(const f32x2*)(r + 768 + 2 * lane);
          const float mu = wave_sum(v.x + v.y) * (1.f / IDXD); const float d0 = v.x - mu, d1 = v.y - mu;
          const float var = wave_sum(d0 * d0 + d1 * d1) * (1.f / IDXD); const float rs = rsqrtf(var + EPS);
          const f32x2 w = *(const f32x2*)(a.kidx_norm_w + 2 * lane), b = *(const f32x2*)(a.kidx_norm_b + 2 * lane);
          *(unsigned*)((bf16*)(ws + WS_KIDX) + (size_t)t * IDXD + 2 * lane) = pk2(d0 * rs * w.x + b.x, d1 * rs * w.y + b.y); }
        if (lane < IDXH) ((float*)(ws + WS_WIDX))[(size_t)t * IDXH + lane] = r[896 + lane] * 0.02209708691207961f;
    }
}
constexpr int R64 = 144, R128 = 272;
__device__ __forceinline__ void p2_hgrn_states(const Ctx& C, const Args& a, float* UT) {
    unsigned char* ws = a.ws;
    const float* G = (const float*)(ws + WS_G); const bf16* VA = (const bf16*)(ws + WS_VA); float* DL = (float*)(ws + WS_DLAST);
    LAS unsigned char* kdT = C.lds;
    LAS unsigned char* vT = C.lds + 128 * R64;
    LAS float* segtot = (LAS float*)(C.lds + 2 * 128 * R64);
    const int tid = C.tid, lane = C.lane, w = C.wave;
    for (int it = C.wg; it < NCH * BH; it += C.G) {
        const int c = it >> 3, h = it & 7;
        const int k = tid & 127, seg = tid >> 7, t0 = c * CHUNK + seg * 16;
        float g[16], cum[16]; float run = 0.f;
#pragma unroll
        for (int i = 0; i < 16; ++i) { g[i] = G[(size_t)(t0 + i) * AW + h * 128 + k]; run += g[i]; cum[i] = run; }
        segtot[seg * 128 + k] = run;
        unsigned short vv[16];
#pragma unroll
        for (int i = 0; i < 16; ++i) vv[i] = VA[(size_t)(t0 + i) * AW + h * 128 + k];
        __syncthreads();
        float pre = 0.f, last = 0.f;
#pragma unroll
        for (int s2 = 0; s2 < 4; ++s2) { const float st = segtot[s2 * 128 + k]; if (s2 < seg) pre += st; last += st; }
        unsigned kd[8], vp[8];
#pragma unroll
        for (int i = 0; i < 8; ++i) {
            const float c0 = cum[2 * i] + pre, c1 = cum[2 * i + 1] + pre;
            const float k0 = -expm1f(g[2 * i]) * __expf(last - c0), k1 = -expm1f(g[2 * i + 1]) * __expf(last - c1);
            kd[i] = pk2(k0, k1); vp[i] = (unsigned)vv[2 * i] | ((unsigned)vv[2 * i + 1] << 16);
        }
        *(LAS u32x4*)(kdT + k * R64 + seg * 32) = (u32x4){kd[0], kd[1], kd[2], kd[3]}; *(LAS u32x4*)(kdT + k * R64 + seg * 32 + 16) = (u32x4){kd[4], kd[5], kd[6], kd[7]};
        *(LAS u32x4*)(vT + k * R64 + seg * 32) = (u32x4){vp[0], vp[1], vp[2], vp[3]}; *(LAS u32x4*)(vT + k * R64 + seg * 32 + 16) = (u32x4){vp[4], vp[5], vp[6], vp[7]};
        if (seg == 0) DL[(size_t)it * 128 + k] = __expf(last);
        __syncthreads();
        f32x4 acc[2][4];
#pragma unroll
        for (int mi = 0; mi < 2; ++mi)
#pragma unroll
            for (int ni = 0; ni < 4; ++ni) acc[mi][ni] = (f32x4){0.f, 0.f, 0.f, 0.f};
        const int fr = lane & 15, fq = lane >> 4;
#pragma unroll
        for (int ks = 0; ks < 2; ++ks) {
            bf16x8 af[2], bfr[4];
#pragma unroll
            for (int mi = 0; mi < 2; ++mi) af[mi] = *(const LAS bf16x8*)(vT + (32 * (w >> 1) + 16 * mi + fr) * R64 + (32 * ks + 8 * fq) * 2);
#pragma unroll
            for (int ni = 0; ni < 4; ++ni) bfr[ni] = *(const LAS bf16x8*)(kdT + (64 * (w & 1) + 16 * ni + fr) * R64 + (32 * ks + 8 * fq) * 2);
#pragma unroll
            for (int mi = 0; mi < 2; ++mi)
#pragma unroll
                for (int ni = 0; ni < 4; ++ni) acc[mi][ni] = __builtin_amdgcn_mfma_f32_16x16x32_bf16(af[mi], bfr[ni], acc[mi][ni], 0, 0, 0);
        }
        float* U = UT + (size_t)it * 16384;
#pragma unroll
        for (int mi = 0; mi < 2; ++mi)
#pragma unroll
            for (int ni = 0; ni < 4; ++ni)
#pragma unroll
                for (int r = 0; r < 4; ++r) U[(32 * (w >> 1) + 16 * mi + 4 * fq + r) * 128 + 64 * (w & 1) + 16 * ni + fr] = acc[mi][ni][r];
        __syncthreads();
    }
}

struct EpiQ {
    unsigned char* ws;
    __device__ __forceinline__ void operator()(f32x4 (&acc)[2][2][4][2], const pg8::Unit& u, int wr, int wc, int fr, int fq) const {
        bf16* O = (bf16*)(ws + (u.pn < 8 ? WS_QABS : WS_RAW)); const int cb = u.pn < 8 ? 0 : 2048;
        EPI_FOREACH({ u32x4 w; w.x = pk2(v0[0], v0[1]); w.y = pk2(v0[2], v0[3]); w.z = pk2(v1[0], v1[1]); w.w = pk2(v1[2], v1[3]); *(u32x4*)(O + (size_t)row * 2048 + col - cb) = w; })
    }
};
__device__ __forceinline__ void p3_scan(const Ctx& C, const Args& a, const float* UT) {
    unsigned char* ws = a.ws;
    const float* DL = (const float*)(ws + WS_DLAST); bf16* SPT = (bf16*)(ws + WS_SPT);
    for (int e = C.wg * NTHR + C.tid; e < BH * 128 * 128; e += C.G * NTHR) {
        const int h = e >> 14, k = e & 127;
        float Sv = 0.f;
        for (int c0 = 0; c0 < NCH; c0 += 16) {
            float u[16], d[16];
#pragma unroll
            for (int j = 0; j < 16; ++j) { u[j] = UT[(size_t)(c0 + j) * (BH * 16384) + e]; d[j] = DL[(size_t)((c0 + j) * BH + h) * 128 + k]; }
#pragma unroll
            for (int j = 0; j < 16; ++j) { SPT[(size_t)(c0 + j) * (BH * 16384) + e] = (bf16)f2bf(Sv); Sv = d[j] * Sv + u[j]; }
        }
    }
}

__device__ __forceinline__ int t5_bucket(int rel) {
    const int n = rel < 0 ? -rel : rel; int b = rel > 0 ? 16 : 0;
    const int large = n < 12 ? 8 : n < 16 ? 9 : n < 23 ? 10 : n < 32 ? 11 : n < 46 ? 12 : n < 64 ? 13 : n < 91 ? 14 : 15;
    return b + (n < 8 ? n : large);
}
__device__ __forceinline__ int swz_sigma(int r) { return ((r & 3) << 1) | ((((r >> 3) ^ (r >> 2)) & 1) << 3) | ((r >> 2) & 1); }
__device__ __forceinline__ int lat_off(int row, int c) { return row * 512 + ((((c & 15) ^ swz_sigma(row & 15)) | (c & 16)) << 4); }
constexpr int AT_SIDX = 131072, AT_BIAS = 139264;
__device__ __forceinline__ void attn_setup(const Ctx& C, const Args& a) {
    LAS float* bias2 = (LAS float*)(C.lds + AT_BIAS);
    for (int e = C.tid; e < 2 * 92 * 8; e += NTHR) { const int sg = e / (92 * 8), nn = (e / 8) % 92, h = e & 7; bias2[e] = a.rel_bias[t5_bucket(sg ? nn : -nn) * BH + h]; }
    __syncthreads();
}
__device__ __forceinline__ void attn_one(const Ctx& C, const Args& a, const int t, const int n) {
    unsigned char* ws = a.ws;
    const bf16* QABS = (const bf16*)(ws + WS_QABS); const char* CKVNb = (const char*)(ws + WS_CKVN);
    bf16* OL = (bf16*)(ws + WS_RAW);
    int lane = C.lane; asm volatile("" : "+v"(lane));
    const int w = C.wave, fr = lane & 15, fq = lane >> 4;
    LAS unsigned char* L = C.lds + w * 16384;
    const LAS int* sidx = (const LAS int*)(C.lds + AT_SIDX) + w * 256;
    const LAS float* bias2 = (const LAS float*)(C.lds + AT_BIAS);
    const int q4 = fr >> 2, p4 = fr & 3;
    unsigned aqk[4], apv[8];
    { const int s = swz_sigma(fr); const unsigned b0 = (unsigned)(fr * 512 + 16 * (fq ^ (s & 3))) | (unsigned)(64 * (s >> 2));
#pragma unroll
      for (int k = 0; k < 4; ++k) aqk[k] = (unsigned)(size_t)L + (b0 ^ (unsigned)(64 * k)); }
    { const int rr = 4 * fq + q4, s = swz_sigma(rr & 15); const unsigned b0 = (unsigned)(rr * 512 + 16 * ((p4 >> 1) ^ (s & 1)) + 8 * (p4 & 1)) | (unsigned)(32 * (s >> 1));
#pragma unroll
      for (int k = 0; k < 8; ++k) apv[k] = (unsigned)(size_t)L + (b0 ^ (unsigned)(32 * k)); }
    unsigned c16[16];
#pragma unroll
    for (int i = 0; i < 16; ++i) { const int row = 2 * i + (lane >> 5), pos = lane & 31; c16[i] = (unsigned)(((pos & 16) | ((pos & 15) ^ swz_sigma(row & 15))) << 4); }
    {
        bf16x8 qf[8];
#pragma unroll
        for (int ks = 0; ks < 8; ++ks) { if (fr < BH) qf[ks] = *(const bf16x8*)(QABS + (size_t)t * 2048 + fr * 256 + 32 * ks + 8 * fq); else qf[ks] = (bf16x8){0, 0, 0, 0, 0, 0, 0, 0}; }
        f32x4 oa[16];
#pragma unroll
        for (int i = 0; i < 16; ++i) oa[i] = (f32x4){0.f, 0.f, 0.f, 0.f};
        float m_run = -INFINITY, l_run = 0.f;
        LDS_WAIT();
        for (int ch = 0; ch * 32 < n; ++ch) {
            int sjv[16];
#pragma unroll
            for (int i = 0; i < 16; ++i) sjv[i] = sidx[32 * ch + 2 * i + (lane >> 5)];
#pragma unroll
            for (int i = 0; i < 16; ++i)
                __builtin_amdgcn_global_load_lds((const unsigned*)(CKVNb + (unsigned)(sjv[i] * 512 + (int)c16[i])), (LAS unsigned*)(L + i * 1024), 16, 0, 0);
            const u32x4 s0 = *(const LAS u32x4*)(sidx + 32 * ch + 4 * fq), s1 = *(const LAS u32x4*)(sidx + 32 * ch + 16 + 4 * fq);
            float bv[2][4];
#pragma unroll
            for (int T = 0; T < 2; ++T)
#pragma unroll
                for (int r = 0; r < 4; ++r) { const int rel = (int)(T ? s1[r] : s0[r]) - t; const int nn = rel < 0 ? -rel : rel; bv[T][r] = bias2[((rel > 0 ? 92 : 0) + (nn < 91 ? nn : 91)) * 8 + (fr & 7)]; }
            VM_WAIT();
            f32x4 lg[2] = {{0.f, 0.f, 0.f, 0.f}, {0.f, 0.f, 0.f, 0.f}};
            {
                u32x4 kf[8][2];
#define AT_KRD(ks) do { _Pragma("unroll") for (int T = 0; T < 2; ++T) asm volatile("ds_read_b128 %0, %1 offset:%2" : "=v"(kf[ks][T]) : "v"(aqk[(ks) & 3]), "n"(256 * ((ks) >> 2) + 8192 * T)); } while (0)
                AT_KRD(0); AT_KRD(1); AT_KRD(2); AT_KRD(3); AT_KRD(4); AT_KRD(5);
                asm volatile("s_waitcnt lgkmcnt(4)" : "+v"(kf[0][0]), "+v"(kf[0][1]), "+v"(kf[1][0]), "+v"(kf[1][1]), "+v"(kf[2][0]), "+v"(kf[2][1]), "+v"(kf[3][0]), "+v"(kf[3][1]));
                AT_KRD(6); AT_KRD(7);
#undef AT_KRD
#pragma unroll
                for (int ks = 0; ks < 4; ++ks)
#pragma unroll
                    for (int T = 0; T < 2; ++T) lg[T] = __builtin_amdgcn_mfma_f32_16x16x32_bf16(__builtin_bit_cast(bf16x8, kf[ks][T]), qf[ks], lg[T], 0, 0, 0);
                asm volatile("s_waitcnt lgkmcnt(0)" : "+v"(kf[4][0]), "+v"(kf[4][1]), "+v"(kf[5][0]), "+v"(kf[5][1]), "+v"(kf[6][0]), "+v"(kf[6][1]), "+v"(kf[7][0]), "+v"(kf[7][1]));
#pragma unroll
                for (int ks = 4; ks < 8; ++ks)
#pragma unroll
                    for (int T = 0; T < 2; ++T) lg[T] = __builtin_amdgcn_mfma_f32_16x16x32_bf16(__builtin_bit_cast(bf16x8, kf[ks][T]), qf[ks], lg[T], 0, 0, 0);
            }
            float mx = -INFINITY;
#pragma unroll
            for (int T = 0; T < 2; ++T)
#pragma unroll
                for (int r = 0; r < 4; ++r) { const int j = 32 * ch + 16 * T + 4 * fq + r; float v = lg[T][r] + bv[T][r];
                    v = (j < n) ? v : -INFINITY; lg[T][r] = v; mx = fmaxf(mx, v); }
            mx = rows_max(mx);
            const float m_new = fmaxf(m_run, mx), scale = __expf(m_run - m_new);
            float sm = 0.f;
#pragma unroll
            for (int T = 0; T < 2; ++T)
#pragma unroll
                for (int r = 0; r < 4; ++r) { const float p = __expf(lg[T][r] - m_new); lg[T][r] = p; sm += p; }
            l_run = l_run * scale + sm; m_run = m_new;
            bf16x8 pf; { const unsigned w0 = pk2(lg[0][0], lg[0][1]), w1 = pk2(lg[0][2], lg[0][3]), w2 = pk2(lg[1][0], lg[1][1]), w3 = pk2(lg[1][2], lg[1][3]);
                pf = __builtin_bit_cast(bf16x8, (u32x4){w0, w1, w2, w3}); }
            if (__any(scale != 1.f)) {
#pragma unroll
                for (int ct = 0; ct < 16; ++ct) oa[ct] *= scale; }
            {
                u32x2 lo[16], hi[16];
#define AT_VRD(ct) do { asm volatile("ds_read_b64_tr_b16 %0, %1 offset:%2" : "=v"(lo[ct]) : "v"(apv[(ct) & 7]), "n"(256 * ((ct) >> 3))); \
                        asm volatile("ds_read_b64_tr_b16 %0, %1 offset:%2" : "=v"(hi[ct]) : "v"(apv[(ct) & 7]), "n"(256 * ((ct) >> 3) + 8192)); } while (0)
#define AT_VWAIT(g, cnt) asm volatile("s_waitcnt lgkmcnt(" #cnt ")" : "+v"(lo[4 * (g)]), "+v"(hi[4 * (g)]), "+v"(lo[4 * (g) + 1]), "+v"(hi[4 * (g) + 1]), "+v"(lo[4 * (g) + 2]), "+v"(hi[4 * (g) + 2]), "+v"(lo[4 * (g) + 3]), "+v"(hi[4 * (g) + 3]))
#define AT_VMMA(g) do { _Pragma("unroll") for (int c4 = 4 * (g); c4 < 4 * (g) + 4; ++c4) { const u32x4 cw = {lo[c4].x, lo[c4].y, hi[c4].x, hi[c4].y}; \
                        oa[c4] = __builtin_amdgcn_mfma_f32_16x16x32_bf16(__builtin_bit_cast(bf16x8, cw), pf, oa[c4], 0, 0, 0); } } while (0)
                AT_VRD(0); AT_VRD(1); AT_VRD(2); AT_VRD(3); AT_VRD(4); AT_VRD(5);
                AT_VWAIT(0, 4); AT_VRD(6); AT_VRD(7); AT_VRD(8); AT_VRD(9); AT_VMMA(0);
                AT_VWAIT(1, 4); AT_VRD(10); AT_VRD(11); AT_VRD(12); AT_VRD(13); AT_VMMA(1);
                AT_VWAIT(2, 4); AT_VRD(14); AT_VRD(15); AT_VMMA(2);
                AT_VWAIT(3, 0); AT_VMMA(3);
#undef AT_VRD
#undef AT_VWAIT
#undef AT_VMMA
            }
            LDS_WAIT();
        }
        l_run = rows_sum(l_run);
        if (fr < BH) { const float inv = __builtin_amdgcn_rcpf(l_run); bf16* o = OL + (size_t)t * 2048 + fr * 256 + 4 * fq;
#pragma unroll
            for (int ct = 0; ct < 16; ++ct) { u32x2 pw; pw.x = pk2(oa[ct][0] * inv, oa[ct][1] * inv); pw.y = pk2(oa[ct][2] * inv, oa[ct][3] * inv); *(u32x2*)(o + 16 * ct) = pw; } }
    }
}

__device__ __forceinline__ unsigned fkey(float f) { const unsigned u = __builtin_bit_cast(unsigned, f); return (u & 0x80000000u) ? ~u : (u | 0x80000000u); }
__device__ __forceinline__ void lds_add_u32(LAS unsigned* p, unsigned v) { asm volatile("ds_add_u32 %0, %1" :: "v"((unsigned)(size_t)p), "v"(v) : "memory"); }
constexpr int IX_KBUF = 65536, IX_CAP = 512;
__device__ __noinline__ void select_slow(const float* sc, int nvis, LAS int* idxrow, LAS unsigned* hist, int lane) {
    unsigned prefix = 0u; int need = TOPK;
#pragma unroll 1
    for (int pass = 0; pass < 4; ++pass) {
        const int shift = 24 - 8 * pass;
#pragma unroll
        for (int j = 0; j < 4; ++j) hist[lane * 4 + j] = 0u;
        LDS_WAIT();
        const unsigned himask = pass == 0 ? 0u : (0xffffffffu << (shift + 8));
        for (int i = lane; i < nvis; i += 64) { const unsigned kk = fkey(sc[i]); if ((kk & himask) == (prefix & himask)) __hip_atomic_fetch_add(&hist[(kk >> shift) & 255u], 1u, __ATOMIC_RELAXED, __HIP_MEMORY_SCOPE_WORKGROUP); }
        LDS_WAIT();
        unsigned cnt[4]; unsigned tl = 0u;
#pragma unroll
        for (int j = 0; j < 4; ++j) { cnt[j] = hist[lane * 4 + j]; tl += cnt[j]; }
        unsigned incl = tl;
#pragma unroll
        for (int o = 1; o < 64; o <<= 1) { const unsigned v = __shfl_down(incl, o); if (lane + o < 64) incl += v; }
        unsigned above = incl - tl;
        int dsel = -1; unsigned asel = 0u;
#pragma unroll
        for (int j = 3; j >= 0; --j) { if (dsel < 0 && above < (unsigned)need && above + cnt[j] >= (unsigned)need) { dsel = lane * 4 + j; asel = above; } above += cnt[j]; }
        const unsigned long long bal = __ballot(dsel >= 0);
        const int src = __ffsll((long long)bal) - 1;
        const int d = __shfl(dsel, src); const unsigned ab = __shfl(asel, src);
        need -= (int)ab; prefix |= ((unsigned)d) << shift;
    }
    int base = 0, eqseen = 0;
    for (int i0 = 0; i0 < nvis; i0 += 64) {
        const int i = i0 + lane; const unsigned kk = fkey(sc[i]);
        const bool gt = kk > prefix, eq = kk == prefix;
        const unsigned long long beq = __ballot(eq);
        const unsigned long long lt_mask = (1ull << lane) - 1ull;
        const int eqrank = eqseen + __popcll(beq & lt_mask);
        const bool sel = gt || (eq && eqrank < need);
        const unsigned long long bs = __ballot(sel);
        if (sel) idxrow[base + __popcll(bs & lt_mask)] = i;
        base += __popcll(bs); eqseen += __popcll(beq);
    }
}
__device__ __forceinline__ void p4_indexer(const Ctx& C, const Args& a, float* SCall, unsigned* qc, volatile LAS unsigned* MISC, int& cur) {
    unsigned char* ws = a.ws;
    const bf16* QIDX = (const bf16*)(ws + WS_RAW); const char* KIDXb = (const char*)(ws + WS_KIDX); const float* WIDX = (const float*)(ws + WS_WIDX);
    LAS int* sidx = (LAS int*)(C.lds + AT_SIDX) + C.wave * 256;
    float* SC = SCall + (size_t)C.wg * (8 * 8192);
    LAS unsigned* HIST = (LAS unsigned*)C.lds;
    LAS unsigned char* KBUF = C.lds + IX_KBUF;
    const int tid = C.tid, w = C.wave, quad = w & 1, kg = w >> 1;
    while (cur < 1024) {
        int lane = C.lane; asm volatile("" : "+v"(lane));
        const int r16 = lane & 15, kq = lane >> 4;
        const int tile = 1023 - cur;
        const int q0 = tile * 8, nvis = ((q0 >> 6) + 1) * CHUNK;
        if (nvis <= TOPK) {
            for (int j = lane; j < TOPK; j += 64) sidx[j] = j < nvis ? j : 0;
            LDS_WAIT(); __syncthreads();
            unsigned nxt = 0u; if (tid == 0) nxt = xb_add(qc, 1u);
            attn_one(C, a, q0 + w, nvis);
            if (tid == 0) MISC[MISC_Q4] = nxt;
            LDS_WAIT(); __syncthreads();
            cur = __builtin_amdgcn_readfirstlane((int)MISC[MISC_Q4]);
            continue;
        }
        for (int i = tid; i < 8 * 2048; i += NTHR) HIST[i] = 0u;
        bf16x8 af[4][4];
#pragma unroll
        for (int j = 0; j < 4; ++j) {
            const bf16* qp = QIDX + (size_t)(q0 + 4 * quad + j) * 2048 + r16 * 128 + 8 * kq;
#pragma unroll
            for (int ks = 0; ks < 4; ++ks) af[j][ks] = *(const bf16x8*)(qp + 32 * ks);
        }
        u32x4 wA[2][2];
        { const int grp = r16 >> 2, mem = r16 & 3;
          const f32x4 wv = mem < 2 ? *(const f32x4*)(WIDX + (size_t)(q0 + 4 * quad + 2 * (grp & 1) + mem) * IDXH + 4 * kq) : (f32x4){0.f, 0.f, 0.f, 0.f};
          const unsigned w01 = pk2(wv[0], wv[1]), w23 = pk2(wv[2], wv[3]);
#pragma unroll
          for (int p = 0; p < 2; ++p)
#pragma unroll
              for (int T = 0; T < 2; ++T) { const bool on = (grp == 2 * T + p) && mem < 2;
                  wA[p][T] = (u32x4){(on && mem == 0) ? w01 : 0u, (on && mem == 0) ? w23 : 0u, (on && mem == 1) ? w01 : 0u, (on && mem == 1) ? w23 : 0u}; } }
        const int ntile = nvis >> 5, nstep = (ntile + 3) >> 2;
        const unsigned soffA = (unsigned)((16 * quad + (lane >> 4)) * 256 + (((lane & 15) ^ (lane >> 4)) << 4));
#define IX_STAGE(step_, buf_) do { const int kt_ = 4 * (step_) + kg; if (kt_ < ntile) { const char* sb_ = KIDXb + (size_t)kt_ * 8192; unsigned so_ = soffA; asm volatile("" : "+v"(so_));   \
            _Pragma("unroll") for (int i_ = 0; i_ < 4; ++i_) { \
            __builtin_amdgcn_global_load_lds((const unsigned*)(sb_ + ((so_ ^ (unsigned)(64 * i_)) + (unsigned)(1024 * i_))), (LAS unsigned*)(KBUF + (buf_) * 32768 + kg * 8192 + (4 * quad + i_) * 1024), 16, 0, 0); } } } while (0)
        const unsigned flane = (unsigned)((4 * quad + 2 * (kq & 1)) * 8192 + 16 * (kq >> 1) + r16);
        LAS unsigned* const hlane = HIST + (4 * quad + 2 * (kq & 1)) * 2048;
#define IX_FLUSH(yv, kt_) do { if ((kt_) < ntile) { _Pragma("unroll") for (int j = 0; j < 2; ++j) { float* scb_ = SC + (size_t)((kt_) * 32 + j * 8192); scb_[flane] = yv[j]; \
            const unsigned bin = fkey(yv[j]) >> 20; lds_add_u32(hlane + j * 2048 + (bin >> 1), 1u << (16 * (bin & 1u))); } } } while (0)
        IX_STAGE(0, 0);
        VM_WAIT(); LDS_WAIT(); __builtin_amdgcn_s_barrier();
        float yp[2] = {0.f, 0.f};
        for (int step = 0; step < nstep; ++step) {
            if (step > 0) IX_FLUSH(yp, 4 * (step - 1) + kg);
            if (step + 1 < nstep) IX_STAGE(step + 1, (step + 1) & 1);
            const unsigned tb = (unsigned)(size_t)(KBUF + (step & 1) * 32768 + kg * 8192) + (unsigned)(r16 * 256 + ((kq ^ r16) << 4));
            bf16x8 bfr[2][4];
#pragma unroll
            for (int T = 0; T < 2; ++T)
#pragma unroll
                for (int ks = 0; ks < 4; ++ks) bfr[T][ks] = *(const LAS bf16x8*)(size_t)((tb ^ (unsigned)(64 * ks)) + 4096 * T);
            f32x4 acc[4][2];
#pragma unroll
            for (int j = 0; j < 4; ++j)
#pragma unroll
                for (int T = 0; T < 2; ++T) acc[j][T] = (f32x4){0.f, 0.f, 0.f, 0.f};
#pragma unroll
            for (int ks = 0; ks < 4; ++ks)
#pragma unroll
                for (int j = 0; j < 4; ++j)
#pragma unroll
                    for (int T = 0; T < 2; ++T) acc[j][T] = __builtin_amdgcn_mfma_f32_16x16x32_bf16(af[j][ks], bfr[T][ks], acc[j][T], 0, 0, 0);
            f32x4 y = {0.f, 0.f, 0.f, 0.f};
#pragma unroll
            for (int p = 0; p < 2; ++p)
#pragma unroll
                for (int T = 0; T < 2; ++T) { const f32x4 xa = acc[2 * p][T], xb = acc[2 * p + 1][T];
                    const u32x4 fr4 = {pk2_relu(xa.x, xa.y), pk2_relu(xa.z, xa.w), pk2_relu(xb.x, xb.y), pk2_relu(xb.z, xb.w)};
                    y = __builtin_amdgcn_mfma_f32_16x16x32_bf16(__builtin_bit_cast(bf16x8, wA[p][T]), __builtin_bit_cast(bf16x8, fr4), y, 0, 0, 0); }
            yp[0] = y.x; yp[1] = y.y;
            VM_WAIT(); LDS_WAIT(); __builtin_amdgcn_s_barrier();
        }
        IX_FLUSH(yp, 4 * (nstep - 1) + kg);
        VM_WAIT(); LDS_WAIT();
        __builtin_amdgcn_s_barrier();
#undef IX_STAGE
#undef IX_FLUSH
        for (int rep_q = 0; rep_q < (PROBE_REP == 42 ? 2 : 1); ++rep_q)
        {
            const float* sc = SC + (size_t)w * 8192; LAS int* idxrow = sidx; const unsigned long long lt_mask = (1ull << lane) - 1ull;
            LAS unsigned* hq = HIST + w * 2048;
            unsigned tl = 0u;
#pragma unroll 8
            for (int i = 0; i < 32; ++i) { const unsigned v = hq[lane * 32 + ((i + lane) & 31)]; tl += (v & 0xffffu) + (v >> 16); }
            const unsigned above_l = wave_above(tl);
            const unsigned long long own = __ballot(above_l < (unsigned)TOPK && above_l + tl >= (unsigned)TOPK);
            const int lo = __ffsll((long long)own) - 1;
            const unsigned above_o = lane_get(above_l, lo);
            const unsigned vw = hq[lo * 32 + (lane >> 1)]; const unsigned cb = (lane & 1) ? (vw >> 16) : (vw & 0xffffu);
            const unsigned above_b = above_o + wave_above(cb);
            const unsigned long long ownb = __ballot(above_b < (unsigned)TOPK && above_b + cb >= (unsigned)TOPK);
            const int lb = __ffsll((long long)ownb) - 1;
            const int b1 = lo * 64 + lb; const unsigned ab1 = lane_get(above_b, lb), cn1 = lane_get(cb, lb);
            if (cn1 > (unsigned)IX_CAP) { __builtin_amdgcn_fence(__ATOMIC_ACQUIRE, "agent"); VM_WAIT(); select_slow(sc, nvis, idxrow, hq, lane); }
            else {
                LAS unsigned* cand = (LAS unsigned*)KBUF + w * (2 * IX_CAP);
                const auto scrs = __builtin_amdgcn_make_buffer_rsrc((void*)sc, 0, 8192 * 4, 0x00020000);
                const unsigned klo = (unsigned)b1 << 20, khi = klo + (1u << 20);
                int selbase = 0, cbase = 0;
                for (int i0 = 0; i0 < nvis; i0 += 2048) {
                    f32x4 v[8];
#pragma unroll
                    for (int j = 0; j < 8; ++j) v[j] = __builtin_bit_cast(f32x4, __builtin_amdgcn_raw_buffer_load_b128(scrs, (unsigned)(((i0 + j * 256 + 4 * lane) & 8191) * 4), 0, 16));
#pragma unroll
                    for (int j = 0; j < 8; ++j) { const int e0 = i0 + j * 256 + 4 * lane; const bool valid = e0 < nvis;
#pragma unroll
                        for (int e = 0; e < 4; ++e) { const unsigned kk = fkey(v[j][e]);
                            const bool ge = valid && kk >= klo; const bool sel = ge && (b1 < 4095) && kk >= khi, cd = ge && !sel;
                            const unsigned long long bs = __ballot(sel), bc = __ballot(cd);
                            if (sel) idxrow[selbase + __popcll(bs & lt_mask)] = e0 + e;
                            if (cd) { const int pos = cbase + __popcll(bc & lt_mask); cand[2 * pos] = kk; cand[2 * pos + 1] = (unsigned)(e0 + e); }
                            selbase += __popcll(bs); cbase += __popcll(bc); } }
                }
                LDS_WAIT();
                const int nc = (int)cn1; int need = TOPK - (int)ab1;
                LAS unsigned* h2 = hq;
                unsigned prefix = klo;
#pragma unroll 1
                for (int pass = 0; pass < 3; ++pass) {
                    const int shift = pass == 0 ? 12 : pass == 1 ? 4 : 0; const unsigned dmask = pass == 2 ? 15u : 255u; const unsigned himask = 0xffffffffu << (pass == 0 ? 20 : pass == 1 ? 12 : 4);
#pragma unroll
                    for (int j = 0; j < 4; ++j) h2[lane * 4 + j] = 0u;
                    LDS_WAIT();
                    for (int i = lane; i < nc; i += 64) { const unsigned kk = cand[2 * i]; if ((kk & himask) == (prefix & himask)) __hip_atomic_fetch_add(&h2[(kk >> shift) & dmask], 1u, __ATOMIC_RELAXED, __HIP_MEMORY_SCOPE_WORKGROUP); }
                    LDS_WAIT();
                    unsigned cnt[4]; unsigned tl2 = 0u;
#pragma unroll
                    for (int j = 0; j < 4; ++j) { cnt[j] = h2[lane * 4 + j]; tl2 += cnt[j]; }
                    unsigned above = wave_above(tl2); int dsel = -1; unsigned asel = 0u;
#pragma unroll
                    for (int j = 3; j >= 0; --j) { if (dsel < 0 && above < (unsigned)need && above + cnt[j] >= (unsigned)need) { dsel = lane * 4 + j; asel = above; } above += cnt[j]; }
                    const unsigned long long bal = __ballot(dsel >= 0); const int src = __ffsll((long long)bal) - 1;
                    const int d = (int)lane_get((unsigned)dsel, src); const unsigned ab = lane_get(asel, src);
                    need -= (int)ab; prefix |= ((unsigned)d) << shift;
                }
                int eqseen = 0;
                for (int i0 = 0; i0 < nc; i0 += 64) {
                    const int i = i0 + lane; const bool vi = i < nc; const unsigned kk = vi ? cand[2 * i] : 0u;
                    const bool gt = vi && kk > prefix, eq = vi && kk == prefix;
                    const unsigned long long beq = __ballot(eq);
                    const int eqrank = eqseen + __popcll(beq & lt_mask);
                    const bool sel = gt || (eq && eqrank < need);
                    const unsigned long long bs = __ballot(sel);
                    if (sel) idxrow[selbase + __popcll(bs & lt_mask)] = (int)cand[2 * i + 1];
                    selbase += __popcll(bs); eqseen += __popcll(beq);
                }
            }
        }
        VM_WAIT(); LDS_WAIT(); __syncthreads();
        unsigned nxt = 0u; if (tid == 0) nxt = xb_add(qc, 1u);
        attn_one(C, a, q0 + w, TOPK);
        if (tid == 0) MISC[MISC_Q4] = nxt;
        LDS_WAIT(); __syncthreads();
        cur = __builtin_amdgcn_readfirstlane((int)MISC[MISC_Q4]);
    }
}

__device__ __forceinline__ void p4_hgrn_out(const Ctx& C, const Args& a, unsigned* qc, volatile LAS unsigned* MISC, int& cur) {
    unsigned char* ws = a.ws;
    const float* G = (const float*)(ws + WS_G); bf16* QA = (bf16*)(ws + WS_QA); const bf16* VA = (const bf16*)(ws + WS_VA); const bf16* GA = (const bf16*)(ws + WS_GA);
    const bf16* SPT = (const bf16*)(ws + WS_SPT);
    LAS unsigned char* QI = C.lds;
    LAS unsigned char* QM = QI + 64 * R128;
    LAS unsigned char* KM = QM + 64 * R128;
    LAS unsigned char* vT = KM + 64 * R128;
    LAS unsigned char* SCb = vT + 128 * R64;
    LAS float* segtot = (LAS float*)(SCb + 64 * R64);
    LAS float* rsp = segtot + 8 * 128;
    const int tid = C.tid, lane = C.lane, w = C.wave, fr = lane & 15, fq = lane >> 4;
    while (cur < 1024 + NCH * BH) {
        const int it = cur - 1024;
        unsigned nxt = 0u; if (tid == 0) nxt = xb_add(qc, 1u);
        const int c = it >> 3, h = it & 7;
        bf16x8 sfr[4][4];
        { const bf16* sp0 = SPT + (size_t)it * 16384 + (size_t)(64 * (w & 1) + fr) * 128 + 8 * fq;
#pragma unroll
          for (int ks = 0; ks < 4; ++ks)
#pragma unroll
              for (int ni = 0; ni < 4; ++ni) sfr[ks][ni] = *(const bf16x8*)(sp0 + (size_t)(16 * ni) * 128 + 32 * ks); }
        unsigned short gav[4][4];
#pragma unroll
        for (int r = 0; r < 4; ++r)
#pragma unroll
            for (int ni = 0; ni < 4; ++ni) gav[r][ni] = GA[(size_t)(c * CHUNK + 16 * (w >> 1) + 4 * fq + r) * AW + h * 128 + 64 * (w & 1) + 16 * ni + fr];
        {
            const int k2 = tid & 63, seg = tid >> 6, t0 = c * CHUNK + seg * 8;
            f32x2 g[8], cum[8]; f32x2 run = {0.f, 0.f};
#pragma unroll
            for (int i = 0; i < 8; ++i) { g[i] = *(const f32x2*)(G + (size_t)(t0 + i) * AW + h * 128 + 2 * k2); run += g[i]; cum[i] = run; }
            unsigned qv[8];
#pragma unroll
            for (int i = 0; i < 8; ++i) qv[i] = *(const unsigned*)(QA + (size_t)(t0 + i) * AW + h * 128 + 2 * k2);
            segtot[seg * 128 + 2 * k2] = run.x; segtot[seg * 128 + 2 * k2 + 1] = run.y;
            { const int v = tid & 127, sg = tid >> 7, tv = c * CHUNK + sg * 16; unsigned vp[8];
#pragma unroll
              for (int i = 0; i < 8; ++i) vp[i] = (unsigned)VA[(size_t)(tv + 2 * i) * AW + h * 128 + v] | ((unsigned)VA[(size_t)(tv + 2 * i + 1) * AW + h * 128 + v] << 16);
              *(LAS u32x4*)(vT + v * R64 + sg * 32) = (u32x4){vp[0], vp[1], vp[2], vp[3]}; *(LAS u32x4*)(vT + v * R64 + sg * 32 + 16) = (u32x4){vp[4], vp[5], vp[6], vp[7]}; }
            __syncthreads();
            f32x2 pre = {0.f, 0.f}, cmid = {0.f, 0.f};
#pragma unroll
            for (int s2 = 0; s2 < 8; ++s2) { const f32x2 st = {segtot[s2 * 128 + 2 * k2], segtot[s2 * 128 + 2 * k2 + 1]}; if (s2 < seg) pre += st; if (s2 < 4) cmid += st; }
#pragma unroll
            for (int i = 0; i < 8; ++i) {
                const f32x2 cm = cum[i] + pre; const float q0 = bflo(qv[i]), q1 = bfhi(qv[i]);
                const int row = seg * 8 + i;
                *(LAS unsigned*)(QI + row * R128 + 4 * k2) = pk2(q0 * __expf(cm.x), q1 * __expf(cm.y));
                *(LAS unsigned*)(QM + row * R128 + 4 * k2) = pk2(q0 * __expf(cm.x - cmid.x), q1 * __expf(cm.y - cmid.y));
                *(LAS unsigned*)(KM + row * R128 + 4 * k2) = pk2(-expm1f(g[i].x) * __expf(cmid.x - cm.x), -expm1f(g[i].y) * __expf(cmid.y - cm.y));
            }
        }
        __syncthreads();
        const int tt = w >> 1;
        {
            f32x4 sa[2] = {{0.f, 0.f, 0.f, 0.f}, {0.f, 0.f, 0.f, 0.f}};
#pragma unroll
            for (int ks = 0; ks < 4; ++ks) {
                const bf16x8 qf = *(const LAS bf16x8*)(QM + (16 * tt + fr) * R128 + (32 * ks + 8 * fq) * 2);
#pragma unroll
                for (int si = 0; si < 2; ++si) { const bf16x8 kf = *(const LAS bf16x8*)(KM + (16 * (2 * (w & 1) + si) + fr) * R128 + (32 * ks + 8 * fq) * 2);
                    sa[si] = __builtin_amdgcn_mfma_f32_16x16x32_bf16(qf, kf, sa[si], 0, 0, 0); }
            }
#pragma unroll
            for (int si = 0; si < 2; ++si)
#pragma unroll
                for (int r = 0; r < 4; ++r) { const int t = 16 * tt + 4 * fq + r, s = 16 * (2 * (w & 1) + si) + fr;
                    *(LAS unsigned short*)(SCb + t * R64 + s * 2) = (unsigned short)f2bf(s <= t ? sa[si][r] : 0.f); }
        }
        __syncthreads();
        f32x4 acc[4];
#pragma unroll
        for (int ni = 0; ni < 4; ++ni) acc[ni] = (f32x4){0.f, 0.f, 0.f, 0.f};
        {
#pragma unroll
            for (int ks = 0; ks < 4; ++ks) {
                const bf16x8 qf = *(const LAS bf16x8*)(QI + (16 * tt + fr) * R128 + (32 * ks + 8 * fq) * 2);
#pragma unroll
                for (int ni = 0; ni < 4; ++ni) acc[ni] = __builtin_amdgcn_mfma_f32_16x16x32_bf16(qf, sfr[ks][ni], acc[ni], 0, 0, 0);
            }
#pragma unroll
            for (int ks = 0; ks < 2; ++ks) {
                const bf16x8 pf = *(const LAS bf16x8*)(SCb + (16 * tt + fr) * R64 + (32 * ks + 8 * fq) * 2);
#pragma unroll
                for (int ni = 0; ni < 4; ++ni) { const bf16x8 vf = *(const LAS bf16x8*)(vT + (64 * (w & 1) + 16 * ni + fr) * R64 + (32 * ks + 8 * fq) * 2);
                    acc[ni] = __builtin_amdgcn_mfma_f32_16x16x32_bf16(pf, vf, acc[ni], 0, 0, 0); }
            }
        }
        float ss[4];
#pragma unroll
        for (int r = 0; r < 4; ++r) { float s = 0.f;
#pragma unroll
            for (int ni = 0; ni < 4; ++ni) s += acc[ni][r] * acc[ni][r];
            ss[r] = row16_sum(s); }
        if (fr == 0) {
#pragma unroll
            for (int r = 0; r < 4; ++r) rsp[(16 * tt + 4 * fq + r) * 2 + (w & 1)] = ss[r]; }
        __syncthreads();
#pragma unroll
        for (int r = 0; r < 4; ++r) {
            const int tl = 16 * tt + 4 * fq + r; const float rstd = rsqrtf((rsp[tl * 2] + rsp[tl * 2 + 1]) * (1.f / 128.f) + EPS);
            const size_t rowoff = (size_t)(c * CHUNK + tl) * AW + h * 128;
#pragma unroll
            for (int ni = 0; ni < 4; ++ni) { const int v = 64 * (w & 1) + 16 * ni + fr;
                const unsigned short yv = (unsigned short)f2bf(acc[ni][r] * rstd * a.gnorm_a[v] * bf2f(gav[r][ni])); QA[rowoff + v] = yv; }
        }
        if (tid == 0) MISC[MISC_Q4] = nxt;
        LDS_WAIT(); __syncthreads();
        cur = __builtin_amdgcn_readfirstlane((int)MISC[MISC_Q4]);
    }
}

struct SchedUV {
    pg8::TileOrder T; const char* Ab; const char* Bb;
    __device__ __forceinline__ bool next(int i, pg8::Unit& u) const { u.sub = 0; return T.tile(i, u.pm, u.pn); }
    __device__ __forceinline__ const char* A(const pg8::Unit& u) const { return Ab + ((size_t)u.pm * 256 * 2048 + (size_t)u.pn * 512) * 2; }
    __device__ __forceinline__ const char* B(const pg8::Unit& u) const { return Bb + (size_t)u.pn * 256 * 512 * 2; }
    __device__ __forceinline__ bool keep(const pg8::Unit&) const { return false; }
};
struct EpiUV {
    unsigned char* ws;
    __device__ __forceinline__ void operator()(f32x4 (&acc)[2][2][4][2], const pg8::Unit& u, int wr, int wc, int fr, int fq) const {
        bf16* O = (bf16*)(ws + WS_GB);
        EPI_FOREACH({ const u32x4 gv = *(const u32x4*)(O + (size_t)row * AW + col); u32x4 w;
            w.x = pk2(v0[0] * bflo(gv.x), v0[1] * bfhi(gv.x)); w.y = pk2(v0[2] * bflo(gv.y), v0[3] * bfhi(gv.y)); w.z = pk2(v1[0] * bflo(gv.z), v1[1] * bfhi(gv.z)); w.w = pk2(v1[2] * bflo(gv.w), v1[3] * bfhi(gv.w));
            *(u32x4*)(O + (size_t)row * AW + col) = w; })
    }
};
struct SchedMerge {
    pg8::TileOrder T; const char* Aa; const char* Ab; const char* Ba; const char* Bb;
    __device__ __forceinline__ bool next(int i, pg8::Unit& u) const { u.sub = i & 1; return T.tile(i >> 1, u.pm, u.pn); }
    __device__ __forceinline__ const char* A(const pg8::Unit& u) const { return (u.sub ? Ab : Aa) + (size_t)u.pm * 256 * AW * 2; }
    __device__ __forceinline__ const char* B(const pg8::Unit& u) const { return (u.sub ? Bb : Ba) + (size_t)u.pn * 256 * AW * 2; }
    __device__ __forceinline__ bool keep(const pg8::Unit& u) const { return u.sub == 0; }
};
struct EpiMerge {
    unsigned char* ws;
    __device__ __forceinline__ void operator()(f32x4 (&acc)[2][2][4][2], const pg8::Unit& u, int wr, int wc, int fr, int fq) const {
        const bf16* SA = (const bf16*)(ws + WS_SA); bf16* SB = (bf16*)(ws + WS_SB);
        if (u.sub == 0) {
            EPI_FOREACH({ const u32x4 av = *(const u32x4*)(SA + (size_t)row * D_ + col); const u32x4 bv = *(const u32x4*)(SB + (size_t)row * D_ + col);
                v0[0] *= bflo(av.x) * __builtin_amdgcn_rcpf(bflo(bv.x)); v0[1] *= bfhi(av.x) * __builtin_amdgcn_rcpf(bfhi(bv.x)); v0[2] *= bflo(av.y) * __builtin_amdgcn_rcpf(bflo(bv.y)); v0[3] *= bfhi(av.y) * __builtin_amdgcn_rcpf(bfhi(bv.y));
                v1[0] *= bflo(av.z) * __builtin_amdgcn_rcpf(bflo(bv.z)); v1[1] *= bfhi(av.z) * __builtin_amdgcn_rcpf(bfhi(bv.z)); v1[2] *= bflo(av.w) * __builtin_amdgcn_rcpf(bflo(bv.w)); v1[3] *= bfhi(av.w) * __builtin_amdgcn_rcpf(bfhi(bv.w)); })
        } else {
            EPI_FOREACH({ const u32x4 bv = *(const u32x4*)(SB + (size_t)row * D_ + col); u32x4 w;
                w.x = pk2(v0[0] * bflo(bv.x), v0[1] * bfhi(bv.x)); w.y = pk2(v0[2] * bflo(bv.y), v0[3] * bfhi(bv.y)); w.z = pk2(v1[0] * bflo(bv.z), v1[1] * bfhi(bv.z)); w.w = pk2(v1[2] * bflo(bv.w), v1[3] * bfhi(bv.w));
                *(u32x4*)(SB + (size_t)row * D_ + col) = w; })
        }
    }
};
struct EpiOut {
    const float* x; bf16* ybf; float* RS;
    __device__ __forceinline__ void operator()(f32x4 (&acc)[2][2][4][2], const pg8::Unit& u, int wr, int wc, int fr, int fq) const {
#pragma unroll
        for (int ai = 0; ai < 2; ++ai)
#pragma unroll
            for (int m = 0; m < 4; ++m) { const int row = u.pm * 256 + ai * 128 + wr * 64 + m * 16 + fr; float ss = 0.f;
#pragma unroll
                for (int bj = 0; bj < 2; ++bj) { const int col = u.pn * 256 + bj * 128 + wc * 32 + 8 * fq; const size_t off = (size_t)row * D_ + col;
                    const f32x4 x0 = *(const f32x4*)(x + off), x1 = *(const f32x4*)(x + off + 4); const f32x4 y0 = x0 + acc[ai][bj][m][0], y1 = x1 + acc[ai][bj][m][1];
                    u32x4 pw; pw.x = pk2(y0[0], y0[1]); pw.y = pk2(y0[2], y0[3]); pw.z = pk2(y1[0], y1[1]); pw.w = pk2(y1[2], y1[3]);
                    *(u32x4*)(ybf + off) = pw;
                    ss += (y0[0] * y0[0] + y0[1] * y0[1]) + (y0[2] * y0[2] + y0[3] * y0[3]) + (y1[0] * y1[0] + y1[1] * y1[1]) + (y1[2] * y1[2] + y1[3] * y1[3]); }
                ss = rows_sum(ss);
                if (fq == 0) atomicAdd(RS + row, ss); }
    }
};
__device__ __forceinline__ void p9_final_norm(const Ctx& C, const Args& a) {
    const float* RS = (const float*)(a.ws + WS_CTL) + RS_WORD; const bf16* YBF = (const bf16*)(a.ws + WS_G);
    const int gw = C.wg * NWAVES + C.wave, NGW = C.G * NWAVES;
    for (int m = gw; m < S_; m += NGW) {
        const float rs = rsqrtf(RS[m] * (1.f / D_) + EPS);
        const u32x4* yr = (const u32x4*)(YBF + (size_t)m * D_) + C.lane; f32x4* orow = (f32x4*)(a.out + (size_t)m * D_); const f32x4* wr = (const f32x4*)a.final_norm_w;
#pragma unroll
        for (int j = 0; j < 4; ++j) { const u32x4 yv = yr[64 * j]; const int c4 = 2 * (C.lane + 64 * j);
            const f32x4 w0 = wr[c4], w1 = wr[c4 + 1];
            f32x4 o0, o1; o0.x = bflo(yv.x) * rs * w0.x; o0.y = bfhi(yv.x) * rs * w0.y; o0.z = bflo(yv.y) * rs * w0.z; o0.w = bfhi(yv.y) * rs * w0.w;
            o1.x = bflo(yv.z) * rs * w1.x; o1.y = bfhi(yv.z) * rs * w1.y; o1.z = bflo(yv.w) * rs * w1.z; o1.w = bfhi(yv.w) * rs * w1.w;
            orow[c4] = o0; orow[c4 + 1] = o1; }
    }
}

#ifndef MK_N_LAUNCHES
#define MK_N_LAUNCHES 1
#endif
constexpr int N_PHASES = 10;
__global__ void __launch_bounds__(NTHR, 2) mega_fwd(Args a) {
    extern __shared__ __attribute__((aligned(16))) unsigned char lds_raw[];
    Ctx C; C.lds = (LAS unsigned char*)lds_raw; C.tid = threadIdx.x; C.lane = C.tid & 63; C.wave = __builtin_amdgcn_readfirstlane(C.tid >> 6); C.wg = blockIdx.x; C.G = gridDim.x;
    volatile LAS unsigned* MISC = (volatile LAS unsigned*)(C.lds + MISC_OFF);
    if (C.tid < 32) MISC[C.tid] = 0u;
    __syncthreads();
    unsigned char* ws = a.ws;
    XcdBarrier bar; bar.bar = (unsigned*)(ws + WS_CTL) + CW_BAR; bar.x = 0; bar.st = nullptr;
    const int lo = a.ph_lo, hi = a.ph_hi;
    if (hi - lo > 1) bar = xcd_barrier_post((unsigned*)(ws + WS_CTL) + CW_BAR, MISC + 8);
#define IN(k) (lo <= (k) && (k) < hi)
#define SEAM(k) do { if (IN(k) && IN((k) + 1)) xcd_barrier(bar); } while (0)
    float* dscr = a.out;
    if (IN(0)) { REP(0) p0_prep(C, a); } SEAM(0);
    if (IN(1)) {
        SchedPlain S; S.T.init(S_, NIN, C.G, C.wg); S.Ab = (const char*)(ws + WS_H); S.Bb = (const char*)(ws + WS_WIN); S.tA = (size_t)256 * D_ * 2; S.tB = (size_t)256 * D_ * 2;
        EpiProj E{ws}; REP(1) pg8::gemm_phase(C.lds, D_, D_, D_, S, E);
    } SEAM(1);
    if (IN(2)) { REP(2) p2_norms(C, a); REP(12) p2_hgrn_states(C, a, dscr); } SEAM(2);
    if (IN(3)) {
        SchedPlain S; S.T.init(S_, 4096, C.G, C.wg); S.Ab = (const char*)(ws + WS_CQN); S.Bb = (const char*)(ws + WS_WQ); S.tA = (size_t)256 * QR * 2; S.tB = (size_t)256 * QR * 2;
        EpiQ E{ws}; REP(3) pg8::gemm_phase(C.lds, QR, QR, QR, S, E);
        REP(13) p3_scan(C, a, dscr);
    } SEAM(3);
    if (IN(4)) {
        unsigned* qc = (unsigned*)(ws + WS_CTL) + CW_Q4;
        if (C.tid == 0) MISC[MISC_Q4] = xb_add(qc, 1u);
        attn_setup(C, a);
        int cur = __builtin_amdgcn_readfirstlane((int)MISC[MISC_Q4]);
        p4_indexer(C, a, dscr, qc, MISC, cur); p4_hgrn_out(C, a, qc, MISC, cur);
    } SEAM(4);
    if (IN(6)) {
        SchedUV S; S.T.init(S_, AW, C.G, C.wg); S.Ab = (const char*)(ws + WS_RAW); S.Bb = (const char*)(ws + WS_WUV);
        EpiUV E{ws}; pg8::gemm_phase(C.lds, 2048, 512, 512, S, E);
    } SEAM(6);
    if (IN(7)) {
        SchedMerge S; S.T.init(S_, D_, C.G, C.wg); S.Aa = (const char*)(ws + WS_QA); S.Ab = (const char*)(ws + WS_GB); S.Ba = (const char*)(ws + WS_WPA); S.Bb = (const char*)(ws + WS_WPB);
        EpiMerge E{ws}; pg8::gemm_phase(C.lds, AW, AW, AW, S, E);
    } SEAM(7);
    if (IN(8)) {
        SchedPlain S; S.T.init(S_, D_, C.G, C.wg); S.Ab = (const char*)(ws + WS_SB); S.Bb = (const char*)(ws + WS_WOUT); S.tA = (size_t)256 * D_ * 2; S.tB = (size_t)256 * D_ * 2;
        EpiOut E{a.x, (bf16*)(ws + WS_G), (float*)(ws + WS_CTL) + RS_WORD}; pg8::gemm_phase(C.lds, D_, D_, D_, S, E);
    } SEAM(8);
    if (IN(9)) { p9_final_norm(C, a); }
#undef IN
#undef SEAM
}

extern "C" void kernel_launch(void* const* d_in, const int* in_sizes, int n_in, void* d_out, int out_size, void* d_ws, size_t ws_size, hipStream_t stream) {
    static int grid = 0;
    if (grid == 0) {
        if (n_in != 17 || in_sizes[0] != S_ * D_ || out_size != S_ * D_ || ws_size < WS_END) {
            fprintf(stderr, "kernel_launch: unexpected shapes / workspace (n_in %d, in0 %d, out %d, ws %zu < %zu); nothing launched\n", n_in, n_in > 0 ? in_sizes[0] : -1, out_size, ws_size, (size_t)WS_END); grid = -1; return; }
        int dev = 0, cus = 0;
        if (hipGetDevice(&dev) != hipSuccess || hipDeviceGetAttribute(&cus, hipDeviceAttributeMultiprocessorCount, dev) != hipSuccess) { grid = -1; return; }
        if (hipFuncSetAttribute((const void*)mega_fwd, hipFuncAttributeMaxDynamicSharedMemorySize, LDS_BYTES) != hipSuccess) { fprintf(stderr, "kernel_launch: hipFuncSetAttribute failed\n"); grid = -1; return; }
        (void)hipGetLastError();
        grid = cus;
    }
    if (grid < 0) return;
    (void)hipMemsetAsync((char*)d_ws + WS_CTL, 0, CTL_ZERO_BYTES, stream);
    Args a{};
    const float** ip = (const float**)&a;
    for (int i = 0; i < 17; ++i) ip[i] = (const float*)d_in[i];
    a.out = (float*)d_out; a.ws = (unsigned char*)d_ws;
    constexpr int NL = MK_N_LAUNCHES;
    for (int li = 0; li < NL; ++li) {
        a.ph_lo = li * N_PHASES / NL; a.ph_hi = (li + 1) * N_PHASES / NL;
        hipLaunchKernelGGL(mega_fwd, dim3(grid), dim3(NTHR), LDS_BYTES, stream, a);
    }
}
```

```cpp
#include <hip/hip_runtime.h>
#include <cstdio>

#define LAS __attribute__((address_space(3)))
#define GAS __attribute__((address_space(1)))
typedef unsigned short bf16;
typedef short bf16x8 __attribute__((ext_vector_type(8)));
typedef short s16x4 __attribute__((ext_vector_type(4)));
typedef float f32x4 __attribute__((ext_vector_type(4)));
typedef float f32x2 __attribute__((ext_vector_type(2)));
typedef float f32x16 __attribute__((ext_vector_type(16)));
typedef unsigned u32x4 __attribute__((ext_vector_type(4)));
typedef unsigned u32x2 __attribute__((ext_vector_type(2)));

namespace pg8 {
constexpr int BM = 256, BK = 64, HALF = 128, HTB = HALF * BK * 2, STAGE_BYTES = 8 * HTB, NXCD = 8, WGM = 8;
__device__ __forceinline__ int lds_byte(int r, int c) { const int st = (r >> 4) * 2 + (c >> 5), rr = r & 15, cc = c & 31, ob = rr * 64 + cc * 2; return st * 1024 + (ob ^ (((ob >> 9) & 1) << 5)); }
__device__ __forceinline__ void stage_rc(int b, int& R, int& C) { const int st = b / 1024, sb = b % 1024, swz = sb ^ (((sb >> 9) & 1) << 5); R = (st >> 1) * 16 + swz / 64; C = (st & 1) * 32 + (swz % 64) / 2; }
__device__ __forceinline__ int perm32(int rho) { const int n = rho >> 4, i = rho & 15; return 8 * (i >> 2) + 4 * n + (i & 3); }
struct Unit { int pm, pn, sub; };
struct TileOrder {
    int nM, nN, nwg, G, c;
    __device__ void init(int M, int N, int G_, int c_) { nM = M / BM; nN = N / BM; nwg = nM * nN; G = G_; c = c_; }
    __device__ bool tile(int i, int& pm, int& pn) const {
        const long L = (long)i * G + c; if (L >= nwg) return false;
        int wgid = (int)L; { const int q = nwg / NXCD, r = nwg % NXCD, xcd = wgid % NXCD, off = wgid / NXCD; wgid = (xcd < r ? xcd * (q + 1) : r * (q + 1) + (xcd - r) * q) + off; }
        const int nig = WGM * nN, gid = wgid / nig, fm = gid * WGM, gsz = (nM - fm) < WGM ? (nM - fm) : WGM;
        pm = fm + ((wgid % nig) % gsz); pn = (wgid % nig) / gsz; return true;
    }
};
template <class Epi, class Sched, bool ALIGN_EPI = true, bool SP2 = true>
__device__ __forceinline__ void gemm_phase(LAS unsigned char* lds, const int lda, const int ldb, const int K, const Sched& S, const Epi& E) {
    const int tid = threadIdx.x, wid = __builtin_amdgcn_readfirstlane(tid >> 6), lane = tid & 63, wr = wid >> 2, wc = wid & 3, fr = lane & 15, fq = lane >> 4;
    const int nt = K / BK;
    unsigned voffA[2], voffB[2];
#pragma unroll
    for (int i = 0; i < 2; ++i) { int R, C; stage_rc(tid * 16 + i * 8192, R, C); const int Rb = (R & ~31) + perm32(R & 31);
        voffA[i] = (unsigned)(R * lda + C) * 2u; voffB[i] = (unsigned)(Rb * ldb + C) * 2u; }
    const size_t kstep = (size_t)(BK * 2);
    const size_t hstepA = (size_t)HALF * lda * 2, hstepB = (size_t)HALF * ldb * 2;
    const unsigned ldsw = (unsigned)wid * 1024u;
    const int aoff = lds_byte(wr * 64 + fr, fq * 8), boff = lds_byte(wc * 32 + fr, fq * 8);
#define PG8_SA(b, h) (((b) * 2 + (h)) * HTB)
#define PG8_SB(b, h) ((4 + (b) * 2 + (h)) * HTB)
#define PG8_STAGE(bufoff, gbase, voff) do { _Pragma("unroll") for (int _i = 0; _i < 2; ++_i) \
        __builtin_amdgcn_global_load_lds((const unsigned*)((const char*)(gbase) + (voff)[_i]), (LAS unsigned*)(lds + (bufoff) + ldsw + _i * 8192), 16, 0, 0); } while (0)
#define PG8_LDA(dst, b, h) do { _Pragma("unroll") for (int m = 0; m < 4; ++m) _Pragma("unroll") for (int k = 0; k < 2; ++k) dst[m][k] = *(const LAS bf16x8*)(lds + PG8_SA(b, h) + aoff + m * 2048 + k * 1024); } while (0)
#define PG8_LDB(dst, b, h) do { _Pragma("unroll") for (int n = 0; n < 2; ++n) _Pragma("unroll") for (int k = 0; k < 2; ++k) dst[n][k] = *(const LAS bf16x8*)(lds + PG8_SB(b, h) + boff + n * 2048 + k * 1024); } while (0)
#define PG8_MMA(ai, bj, At, Bt) do { __builtin_amdgcn_s_setprio(1); _Pragma("unroll") for (int m = 0; m < 4; ++m) _Pragma("unroll") for (int n = 0; n < 2; ++n) _Pragma("unroll") for (int k = 0; k < 2; ++k) \
        acc[ai][bj][m][n] = __builtin_amdgcn_mfma_f32_16x16x32_bf16(Bt[n][k], At[m][k], acc[ai][bj][m][n], 0, 0, 0); __builtin_amdgcn_s_setprio(0); } while (0)
#define PG8_WAIT_V(n) asm volatile("s_waitcnt vmcnt(" #n ")" ::: "memory")
#define PG8_WAIT_L(n) asm volatile("s_waitcnt lgkmcnt(" #n ")" ::: "memory")
#define PG8_BAR __builtin_amdgcn_s_barrier()
#define PG8_SCHED __builtin_amdgcn_sched_barrier(0)
    Unit cur, nxt; int ui = 0;
    if (!S.next(0, cur)) return;
    f32x4 acc[2][2][4][2];
#pragma unroll
    for (int a = 0; a < 2; ++a)
#pragma unroll
        for (int b = 0; b < 2; ++b)
#pragma unroll
            for (int m = 0; m < 4; ++m)
#pragma unroll
                for (int n = 0; n < 2; ++n) acc[a][b][m][n] = (f32x4){0.f, 0.f, 0.f, 0.f};
    bf16x8 At[4][2], B0[2][2], B1[2][2];
    const char* cA = S.A(cur); const char* cB = S.B(cur);
    if constexpr (SP2) {
        PG8_STAGE(PG8_SB(0, 0), cB, voffB); PG8_STAGE(PG8_SB(0, 1), cB + hstepB, voffB); PG8_STAGE(PG8_SA(0, 0), cA, voffA); PG8_STAGE(PG8_SA(0, 1), cA + hstepA, voffA);
        if (wr == 1) PG8_BAR;
        PG8_WAIT_V(2); PG8_BAR;
        PG8_STAGE(PG8_SB(1, 0), cB + kstep, voffB); PG8_STAGE(PG8_SA(1, 0), cA + kstep, voffA); PG8_STAGE(PG8_SB(1, 1), cB + hstepB + kstep, voffB);
        PG8_WAIT_V(6); PG8_BAR;
    } else {
        PG8_STAGE(PG8_SB(0, 0), cB, voffB); PG8_STAGE(PG8_SA(0, 0), cA, voffA); PG8_STAGE(PG8_SB(0, 1), cB + hstepB, voffB); PG8_STAGE(PG8_SA(0, 1), cA + hstepA, voffA);
        if (wr == 1) PG8_BAR;
        PG8_WAIT_V(4); PG8_BAR;
        PG8_STAGE(PG8_SB(1, 0), cB + kstep, voffB); PG8_STAGE(PG8_SA(1, 0), cA + kstep, voffA); PG8_STAGE(PG8_SB(1, 1), cB + hstepB + kstep, voffB);
        PG8_WAIT_V(6); PG8_BAR;
    }
    for (;;) {
        const bool has_next = S.next(ui + 1, nxt);
        const char* nA = has_next ? S.A(nxt) : cA; const char* nB = has_next ? S.B(nxt) : cB;
        for (int t = 0; t < nt; t += 2) {
            const bool last = (t == nt - 2);
            const char* a1 = cA + (size_t)(t + 1) * kstep;
            const char* a2 = last ? nA : cA + (size_t)(t + 2) * kstep; const char* b2 = last ? nB : cB + (size_t)(t + 2) * kstep;
            const char* a3 = a2 + kstep; const char* b3 = b2 + kstep;
            if constexpr (SP2) {
            PG8_LDB(B0, 0, 0); PG8_LDB(B1, 0, 1); PG8_SCHED; PG8_LDA(At, 0, 0); PG8_STAGE(PG8_SA(1, 1), a1 + hstepA, voffA);
            PG8_WAIT_V(8); PG8_WAIT_L(0); PG8_BAR; PG8_MMA(0, 0, At, B0); PG8_MMA(0, 1, At, B1); PG8_BAR; PG8_SCHED;
            PG8_LDA(At, 0, 1); PG8_STAGE(PG8_SB(0, 0), b2, voffB); PG8_STAGE(PG8_SB(0, 1), b2 + hstepB, voffB); PG8_STAGE(PG8_SA(0, 0), a2, voffA);
            PG8_WAIT_V(8); PG8_WAIT_L(0); PG8_BAR; PG8_MMA(1, 0, At, B0); PG8_MMA(1, 1, At, B1); PG8_BAR; PG8_SCHED;
            PG8_LDB(B0, 1, 0); PG8_LDB(B1, 1, 1); PG8_SCHED; PG8_LDA(At, 1, 0); PG8_STAGE(PG8_SA(0, 1), a2 + hstepA, voffA);
            PG8_WAIT_V(8); PG8_WAIT_L(0); PG8_BAR; PG8_MMA(0, 0, At, B0); PG8_MMA(0, 1, At, B1); PG8_BAR; PG8_SCHED;
            PG8_LDA(At, 1, 1); PG8_STAGE(PG8_SB(1, 0), b3, voffB); PG8_STAGE(PG8_SB(1, 1), b3 + hstepB, voffB); PG8_STAGE(PG8_SA(1, 0), a3, voffA);
            PG8_WAIT_V(8); PG8_WAIT_L(0); PG8_BAR; PG8_MMA(1, 0, At, B0); PG8_MMA(1, 1, At, B1); PG8_BAR; PG8_SCHED;
            } else {
            PG8_LDB(B0, 0, 0); PG8_SCHED; PG8_LDA(At, 0, 0); PG8_STAGE(PG8_SA(1, 1), a1 + hstepA, voffA);
            PG8_WAIT_L(8); PG8_BAR; PG8_WAIT_L(0); PG8_MMA(0, 0, At, B0); PG8_BAR; PG8_SCHED;
            PG8_LDB(B1, 0, 1); PG8_STAGE(PG8_SB(0, 0), b2, voffB);
            PG8_BAR; PG8_WAIT_L(0); PG8_MMA(0, 1, At, B1); PG8_BAR;
            PG8_LDA(At, 0, 1); PG8_STAGE(PG8_SA(0, 0), a2, voffA);
            PG8_BAR; PG8_WAIT_L(0); PG8_MMA(1, 0, At, B0); PG8_BAR; PG8_SCHED;
            PG8_STAGE(PG8_SB(0, 1), b2 + hstepB, voffB);
            PG8_WAIT_V(6); PG8_BAR; PG8_MMA(1, 1, At, B1); PG8_BAR;
            PG8_LDB(B0, 1, 0); PG8_SCHED; PG8_LDA(At, 1, 0); PG8_STAGE(PG8_SA(0, 1), a2 + hstepA, voffA);
            PG8_WAIT_L(8); PG8_BAR; PG8_WAIT_L(0); PG8_MMA(0, 0, At, B0); PG8_BAR; PG8_SCHED;
            PG8_LDB(B1, 1, 1); PG8_STAGE(PG8_SB(1, 0), b3, voffB);
            PG8_BAR; PG8_WAIT_L(0); PG8_MMA(0, 1, At, B1); PG8_BAR;
            PG8_LDA(At, 1, 1); PG8_STAGE(PG8_SA(1, 0), a3, voffA);
            PG8_BAR; PG8_WAIT_L(0); PG8_MMA(1, 0, At, B0); PG8_BAR; PG8_SCHED;
            PG8_STAGE(PG8_SB(1, 1), b3 + hstepB, voffB);
            PG8_WAIT_V(6); PG8_BAR; PG8_MMA(1, 1, At, B1); PG8_BAR;
            }
        }
        if constexpr (ALIGN_EPI) { if (wr == 0) PG8_BAR; }
        E(acc, cur, wr, wc, fr, fq);
        if (!has_next) break;
        if (!S.keep(cur)) {
#pragma unroll
            for (int a = 0; a < 2; ++a)
#pragma unroll
                for (int b = 0; b < 2; ++b)
#pragma unroll
                    for (int m = 0; m < 4; ++m)
#pragma unroll
                        for (int n = 0; n < 2; ++n) acc[a][b][m][n] = (f32x4){0.f, 0.f, 0.f, 0.f};
        }
        cur = nxt; cA = nA; cB = nB; ++ui;
        if constexpr (ALIGN_EPI) { if (wr == 1) PG8_BAR; }
    }
    PG8_WAIT_V(0);
    if constexpr (!ALIGN_EPI) { if (wr == 0) PG8_BAR; }
    PG8_BAR;
#undef PG8_SA
#undef PG8_SB
#undef PG8_STAGE
#undef PG8_LDA
#undef PG8_LDB
#undef PG8_MMA
#undef PG8_WAIT_V
#undef PG8_WAIT_L
#undef PG8_BAR
#undef PG8_SCHED
}
}

#ifndef PROBE_REP
#define PROBE_REP -1
#endif
#define REP(k) for (int _r = 0; _r < ((k) == PROBE_REP ? 2 : 1); ++_r)
constexpr int S_ = 8192, D_ = 2048, AW = 1024, QR = 512, KVR = 256, IDXD = 128, IDXH = 16, BH = 8, TOPK = 256, CHUNK = 64, NCH = S_ / CHUNK;
constexpr int IN_W = 10128, NIN = 10240;
constexpr float EPS = 1e-6f;
constexpr int NWAVES = 8, NTHR = 512;

constexpr size_t MiB = 1u << 20;
constexpr size_t WS_CTL = 0, CTL_ZERO_BYTES = 1 * MiB;
constexpr size_t WS_LB = 1 * MiB;
constexpr size_t WS_NCNT = 1 * MiB + 64 * 1024;
constexpr size_t WS_DLAST = 1 * MiB + 128 * 1024;
constexpr size_t WS_WIDX = 2 * MiB;
constexpr size_t WS_WQ = 4 * MiB;
constexpr size_t WS_WUV = 8 * MiB;
constexpr size_t WS_WPA = 9 * MiB, WS_WPB = 13 * MiB;
constexpr size_t WS_WOUT = 17 * MiB;
constexpr size_t WS_QA = 25 * MiB;
constexpr size_t WS_G = 41 * MiB;
constexpr size_t WS_VA = 73 * MiB;
constexpr size_t WS_GA = 89 * MiB;
constexpr size_t WS_GB = 105 * MiB;
constexpr size_t WS_SA = 121 * MiB;
constexpr size_t WS_SB = 153 * MiB;
constexpr size_t WS_RAW = 185 * MiB;
constexpr size_t WS_H = 217 * MiB;
constexpr size_t WS_CQN = 217 * MiB, WS_CKVN = 225 * MiB, WS_KIDX = 229 * MiB, WS_IDX = 231 * MiB;
constexpr size_t WS_WIN = 249 * MiB;
constexpr size_t WS_QABS = 249 * MiB;
constexpr size_t WS_SPT = 281 * MiB;
constexpr size_t WS_END = 313 * MiB;
constexpr int RS_WORD = 65536;
constexpr int CW_BAR = 4096;
constexpr int CW_Q4 = 8192;
constexpr int MISC_Q4 = 16;

typedef __bf16 bf16x2_t __attribute__((ext_vector_type(2)));
typedef short s16x2 __attribute__((ext_vector_type(2)));
__device__ __forceinline__ unsigned pk2(float lo, float hi) { const f32x2 v = {lo, hi}; return __builtin_bit_cast(unsigned, __builtin_convertvector(v, bf16x2_t)); }
__device__ __forceinline__ unsigned f2bf(float f) { return pk2(f, 0.f) & 0xffffu; }
__device__ __forceinline__ unsigned pk2_relu(float lo, float hi) { const f32x2 v = {lo, hi}; const s16x2 z = {0, 0};
    return __builtin_bit_cast(unsigned, __builtin_elementwise_max(__builtin_bit_cast(s16x2, __builtin_convertvector(v, bf16x2_t)), z)); }
__device__ __forceinline__ float bf2f(unsigned short b) { return __builtin_bit_cast(float, ((unsigned)b) << 16); }
__device__ __forceinline__ float bflo(unsigned w) { return __builtin_bit_cast(float, w << 16); }
__device__ __forceinline__ float bfhi(unsigned w) { return __builtin_bit_cast(float, w & 0xffff0000u); }
template <int CTRL, int ROWMASK, bool BOUND> __device__ __forceinline__ unsigned dpp_mov(unsigned x) { return (unsigned)__builtin_amdgcn_update_dpp(0, (int)x, CTRL, ROWMASK, 0xf, BOUND); }
__device__ __forceinline__ float row16_sum(float v) {
    v += __builtin_bit_cast(float, dpp_mov<0x128, 0xf, false>(__builtin_bit_cast(unsigned, v)));
    v += __builtin_bit_cast(float, dpp_mov<0x124, 0xf, false>(__builtin_bit_cast(unsigned, v)));
    v += __builtin_bit_cast(float, dpp_mov<0x122, 0xf, false>(__builtin_bit_cast(unsigned, v)));
    v += __builtin_bit_cast(float, dpp_mov<0x121, 0xf, false>(__builtin_bit_cast(unsigned, v)));
    return v;
}
__device__ __forceinline__ float rows_sum(float v) {
    { const auto r = __builtin_amdgcn_permlane32_swap(__builtin_bit_cast(unsigned, v), __builtin_bit_cast(unsigned, v), false, false); const unsigned a0 = r[0], a1 = r[1];
      v = __builtin_bit_cast(float, a0) + __builtin_bit_cast(float, a1); }
    { const auto r = __builtin_amdgcn_permlane16_swap(__builtin_bit_cast(unsigned, v), __builtin_bit_cast(unsigned, v), false, false); const unsigned a0 = r[0], a1 = r[1];
      v = __builtin_bit_cast(float, a0) + __builtin_bit_cast(float, a1); }
    return v;
}
__device__ __forceinline__ float rows_max(float v) {
    { const auto r = __builtin_amdgcn_permlane32_swap(__builtin_bit_cast(unsigned, v), __builtin_bit_cast(unsigned, v), false, false); const unsigned a0 = r[0], a1 = r[1];
      v = fmaxf(__builtin_bit_cast(float, a0), __builtin_bit_cast(float, a1)); }
    { const auto r = __builtin_amdgcn_permlane16_swap(__builtin_bit_cast(unsigned, v), __builtin_bit_cast(unsigned, v), false, false); const unsigned a0 = r[0], a1 = r[1];
      v = fmaxf(__builtin_bit_cast(float, a0), __builtin_bit_cast(float, a1)); }
    return v;
}
__device__ __forceinline__ float wave_sum(float v) { return rows_sum(row16_sum(v)); }
__device__ __forceinline__ unsigned wave_scan_incl(unsigned x) {
    x += dpp_mov<0x111, 0xf, true>(x); x += dpp_mov<0x112, 0xf, true>(x); x += dpp_mov<0x114, 0xf, true>(x); x += dpp_mov<0x118, 0xf, true>(x);
    x += dpp_mov<0x142, 0xa, false>(x); x += dpp_mov<0x143, 0xc, false>(x);
    return x;
}
__device__ __forceinline__ unsigned wave_above(unsigned x) { const unsigned pi = wave_scan_incl(x); return (unsigned)__builtin_amdgcn_readlane((int)pi, 63) - pi; }
__device__ __forceinline__ unsigned lane_get(unsigned x, int l) { return (unsigned)__builtin_amdgcn_readlane((int)x, l); }
__device__ __forceinline__ float sigmoidf_(float x) { return __builtin_amdgcn_rcpf(1.0f + __expf(-x)); }
__device__ __forceinline__ float siluf_(float x) { return x * __builtin_amdgcn_rcpf(1.0f + __expf(-x)); }
#define LDS_WAIT() asm volatile("s_waitcnt lgkmcnt(0)" ::: "memory")
#define VM_WAIT() asm volatile("s_waitcnt vmcnt(0)" ::: "memory")

#define XB_TMO      128
#define XB_XCNT(j)  (256  + 64 * (j))
#define XB_XSUB(j)  (1280 + 64 * (j))
#define XB_XGEN(j)  (2304 + 64 * (j))
#define XB_TOP      3328
#define XB_TOPGEN   3392
#define XCD_BAR_WORDS 3456
#define XB_SPIN_CAP (1u << 22)
__device__ __forceinline__ unsigned xb_ld(unsigned* p)              { return __hip_atomic_load(p, __ATOMIC_RELAXED, __HIP_MEMORY_SCOPE_AGENT); }
__device__ __forceinline__ unsigned xb_add(unsigned* p, unsigned v) { return __hip_atomic_fetch_add(p, v, __ATOMIC_RELAXED, __HIP_MEMORY_SCOPE_AGENT); }
__device__ __forceinline__ unsigned xb_xcc_id() { return (unsigned)__builtin_amdgcn_s_getreg((3 << 11) | 20) & 0xFu; }
#define XB_SPIN(cond, bar) do { unsigned _sp = 0; while (cond) { __builtin_amdgcn_s_sleep(1); \
    if ((++_sp & 255u) == 0u) { if (xb_ld(&(bar)[XB_TMO])) break; if (_sp > XB_SPIN_CAP) { atomicAdd(&(bar)[XB_TMO], 1u); break; } } } } while (0)
struct XcdBarrier { unsigned* bar; unsigned x; volatile LAS unsigned* st; };
__device__ __forceinline__ XcdBarrier xcd_barrier_post(unsigned* bar, volatile LAS unsigned* st) {
    XcdBarrier b; b.bar = bar; b.x = xb_xcc_id(); b.st = st;
    if (threadIdx.x == 0) (void)xb_add(&bar[XB_XCNT(b.x)], 1u);
    return b;
}
__device__ __forceinline__ void xcd_barrier_complete(unsigned* bar, unsigned x, unsigned& nloc, unsigned& nx) {
    const unsigned G = gridDim.x * gridDim.y * gridDim.z;
    unsigned sum, cnt, mine, sp = 0u;
    for (;;) {
        sum = 0u; cnt = 0u; mine = 0u;
#pragma unroll
        for (unsigned j = 0; j < 16; ++j) { const unsigned c = xb_ld(&bar[XB_XCNT(j)]); sum += c; cnt += (c > 0u) ? 1u : 0u; mine = (j == x) ? c : mine; }
        if (sum == G) break;
        __builtin_amdgcn_s_sleep(1);
        if ((++sp & 255u) == 0u) { if (xb_ld(&bar[XB_TMO])) break; if (sp > XB_SPIN_CAP) { atomicAdd(&bar[XB_TMO], 1u); break; } }
    }
    nloc = mine > 0u ? mine : 1u; nx = cnt > 0u ? cnt : 1u;
}
__device__ __forceinline__ void xcd_barrier(const XcdBarrier& b) {
    asm volatile("s_waitcnt vmcnt(0)" ::: "memory");
    __syncthreads();
    if (threadIdx.x == 0) {
        unsigned* bar = b.bar;
        __builtin_amdgcn_s_waitcnt(0);
        unsigned nloc = b.st[0], nx = b.st[1];
        if (nloc == 0u) { xcd_barrier_complete(bar, b.x, nloc, nx); b.st[0] = nloc; b.st[1] = nx; }
        const unsigned old = xb_add(&bar[XB_XSUB(b.x)], 1u);
        const unsigned gen = old / nloc;
        if (old + 1u == (gen + 1u) * nloc) {
            __builtin_amdgcn_fence(__ATOMIC_RELEASE, "agent");
            asm volatile("s_waitcnt vmcnt(0)" ::: "memory");
            const unsigned og = xb_add(&bar[XB_TOP], 1u);
            const unsigned tg = og / nx;
            if (og + 1u == (tg + 1u) * nx) xb_add(&bar[XB_TOPGEN], 1u);
            else XB_SPIN(xb_ld(&bar[XB_TOPGEN]) == tg, bar);
            __builtin_amdgcn_fence(__ATOMIC_ACQUIRE, "agent");
            asm volatile("s_waitcnt vmcnt(0)" ::: "memory");
        } else {
            XB_SPIN(xb_ld(&bar[XB_TOPGEN]) == gen, bar);
            __builtin_amdgcn_fence(__ATOMIC_ACQUIRE, "agent");
            asm volatile("s_waitcnt vmcnt(0)" ::: "memory");
        }
    }
    __syncthreads();
}

struct Args {
    const float *x, *norm_w, *w_in, *lb_table, *gnorm_a, *q_norm_w, *kv_norm_w, *w_uq, *w_qidx, *w_ukv, *kidx_norm_w, *kidx_norm_b, *w_pa, *w_pb, *w_out, *rel_bias, *final_norm_w;
    float* out; unsigned char* ws; int ph_lo, ph_hi;
};
constexpr int LDS_BYTES = 155648;
constexpr int MISC_OFF = 154624;
struct Ctx { LAS unsigned char* lds; int tid, lane, wave, wg, G; };

struct P0Item { const float* src; bf16* dst; int N, ldk, sc; };
__device__ __forceinline__ P0Item p0_decode(const Args& a, unsigned char* ws, int it, int lane) {
    constexpr int I_IN = (D_ / 64) * (NIN / 32), I_QI = (QR / 64) * (2048 / 32), I_PA = (AW / 64) * (D_ / 32), I_OUT = (D_ / 64) * (D_ / 32);
    const int c4 = lane & 7; P0Item d; int r = it;
    if (r < I_IN) { const int kb = r / (NIN / 32), nb = r % (NIN / 32), np = 32 * nb + 4 * c4;
        d.src = a.w_in + (size_t)(64 * kb) * IN_W; d.N = IN_W; d.sc = np < 5008 ? np : (np < 5120 ? -1 : np - 112); d.dst = (bf16*)(ws + WS_WIN) + (size_t)(32 * nb) * D_ + 64 * kb; d.ldk = D_; return d; } r -= I_IN;
    if (r < I_QI) { const int kb = r / 64, nb = r % 64; d.src = a.w_qidx + (size_t)(64 * kb) * 2048; d.N = 2048; d.sc = 32 * nb + 4 * c4; d.dst = (bf16*)(ws + WS_WQ) + (size_t)(2048 + 32 * nb) * QR + 64 * kb; d.ldk = QR; return d; } r -= I_QI;
    if (r < 2 * I_PA) { const bool pb = r >= I_PA; if (pb) r -= I_PA; const int kb = r / 64, nb = r % 64;
        d.src = (pb ? a.w_pb : a.w_pa) + (size_t)(64 * kb) * D_; d.N = D_; d.sc = 32 * nb + 4 * c4; d.dst = (bf16*)(ws + (pb ? WS_WPB : WS_WPA)) + (size_t)(32 * nb) * AW + 64 * kb; d.ldk = AW; return d; } r -= 2 * I_PA;
    if (r < I_OUT) { const int kb = r / 64, nb = r % 64; d.src = a.w_out + (size_t)(64 * kb) * D_; d.N = D_; d.sc = 32 * nb + 4 * c4; d.dst = (bf16*)(ws + WS_WOUT) + (size_t)(32 * nb) * D_ + 64 * kb; d.ldk = D_; return d; } r -= I_OUT;
    {
        const int kb = r / 32, nb = r % 32, k0 = 64 * kb, hh = k0 >> 8, c0 = k0 & 255, np = 32 * nb + 4 * c4, h = np >> 7, dd = np & 127;
        d.src = a.w_ukv + (size_t)c0 * 2048; d.N = 2048; d.sc = (hh == (h & 1)) ? h * 256 + 128 + dd : -1; d.dst = (bf16*)(ws + WS_WUV) + (size_t)(32 * nb) * 512 + k0; d.ldk = 512; return d; }
}
__device__ __forceinline__ void p0_item_load(const P0Item& d, int lane, f32x4 (&v)[8]) {
    const int kr = lane >> 3;
#pragma unroll
    for (int i = 0; i < 8; ++i) v[i] = d.sc >= 0 ? *(const f32x4*)(d.src + (size_t)(kr + 8 * i) * d.N + d.sc) : (f32x4){0.f, 0.f, 0.f, 0.f};
}
__device__ __forceinline__ void p0_item_put(const P0Item& d, int lane, const f32x4 (&v)[8], LAS float* scr) {
    const int c4 = lane & 7, kr = lane >> 3;
#pragma unroll
    for (int i = 0; i < 8; ++i) { LAS float* p = scr + (kr + 8 * i) * 33 + 4 * c4; p[0] = v[i].x; p[1] = v[i].y; p[2] = v[i].z; p[3] = v[i].w; }
    LDS_WAIT(); asm volatile("" ::: "memory");
    const int c = lane & 7;
#pragma unroll
    for (int j = 0; j < 4; ++j) { const int n = (lane >> 3) + 8 * j; const LAS float* sp = scr + (8 * c) * 33 + n;
        u32x4 o; o.x = pk2(sp[0 * 33], sp[1 * 33]); o.y = pk2(sp[2 * 33], sp[3 * 33]); o.z = pk2(sp[4 * 33], sp[5 * 33]); o.w = pk2(sp[6 * 33], sp[7 * 33]);
        *(u32x4*)(d.dst + (size_t)n * d.ldk + 8 * c) = o; }
    LDS_WAIT(); asm volatile("" ::: "memory");
}
__device__ __forceinline__ void p0_prep(const Ctx& C, const Args& a) {
    unsigned char* ws = a.ws;
    LAS float* scr = (LAS float*)(C.lds + C.wave * 16384);
    const int gw = C.wg * NWAVES + C.wave, NGW = C.G * NWAVES;
    constexpr int NITEMS = (D_ / 64) * (NIN / 32) + (QR / 64) * (2048 / 32) + 2 * (AW / 64) * (D_ / 32) + (D_ / 64) * (D_ / 32) + (512 / 64) * (1024 / 32);
    {
        f32x4 va[8], vb[8]; int it = gw;
        P0Item da, db;
        if (it < NITEMS) { da = p0_decode(a, ws, it, C.lane); p0_item_load(da, C.lane, va); }
        while (it < NITEMS) {
            const int i1 = it + NGW; if (i1 < NITEMS) { db = p0_decode(a, ws, i1, C.lane); p0_item_load(db, C.lane, vb); }
            p0_item_put(da, C.lane, va, scr);
            if (i1 >= NITEMS) break;
            const int i2 = i1 + NGW; if (i2 < NITEMS) { da = p0_decode(a, ws, i2, C.lane); p0_item_load(da, C.lane, va); }
            p0_item_put(db, C.lane, vb, scr);
            it = i2;
        }
    }
    for (int m = gw; m < S_; m += NGW) {
        const f32x4* xr = (const f32x4*)(a.x + (size_t)m * D_) + C.lane; const f32x4* wr = (const f32x4*)a.norm_w + C.lane;
        f32x4 v[8]; float s = 0.f;
#pragma unroll
        for (int j = 0; j < 8; ++j) { v[j] = xr[64 * j]; s += (v[j].x * v[j].x + v[j].y * v[j].y) + (v[j].z * v[j].z + v[j].w * v[j].w); }
        const float rs = rsqrtf(wave_sum(s) * (1.f / D_) + EPS);
        u32x2* o8 = (u32x2*)((bf16*)(ws + WS_H) + (size_t)m * D_) + C.lane;
#pragma unroll
        for (int j = 0; j < 8; ++j) { const f32x4 w = wr[64 * j]; u32x2 o; o.x = pk2(v[j].x * rs * w.x, v[j].y * rs * w.y); o.y = pk2(v[j].z * rs * w.z, v[j].w * rs * w.w); o8[64 * j] = o; }
    }
    { const int g = C.wg * NTHR + C.tid; if (g < AW) { const float l0 = a.lb_table[g], l1 = a.lb_table[AW + g], mx = fmaxf(l0, l1), e0 = __expf(l0 - mx), e1 = __expf(l1 - mx); ((float*)(ws + WS_LB))[g] = e0 / (e0 + e1); } }
    __syncthreads();
    {
        LAS float* As = (LAS float*)C.lds;
        LAS float* Bs = As + 64 * 129;
        bf16* WqT = (bf16*)(ws + WS_WQ);
        for (int it = C.wg; it < 256; it += C.G) {
            const int h = it >> 5, cb = (it >> 3) & 3, rb = it & 7, c0 = cb * 64, r0 = rb * 64;
            { const int rr = C.tid >> 3, seg = C.tid & 7;
#pragma unroll
              for (int j = 0; j < 4; ++j) { const f32x4 va = *(const f32x4*)(a.w_uq + (size_t)(r0 + rr) * 1024 + h * 128 + seg * 16 + 4 * j); const f32x4 vb = *(const f32x4*)(a.w_ukv + (size_t)(c0 + rr) * 2048 + h * 256 + seg * 16 + 4 * j);
                  LAS float* pa = As + rr * 129 + seg * 16 + 4 * j; pa[0] = va.x; pa[1] = va.y; pa[2] = va.z; pa[3] = va.w;
                  LAS float* pb = Bs + rr * 129 + seg * 16 + 4 * j; pb[0] = vb.x; pb[1] = vb.y; pb[2] = vb.z; pb[3] = vb.w; } }
            __syncthreads();
            { const int r = C.tid & 63, cg = C.tid >> 6; float o[8];
#pragma unroll
              for (int i = 0; i < 8; ++i) o[i] = 0.f;
              for (int d = 0; d < 128; ++d) { const float av = As[r * 129 + d];
#pragma unroll
                  for (int i = 0; i < 8; ++i) o[i] += av * Bs[(cg * 8 + i) * 129 + d]; }
#pragma unroll
              for (int i = 0; i < 8; ++i) WqT[(size_t)(h * 256 + c0 + cg * 8 + i) * QR + r0 + r] = (bf16)f2bf(o[i] * 0.08838834764831845f); }
            __syncthreads();
        }
    }
}

struct SchedPlain {
    pg8::TileOrder T; const char* Ab; const char* Bb; size_t tA, tB;
    __device__ __forceinline__ bool next(int i, pg8::Unit& u) const { u.sub = 0; return T.tile(i, u.pm, u.pn); }
    __device__ __forceinline__ const char* A(const pg8::Unit& u) const { return Ab + (size_t)u.pm * tA; }
    __device__ __forceinline__ const char* B(const pg8::Unit& u) const { return Bb + (size_t)u.pn * tB; }
    __device__ __forceinline__ bool keep(const pg8::Unit&) const { return false; }
};
#define EPI_FOREACH(...) \
    _Pragma("unroll") for (int ai = 0; ai < 2; ++ai) _Pragma("unroll") for (int m = 0; m < 4; ++m) { const int row = u.pm * 256 + ai * 128 + wr * 64 + m * 16 + fr; \
    _Pragma("unroll") for (int bj = 0; bj < 2; ++bj) { const int col = u.pn * 256 + bj * 128 + wc * 32 + 8 * fq; f32x4& v0 = acc[ai][bj][m][0]; f32x4& v1 = acc[ai][bj][m][1]; __VA_ARGS__ } }

struct EpiProj {
    unsigned char* ws;
    __device__ __forceinline__ void operator()(f32x4 (&acc)[2][2][4][2], const pg8::Unit& u, int wr, int wc, int fr, int fq) const {
        const int pn = u.pn;
        if (pn < 4) {
            bf16* O = (bf16*)(ws + WS_QA);
            EPI_FOREACH({ u32x4 w; const float s = 0.08838834764831845f; w.x = pk2(siluf_(v0[0]) * s, siluf_(v0[1]) * s); w.y = pk2(siluf_(v0[2]) * s, siluf_(v0[3]) * s); w.z = pk2(siluf_(v1[0]) * s, siluf_(v1[1]) * s); w.w = pk2(siluf_(v1[2]) * s, siluf_(v1[3]) * s);
                *(u32x4*)(O + (size_t)row * AW + col) = w; })
        } else if (pn < 8) {
            float* O = (float*)(ws + WS_G); const float* lb = (const float*)(ws + WS_LB);
            EPI_FOREACH({ const int c = col - 1024; const f32x4 l0 = *(const f32x4*)(lb + c), l1 = *(const f32x4*)(lb + c + 4); f32x4 o0, o1;
                _Pragma("unroll") for (int j = 0; j < 4; ++j) { o0[j] = __logf(l0[j] + (1.f - l0[j]) * sigmoidf_(v0[j])); o1[j] = __logf(l1[j] + (1.f - l1[j]) * sigmoidf_(v1[j])); }
                *(f32x4*)(O + (size_t)row * AW + c) = o0; *(f32x4*)(O + (size_t)row * AW + c + 4) = o1; })
        } else if (pn < 12) {
            bf16* O = (bf16*)(ws + WS_VA);
            EPI_FOREACH({ u32x4 w; w.x = pk2(v0[0], v0[1]); w.y = pk2(v0[2], v0[3]); w.z = pk2(v1[0], v1[1]); w.w = pk2(v1[2], v1[3]); *(u32x4*)(O + (size_t)row * AW + col - 2048) = w; })
        } else if (pn < 16 || (pn >= 20 && pn < 24)) {
            bf16* O = (bf16*)(ws + (pn < 16 ? WS_GA : WS_GB)); const int cb = pn < 16 ? 3072 : 5120;
            EPI_FOREACH({ u32x4 w; w.x = pk2(siluf_(v0[0]), siluf_(v0[1])); w.y = pk2(siluf_(v0[2]), siluf_(v0[3])); w.z = pk2(siluf_(v1[0]), siluf_(v1[1])); w.w = pk2(siluf_(v1[2]), siluf_(v1[3]));
                *(u32x4*)(O + (size_t)row * AW + col - cb) = w; })
        } else if (pn < 20) {
            float* O = (float*)(ws + WS_RAW);
            EPI_FOREACH({ *(f32x4*)(O + (size_t)row * 1024 + col - 4096) = v0; *(f32x4*)(O + (size_t)row * 1024 + col - 4096 + 4) = v1; })
        } else {
            bf16* O = (bf16*)(ws + (pn < 32 ? WS_SA : WS_SB)); const int cb = pn < 32 ? 6144 : 8192;
            EPI_FOREACH({ u32x4 w; w.x = pk2(sigmoidf_(v0[0]), sigmoidf_(v0[1])); w.y = pk2(sigmoidf_(v0[2]), sigmoidf_(v0[3])); w.z = pk2(sigmoidf_(v1[0]), sigmoidf_(v1[1])); w.w = pk2(sigmoidf_(v1[2]), sigmoidf_(v1[3]));
                *(u32x4*)(O + (size_t)row * D_ + col - cb) = w; })
        }
    }
};

__device__ __forceinline__ void p2_norms(const Ctx& C, const Args& a) {
    unsigned char* ws = a.ws;
    const int gw = C.wg * NWAVES + C.wave, NGW = C.G * NWAVES, lane = C.lane;
    const float* RAW = (const float*)(ws + WS_RAW);
    for (int t = gw; t < S_; t += NGW) {
        const float* r = RAW + (size_t)t * 1024;
        { const f32x4 v0 = *(const f32x4*)(r + 4 * lane), v1 = *(const f32x4*)(r + 256 + 4 * lane);
          const float ss = wave_sum((v0.x * v0.x + v0.y * v0.y) + (v0.z * v0.z + v0.w * v0.w) + (v1.x * v1.x + v1.y * v1.y) + (v1.z * v1.z + v1.w * v1.w));
          const float rs = rsqrtf(ss * (1.f / QR) + EPS);
          const f32x4 w0 = *(const f32x4*)(a.q_norm_w + 4 * lane), w1 = *(const f32x4*)(a.q_norm_w + 256 + 4 * lane);
          bf16* o = (bf16*)(ws + WS_CQN) + (size_t)t * QR;
          u32x2 p0, p1; p0.x = pk2(v0.x * rs * w0.x, v0.y * rs * w0.y); p0.y = pk2(v0.z * rs * w0.z, v0.w * rs * w0.w); p1.x = pk2(v1.x * rs * w1.x, v1.y * rs * w1.y); p1.y = pk2(v1.z * rs * w1.z, v1.w * rs * w1.w);
          *(u32x2*)(o + 4 * lane) = p0; *(u32x2*)(o + 256 + 4 * lane) = p1; }
        { const f32x4 v0 = *(const f32x4*)(r + 512 + 4 * lane);
          const float ss = wave_sum((v0.x * v0.x + v0.y * v0.y) + (v0.z * v0.z + v0.w * v0.w));
          const float rs = rsqrtf(ss * (1.f / KVR) + EPS);
          const f32x4 w0 = *(const f32x4*)(a.kv_norm_w + 4 * lane);
          u32x2 p0; p0.x = pk2(v0.x * rs * w0.x, v0.y * rs * w0.y); p0.y = pk2(v0.z * rs * w0.z, v0.w * rs * w0.w);
          *(u32x2*)((bf16*)(ws + WS_CKVN) + (size_t)t * KVR + 4 * lane) = p0; }
        { const f32x2 v = *(const f32x2*)(r + 768 + 2 * lane);
          const float mu = wave_sum(v.x + v.y) * (1.f / IDXD); const float d0 = v.x - mu, d1 = v.y - mu;
          const float var = wave_sum(d0 * d0 + d1 * d1) * (1.f / IDXD); const float rs = rsqrtf(var + EPS);
          const f32x2 w = *(const f32x2*)(a.kidx_norm_w + 2 * lane), b = *(const f32x2*)(a.kidx_norm_b + 2 * lane);
          *(unsigned*)((bf16*)(ws + WS_KIDX) + (size_t)t * IDXD + 2 * lane) = pk2(d0 * rs * w.x + b.x, d1 * rs * w.y + b.y); }
        if (lane < IDXH) ((float*)(ws + WS_WIDX))[(size_t)t * IDXH + lane] = r[896 + lane] * 0.02209708691207961f;
    }
}
constexpr int R64 = 144, R128 = 272;
__device__ __forceinline__ void p2_hgrn_states(const Ctx& C, const Args& a, float* UT) {
    unsigned char* ws = a.ws;
    const float* G = (const float*)(ws + WS_G); const bf16* VA = (const bf16*)(ws + WS_VA); float* DL = (float*)(ws + WS_DLAST);
    LAS unsigned char* kdT = C.lds;
    LAS unsigned char* vT = C.lds + 128 * R64;
    LAS float* segtot = (LAS float*)(C.lds + 2 * 128 * R64);
    const int tid = C.tid, lane = C.lane, w = C.wave;
    for (int it = C.wg; it < NCH * BH; it += C.G) {
        const int c = it >> 3, h = it & 7;
        const int k = tid & 127, seg = tid >> 7, t0 = c * CHUNK + seg * 16;
        float g[16], cum[16]; float run = 0.f;
#pragma unroll
        for (int i = 0; i < 16; ++i) { g[i] = G[(size_t)(t0 + i) * AW + h * 128 + k]; run += g[i]; cum[i] = run; }
        segtot[seg * 128 + k] = run;
        unsigned short vv[16];
#pragma unroll
        for (int i = 0; i < 16; ++i) vv[i] = VA[(size_t)(t0 + i) * AW + h * 128 + k];
        __syncthreads();
        float pre = 0.f, last = 0.f;
#pragma unroll
        for (int s2 = 0; s2 < 4; ++s2) { const float st = segtot[s2 * 128 + k]; if (s2 < seg) pre += st; last += st; }
        unsigned kd[8], vp[8];
#pragma unroll
        for (int i = 0; i < 8; ++i) {
            const float c0 = cum[2 * i] + pre, c1 = cum[2 * i + 1] + pre;
            const float k0 = -expm1f(g[2 * i]) * __expf(last - c0), k1 = -expm1f(g[2 * i + 1]) * __expf(last - c1);
            kd[i] = pk2(k0, k1); vp[i] = (unsigned)vv[2 * i] | ((unsigned)vv[2 * i + 1] << 16);
        }
        *(LAS u32x4*)(kdT + k * R64 + seg * 32) = (u32x4){kd[0], kd[1], kd[2], kd[3]}; *(LAS u32x4*)(kdT + k * R64 + seg * 32 + 16) = (u32x4){kd[4], kd[5], kd[6], kd[7]};
        *(LAS u32x4*)(vT + k * R64 + seg * 32) = (u32x4){vp[0], vp[1], vp[2], vp[3]}; *(LAS u32x4*)(vT + k * R64 + seg * 32 + 16) = (u32x4){vp[4], vp[5], vp[6], vp[7]};
        if (seg == 0) DL[(size_t)it * 128 + k] = __expf(last);
        __syncthreads();
        f32x4 acc[2][4];
#pragma unroll
        for (int mi = 0; mi < 2; ++mi)
#pragma unroll
            for (int ni = 0; ni < 4; ++ni) acc[mi][ni] = (f32x4){0.f, 0.f, 0.f, 0.f};
        const int fr = lane & 15, fq = lane >> 4;
#pragma unroll
        for (int ks = 0; ks < 2; ++ks) {
            bf16x8 af[2], bfr[4];
#pragma unroll
            for (int mi = 0; mi < 2; ++mi) af[mi] = *(const LAS bf16x8*)(vT + (32 * (w >> 1) + 16 * mi + fr) * R64 + (32 * ks + 8 * fq) * 2);
#pragma unroll
            for (int ni = 0; ni < 4; ++ni) bfr[ni] = *(const LAS bf16x8*)(kdT + (64 * (w & 1) + 16 * ni + fr) * R64 + (32 * ks + 8 * fq) * 2);
#pragma unroll
            for (int mi = 0; mi < 2; ++mi)
#pragma unroll
                for (int ni = 0; ni < 4; ++ni) acc[mi][ni] = __builtin_amdgcn_mfma_f32_16x16x32_bf16(af[mi], bfr[ni], acc[mi][ni], 0, 0, 0);
        }
        float* U = UT + (size_t)it * 16384;
#pragma unroll
        for (int mi = 0; mi < 2; ++mi)
#pragma unroll
            for (int ni = 0; ni < 4; ++ni)
#pragma unroll
                for (int r = 0; r < 4; ++r) U[(32 * (w >> 1) + 16 * mi + 4 * fq + r) * 128 + 64 * (w & 1) + 16 * ni + fr] = acc[mi][ni][r];
        __syncthreads();
    }
}

struct EpiQ {
    unsigned char* ws;
    __device__ __forceinline__ void operator()(f32x4 (&acc)[2][2][4][2], const pg8::Unit& u, int wr, int wc, int fr, int fq) const {
        bf16* O = (bf16*)(ws + (u.pn < 8 ? WS_QABS : WS_RAW)); const int cb = u.pn < 8 ? 0 : 2048;
        EPI_FOREACH({ u32x4 w; w.x = pk2(v0[0], v0[1]); w.y = pk2(v0[2], v0[3]); w.z = pk2(v1[0], v1[1]); w.w = pk2(v1[2], v1[3]); *(u32x4*)(O + (size_t)row * 2048 + col - cb) = w; })
    }
};
__device__ __forceinline__ void p3_scan(const Ctx& C, const Args& a, const float* UT) {
    unsigned char* ws = a.ws;
    const float* DL = (const float*)(ws + WS_DLAST); bf16* SPT = (bf16*)(ws + WS_SPT);
    for (int e = C.wg * NTHR + C.tid; e < BH * 128 * 128; e += C.G * NTHR) {
        const int h = e >> 14, k = e & 127;
        float Sv = 0.f;
        for (int c0 = 0; c0 < NCH; c0 += 16) {
            float u[16], d[16];
#pragma unroll
            for (int j = 0; j < 16; ++j) { u[j] = UT[(size_t)(c0 + j) * (BH * 16384) + e]; d[j] = DL[(size_t)((c0 + j) * BH + h) * 128 + k]; }
#pragma unroll
            for (int j = 0; j < 16; ++j) { SPT[(size_t)(c0 + j) * (BH * 16384) + e] = (bf16)f2bf(Sv); Sv = d[j] * Sv + u[j]; }
        }
    }
}

__device__ __forceinline__ int t5_bucket(int rel) {
    const int n = rel < 0 ? -rel : rel; int b = rel > 0 ? 16 : 0;
    const int large = n < 12 ? 8 : n < 16 ? 9 : n < 23 ? 10 : n < 32 ? 11 : n < 46 ? 12 : n < 64 ? 13 : n < 91 ? 14 : 15;
    return b + (n < 8 ? n : large);
}
__device__ __forceinline__ int swz_sigma(int r) { return ((r & 3) << 1) | ((((r >> 3) ^ (r >> 2)) & 1) << 3) | ((r >> 2) & 1); }
__device__ __forceinline__ int lat_off(int row, int c) { return row * 512 + ((((c & 15) ^ swz_sigma(row & 15)) | (c & 16)) << 4); }
constexpr int AT_SIDX = 131072, AT_BIAS = 139264;
__device__ __forceinline__ void attn_setup(const Ctx& C, const Args& a) {
    LAS float* bias2 = (LAS float*)(C.lds + AT_BIAS);
    for (int e = C.tid; e < 2 * 92 * 8; e += NTHR) { const int sg = e / (92 * 8), nn = (e / 8) % 92, h = e & 7; bias2[e] = a.rel_bias[t5_bucket(sg ? nn : -nn) * BH + h]; }
    __syncthreads();
}
__device__ __forceinline__ void attn_one(const Ctx& C, const Args& a, const int t, const int n) {
    unsigned char* ws = a.ws;
    const bf16* QABS = (const bf16*)(ws + WS_QABS); const char* CKVNb = (const char*)(ws + WS_CKVN);
    bf16* OL = (bf16*)(ws + WS_RAW);
    int lane = C.lane; asm volatile("" : "+v"(lane));
    const int w = C.wave, fr = lane & 15, fq = lane >> 4;
    LAS unsigned char* L = C.lds + w * 16384;
    const LAS int* sidx = (const LAS int*)(C.lds + AT_SIDX) + w * 256;
    const LAS float* bias2 = (const LAS float*)(C.lds + AT_BIAS);
    const int q4 = fr >> 2, p4 = fr & 3;
    unsigned aqk[4], apv[8];
    { const int s = swz_sigma(fr); const unsigned b0 = (unsigned)(fr * 512 + 16 * (fq ^ (s & 3))) | (unsigned)(64 * (s >> 2));
#pragma unroll
      for (int k = 0; k < 4; ++k) aqk[k] = (unsigned)(size_t)L + (b0 ^ (unsigned)(64 * k)); }
    { const int rr = 4 * fq + q4, s = swz_sigma(rr & 15); const unsigned b0 = (unsigned)(rr * 512 + 16 * ((p4 >> 1) ^ (s & 1)) + 8 * (p4 & 1)) | (unsigned)(32 * (s >> 1));
#pragma unroll
      for (int k = 0; k < 8; ++k) apv[k] = (unsigned)(size_t)L + (b0 ^ (unsigned)(32 * k)); }
    unsigned c16[16];
#pragma unroll
    for (int i = 0; i < 16; ++i) { const int row = 2 * i + (lane >> 5), pos = lane & 31; c16[i] = (unsigned)(((pos & 16) | ((pos & 15) ^ swz_sigma(row & 15))) << 4); }
    {
        bf16x8 qf[8];
#pragma unroll
        for (int ks = 0; ks < 8; ++ks) { if (fr < BH) qf[ks] = *(const bf16x8*)(QABS + (size_t)t * 2048 + fr * 256 + 32 * ks + 8 * fq); else qf[ks] = (bf16x8){0, 0, 0, 0, 0, 0, 0, 0}; }
        f32x4 oa[16];
#pragma unroll
        for (int i = 0; i < 16; ++i) oa[i] = (f32x4){0.f, 0.f, 0.f, 0.f};
        float m_run = -INFINITY, l_run = 0.f;
        LDS_WAIT();
        for (int ch = 0; ch * 32 < n; ++ch) {
            int sjv[16];
#pragma unroll
            for (int i = 0; i < 16; ++i) sjv[i] = sidx[32 * ch + 2 * i + (lane >> 5)];
#pragma unroll
            for (int i = 0; i < 16; ++i)
                __builtin_amdgcn_global_load_lds((const unsigned*)(CKVNb + (unsigned)(sjv[i] * 512 + (int)c16[i])), (LAS unsigned*)(L + i * 1024), 16, 0, 0);
            const u32x4 s0 = *(const LAS u32x4*)(sidx + 32 * ch + 4 * fq), s1 = *(const LAS u32x4*)(sidx + 32 * ch + 16 + 4 * fq);
            float bv[2][4];
#pragma unroll
            for (int T = 0; T < 2; ++T)
#pragma unroll
                for (int r = 0; r < 4; ++r) { const int rel = (int)(T ? s1[r] : s0[r]) - t; const int nn = rel < 0 ? -rel : rel; bv[T][r] = bias2[((rel > 0 ? 92 : 0) + (nn < 91 ? nn : 91)) * 8 + (fr & 7)]; }
            VM_WAIT();
            f32x4 lg[2] = {{0.f, 0.f, 0.f, 0.f}, {0.f, 0.f, 0.f, 0.f}};
            {
                u32x4 kf[8][2];
#define AT_KRD(ks) do { _Pragma("unroll") for (int T = 0; T < 2; ++T) asm volatile("ds_read_b128 %0, %1 offset:%2" : "=v"(kf[ks][T]) : "v"(aqk[(ks) & 3]), "n"(256 * ((ks) >> 2) + 8192 * T)); } while (0)
                AT_KRD(0); AT_KRD(1); AT_KRD(2); AT_KRD(3); AT_KRD(4); AT_KRD(5);
                asm volatile("s_waitcnt lgkmcnt(4)" : "+v"(kf[0][0]), "+v"(kf[0][1]), "+v"(kf[1][0]), "+v"(kf[1][1]), "+v"(kf[2][0]), "+v"(kf[2][1]), "+v"(kf[3][0]), "+v"(kf[3][1]));
                AT_KRD(6); AT_KRD(7);
#undef AT_KRD
#pragma unroll
                for (int ks = 0; ks < 4; ++ks)
#pragma unroll
                    for (int T = 0; T < 2; ++T) lg[T] = __builtin_amdgcn_mfma_f32_16x16x32_bf16(__builtin_bit_cast(bf16x8, kf[ks][T]), qf[ks], lg[T], 0, 0, 0);
                asm volatile("s_waitcnt lgkmcnt(0)" : "+v"(kf[4][0]), "+v"(kf[4][1]), "+v"(kf[5][0]), "+v"(kf[5][1]), "+v"(kf[6][0]), "+v"(kf[6][1]), "+v"(kf[7][0]), "+v"(kf[7][1]));
#pragma unroll
                for (int ks = 4; ks < 8; ++ks)
#pragma unroll
                    for (int T = 0; T < 2; ++T) lg[T] = __builtin_amdgcn_mfma_f32_16x16x32_bf16(__builtin_bit_cast(bf16x8, kf[ks][T]), qf[ks], lg[T], 0, 0, 0);
            }
            float mx = -INFINITY;
#pragma unroll
            for (int T = 0; T < 2; ++T)
#pragma unroll
                for (int r = 0; r < 4; ++r) { const int j = 32 * ch + 16 * T + 4 * fq + r; float v = lg[T][r] + bv[T][r];
                    v = (j < n) ? v : -INFINITY; lg[T][r] = v; mx = fmaxf(mx, v); }
            mx = rows_max(mx);
            const float m_new = fmaxf(m_run, mx), scale = __expf(m_run - m_new);
            float sm = 0.f;
#pragma unroll
            for (int T = 0; T < 2; ++T)
#pragma unroll
                for (int r = 0; r < 4; ++r) { const float p = __expf(lg[T][r] - m_new); lg[T][r] = p; sm += p; }
            l_run = l_run * scale + sm; m_run = m_new;
            bf16x8 pf; { const unsigned w0 = pk2(lg[0][0], lg[0][1]), w1 = pk2(lg[0][2], lg[0][3]), w2 = pk2(lg[1][0], lg[1][1]), w3 = pk2(lg[1][2], lg[1][3]);
                pf = __builtin_bit_cast(bf16x8, (u32x4){w0, w1, w2, w3}); }
            if (__any(scale != 1.f)) {
#pragma unroll
                for (int ct = 0; ct < 16; ++ct) oa[ct] *= scale; }
            {
                u32x2 lo[16], hi[16];
#define AT_VRD(ct) do { asm volatile("ds_read_b64_tr_b16 %0, %1 offset:%2" : "=v"(lo[ct]) : "v"(apv[(ct) & 7]), "n"(256 * ((ct) >> 3))); \
                        asm volatile("ds_read_b64_tr_b16 %0, %1 offset:%2" : "=v"(hi[ct]) : "v"(apv[(ct) & 7]), "n"(256 * ((ct) >> 3) + 8192)); } while (0)
#define AT_VWAIT(g, cnt) asm volatile("s_waitcnt lgkmcnt(" #cnt ")" : "+v"(lo[4 * (g)]), "+v"(hi[4 * (g)]), "+v"(lo[4 * (g) + 1]), "+v"(hi[4 * (g) + 1]), "+v"(lo[4 * (g) + 2]), "+v"(hi[4 * (g) + 2]), "+v"(lo[4 * (g) + 3]), "+v"(hi[4 * (g) + 3]))
#define AT_VMMA(g) do { _Pragma("unroll") for (int c4 = 4 * (g); c4 < 4 * (g) + 4; ++c4) { const u32x4 cw = {lo[c4].x, lo[c4].y, hi[c4].x, hi[c4].y}; \
                        oa[c4] = __builtin_amdgcn_mfma_f32_16x16x32_bf16(__builtin_bit_cast(bf16x8, cw), pf, oa[c4], 0, 0, 0); } } while (0)
                AT_VRD(0); AT_VRD(1); AT_VRD(2); AT_VRD(3); AT_VRD(4); AT_VRD(5);
                AT_VWAIT(0, 4); AT_VRD(6); AT_VRD(7); AT_VRD(8); AT_VRD(9); AT_VMMA(0);
                AT_VWAIT(1, 4); AT_VRD(10); AT_VRD(11); AT_VRD(12); AT_VRD(13); AT_VMMA(1);
                AT_VWAIT(2, 4); AT_VRD(14); AT_VRD(15); AT_VMMA(2);
                AT_VWAIT(3, 0); AT_VMMA(3);
#undef AT_VRD
#undef AT_VWAIT
#undef AT_VMMA
            }
            LDS_WAIT();
        }
        l_run = rows_sum(l_run);
        if (fr < BH) { const float inv = __builtin_amdgcn_rcpf(l_run); bf16* o = OL + (size_t)t * 2048 + fr * 256 + 4 * fq;
#pragma unroll
            for (int ct = 0; ct < 16; ++ct) { u32x2 pw; pw.x = pk2(oa[ct][0] * inv, oa[ct][1] * inv); pw.y = pk2(oa[ct][2] * inv, oa[ct][3] * inv); *(u32x2*)(o + 16 * ct) = pw; } }
    }
}

__device__ __forceinline__ unsigned fkey(float f) { const unsigned u = __builtin_bit_cast(unsigned, f); return (u & 0x80000000u) ? ~u : (u | 0x80000000u); }
__device__ __forceinline__ void lds_add_u32(LAS unsigned* p, unsigned v) { asm volatile("ds_add_u32 %0, %1" :: "v"((unsigned)(size_t)p), "v"(v) : "memory"); }
constexpr int IX_KBUF = 65536, IX_CAP = 512;
__device__ __noinline__ void select_slow(const float* sc, int nvis, LAS int* idxrow, LAS unsigned* hist, int lane) {
    unsigned prefix = 0u; int need = TOPK;
#pragma unroll 1
    for (int pass = 0; pass < 4; ++pass) {
        const int shift = 24 - 8 * pass;
#pragma unroll
        for (int j = 0; j < 4; ++j) hist[lane * 4 + j] = 0u;
        LDS_WAIT();
        const unsigned himask = pass == 0 ? 0u : (0xffffffffu << (shift + 8));
        for (int i = lane; i < nvis; i += 64) { const unsigned kk = fkey(sc[i]); if ((kk & himask) == (prefix & himask)) __hip_atomic_fetch_add(&hist[(kk >> shift) & 255u], 1u, __ATOMIC_RELAXED, __HIP_MEMORY_SCOPE_WORKGROUP); }
        LDS_WAIT();
        unsigned cnt[4]; unsigned tl = 0u;
#pragma unroll
        for (int j = 0; j < 4; ++j) { cnt[j] = hist[lane * 4 + j]; tl += cnt[j]; }
        unsigned incl = tl;
#pragma unroll
        for (int o = 1; o < 64; o <<= 1) { const unsigned v = __shfl_down(incl, o); if (lane + o < 64) incl += v; }
        unsigned above = incl - tl;
        int dsel = -1; unsigned asel = 0u;
#pragma unroll
        for (int j = 3; j >= 0; --j) { if (dsel < 0 && above < (unsigned)need && above + cnt[j] >= (unsigned)need) { dsel = lane * 4 + j; asel = above; } above += cnt[j]; }
        const unsigned long long bal = __ballot(dsel >= 0);
        const int src = __ffsll((long long)bal) - 1;
        const int d = __shfl(dsel, src); const unsigned ab = __shfl(asel, src);
        need -= (int)ab; prefix |= ((unsigned)d) << shift;
    }
    int base = 0, eqseen = 0;
    for (int i0 = 0; i0 < nvis; i0 += 64) {
        const int i = i0 + lane; const unsigned kk = fkey(sc[i]);
        const bool gt = kk > prefix, eq = kk == prefix;
        const unsigned long long beq = __ballot(eq);
        const unsigned long long lt_mask = (1ull << lane) - 1ull;
        const int eqrank = eqseen + __popcll(beq & lt_mask);
        const bool sel = gt || (eq && eqrank < need);
        const unsigned long long bs = __ballot(sel);
        if (sel) idxrow[base + __popcll(bs & lt_mask)] = i;
        base += __popcll(bs); eqseen += __popcll(beq);
    }
}
__device__ __forceinline__ void p4_indexer(const Ctx& C, const Args& a, float* SCall, unsigned* qc, volatile LAS unsigned* MISC, int& cur) {
    unsigned char* ws = a.ws;
    const bf16* QIDX = (const bf16*)(ws + WS_RAW); const char* KIDXb = (const char*)(ws + WS_KIDX); const float* WIDX = (const float*)(ws + WS_WIDX);
    LAS int* sidx = (LAS int*)(C.lds + AT_SIDX) + C.wave * 256;
    float* SC = SCall + (size_t)C.wg * (8 * 8192);
    LAS unsigned* HIST = (LAS unsigned*)C.lds;
    LAS unsigned char* KBUF = C.lds + IX_KBUF;
    const int tid = C.tid, w = C.wave, quad = w & 1, kg = w >> 1;
    while (cur < 1024) {
        int lane = C.lane; asm volatile("" : "+v"(lane));
        const int r16 = lane & 15, kq = lane >> 4;
        const int tile = 1023 - cur;
        const int q0 = tile * 8, nvis = ((q0 >> 6) + 1) * CHUNK;
        if (nvis <= TOPK) {
            for (int j = lane; j < TOPK; j += 64) sidx[j] = j < nvis ? j : 0;
            LDS_WAIT(); __syncthreads();
            unsigned nxt = 0u; if (tid == 0) nxt = xb_add(qc, 1u);
            attn_one(C, a, q0 + w, nvis);
            if (tid == 0) MISC[MISC_Q4] = nxt;
            LDS_WAIT(); __syncthreads();
            cur = __builtin_amdgcn_readfirstlane((int)MISC[MISC_Q4]);
            continue;
        }
        for (int i = tid; i < 8 * 2048; i += NTHR) HIST[i] = 0u;
        bf16x8 af[4][4];
#pragma unroll
        for (int j = 0; j < 4; ++j) {
            const bf16* qp = QIDX + (size_t)(q0 + 4 * quad + j) * 2048 + r16 * 128 + 8 * kq;
#pragma unroll
            for (int ks = 0; ks < 4; ++ks) af[j][ks] = *(const bf16x8*)(qp + 32 * ks);
        }
        u32x4 wA[2][2];
        { const int grp = r16 >> 2, mem = r16 & 3;
          const f32x4 wv = mem < 2 ? *(const f32x4*)(WIDX + (size_t)(q0 + 4 * quad + 2 * (grp & 1) + mem) * IDXH + 4 * kq) : (f32x4){0.f, 0.f, 0.f, 0.f};
          const unsigned w01 = pk2(wv[0], wv[1]), w23 = pk2(wv[2], wv[3]);
#pragma unroll
          for (int p = 0; p < 2; ++p)
#pragma unroll
              for (int T = 0; T < 2; ++T) { const bool on = (grp == 2 * T + p) && mem < 2;
                  wA[p][T] = (u32x4){(on && mem == 0) ? w01 : 0u, (on && mem == 0) ? w23 : 0u, (on && mem == 1) ? w01 : 0u, (on && mem == 1) ? w23 : 0u}; } }
        const int ntile = nvis >> 5, nstep = (ntile + 3) >> 2;
        const unsigned soffA = (unsigned)((16 * quad + (lane >> 4)) * 256 + (((lane & 15) ^ (lane >> 4)) << 4));
#define IX_STAGE(step_, buf_) do { const int kt_ = 4 * (step_) + kg; if (kt_ < ntile) { const char* sb_ = KIDXb + (size_t)kt_ * 8192; unsigned so_ = soffA; asm volatile("" : "+v"(so_));   \
            _Pragma("unroll") for (int i_ = 0; i_ < 4; ++i_) { \
            __builtin_amdgcn_global_load_lds((const unsigned*)(sb_ + ((so_ ^ (unsigned)(64 * i_)) + (unsigned)(1024 * i_))), (LAS unsigned*)(KBUF + (buf_) * 32768 + kg * 8192 + (4 * quad + i_) * 1024), 16, 0, 0); } } } while (0)
        const unsigned flane = (unsigned)((4 * quad + 2 * (kq & 1)) * 8192 + 16 * (kq >> 1) + r16);
        LAS unsigned* const hlane = HIST + (4 * quad + 2 * (kq & 1)) * 2048;
#define IX_FLUSH(yv, kt_) do { if ((kt_) < ntile) { _Pragma("unroll") for (int j = 0; j < 2; ++j) { float* scb_ = SC + (size_t)((kt_) * 32 + j * 8192); scb_[flane] = yv[j]; \
            const unsigned bin = fkey(yv[j]) >> 20; lds_add_u32(hlane + j * 2048 + (bin >> 1), 1u << (16 * (bin & 1u))); } } } while (0)
        IX_STAGE(0, 0);
        VM_WAIT(); LDS_WAIT(); __builtin_amdgcn_s_barrier();
        float yp[2] = {0.f, 0.f};
        for (int step = 0; step < nstep; ++step) {
            if (step > 0) IX_FLUSH(yp, 4 * (step - 1) + kg);
            if (step + 1 < nstep) IX_STAGE(step + 1, (step + 1) & 1);
            const unsigned tb = (unsigned)(size_t)(KBUF + (step & 1) * 32768 + kg * 8192) + (unsigned)(r16 * 256 + ((kq ^ r16) << 4));
            bf16x8 bfr[2][4];
#pragma unroll
            for (int T = 0; T < 2; ++T)
#pragma unroll
                for (int ks = 0; ks < 4; ++ks) bfr[T][ks] = *(const LAS bf16x8*)(size_t)((tb ^ (unsigned)(64 * ks)) + 4096 * T);
            f32x4 acc[4][2];
#pragma unroll
            for (int j = 0; j < 4; ++j)
#pragma unroll
                for (int T = 0; T < 2; ++T) acc[j][T] = (f32x4){0.f, 0.f, 0.f, 0.f};
#pragma unroll
            for (int ks = 0; ks < 4; ++ks)
#pragma unroll
                for (int j = 0; j < 4; ++j)
#pragma unroll
                    for (int T = 0; T < 2; ++T) acc[j][T] = __builtin_amdgcn_mfma_f32_16x16x32_bf16(af[j][ks], bfr[T][ks], acc[j][T], 0, 0, 0);
            f32x4 y = {0.f, 0.f, 0.f, 0.f};
#pragma unroll
            for (int p = 0; p < 2; ++p)
#pragma unroll
                for (int T = 0; T < 2; ++T) { const f32x4 xa = acc[2 * p][T], xb = acc[2 * p + 1][T];
                    const u32x4 fr4 = {pk2_relu(xa.x, xa.y), pk2_relu(xa.z, xa.w), pk2_relu(xb.x, xb.y), pk2_relu(xb.z, xb.w)};
                    y = __builtin_amdgcn_mfma_f32_16x16x32_bf16(__builtin_bit_cast(bf16x8, wA[p][T]), __builtin_bit_cast(bf16x8, fr4), y, 0, 0, 0); }
            yp[0] = y.x; yp[1] = y.y;
            VM_WAIT(); LDS_WAIT(); __builtin_amdgcn_s_barrier();
        }
        IX_FLUSH(yp, 4 * (nstep - 1) + kg);
        VM_WAIT(); LDS_WAIT();
        __builtin_amdgcn_s_barrier();
#undef IX_STAGE
#undef IX_FLUSH
        for (int rep_q = 0; rep_q < (PROBE_REP == 42 ? 2 : 1); ++rep_q)
        {
            const float* sc = SC + (size_t)w * 8192; LAS int* idxrow = sidx; const unsigned long long lt_mask = (1ull << lane) - 1ull;
            LAS unsigned* hq = HIST + w * 2048;
            unsigned tl = 0u;
#pragma unroll 8
            for (int i = 0; i < 32; ++i) { const unsigned v = hq[lane * 32 + ((i + lane) & 31)]; tl += (v & 0xffffu) + (v >> 16); }
            const unsigned above_l = wave_above(tl);
            const unsigned long long own = __ballot(above_l < (unsigned)TOPK && above_l + tl >= (unsigned)TOPK);
            const int lo = __ffsll((long long)own) - 1;
            const unsigned above_o = lane_get(above_l, lo);
            const unsigned vw = hq[lo * 32 + (lane >> 1)]; const unsigned cb = (lane & 1) ? (vw >> 16) : (vw & 0xffffu);
            const unsigned above_b = above_o + wave_above(cb);
            const unsigned long long ownb = __ballot(above_b < (unsigned)TOPK && above_b + cb >= (unsigned)TOPK);
            const int lb = __ffsll((long long)ownb) - 1;
            const int b1 = lo * 64 + lb; const unsigned ab1 = lane_get(above_b, lb), cn1 = lane_get(cb, lb);
            if (cn1 > (unsigned)IX_CAP) { __builtin_amdgcn_fence(__ATOMIC_ACQUIRE, "agent"); VM_WAIT(); select_slow(sc, nvis, idxrow, hq, lane); }
            else {
                constexpr int E_ROWS = (TOPK + IX_CAP) / 64;
                LAS unsigned* E = (LAS unsigned*)KBUF + w * (2 * (TOPK + IX_CAP));
                const auto scrs = __builtin_amdgcn_make_buffer_rsrc((void*)sc, 0, 8192 * 4, 0x00020000);
                const unsigned klo = (unsigned)b1 << 20;
                int ebase = 0;
                for (int i0 = 0; i0 < nvis; i0 += 2048) {
                    f32x4 v[8];
#pragma unroll
                    for (int j = 0; j < 8; ++j) v[j] = __builtin_bit_cast(f32x4, __builtin_amdgcn_raw_buffer_load_b128(scrs, (unsigned)(((i0 + j * 256 + 4 * lane) & 8191) * 4), 0, 16));
#pragma unroll
                    for (int j = 0; j < 8; ++j) if (i0 + j * 256 < nvis) { const int e0 = i0 + j * 256 + 4 * lane; const unsigned valid = e0 < nvis ? 1u : 0u;
                        unsigned kk[4], ge[4];
#pragma unroll
                        for (int e = 0; e < 4; ++e) { const float fe = v[j][e]; const unsigned u = __builtin_bit_cast(unsigned, fe); kk[e] = u ^ ((unsigned)((int)u >> 31) | 0x80000000u);
                            ge[e] = (kk[e] >= klo ? 1u : 0u) & valid; }
                        const unsigned cnt4 = (ge[0] + ge[1]) + (ge[2] + ge[3]);
                        const unsigned scan = wave_scan_incl(cnt4), total = lane_get(scan, 63);
                        int eo = ebase + (int)(scan - cnt4);
#pragma unroll
                        for (int e = 0; e < 4; ++e) { if (ge[e]) { const u32x2 pr = {kk[e], (unsigned)(e0 + e)}; *(LAS u32x2*)(E + 2 * eo) = pr; } eo += (int)ge[e]; }
                        ebase += (int)total; }
                }
                LDS_WAIT();
                const int ne = (int)(ab1 + cn1);
                u32x2 en[E_ROWS];
#pragma unroll
                for (int r = 0; r < E_ROWS; ++r) en[r] = *(const LAS u32x2*)(E + 2 * (lane + 64 * r));
                int need = TOPK - (int)ab1;
                LAS unsigned* h2 = hq;
                unsigned prefix = klo;
#pragma unroll 1
                for (int pass = 0; pass < 3; ++pass) {
                    const int shift = pass == 0 ? 12 : pass == 1 ? 4 : 0; const unsigned dmask = pass == 2 ? 15u : 255u; const unsigned himask = 0xffffffffu << (pass == 0 ? 20 : pass == 1 ? 12 : 4);
                    *(LAS u32x4*)(h2 + lane * 4) = (u32x4){0u, 0u, 0u, 0u};
                    LDS_WAIT();
#pragma unroll
                    for (int r = 0; r < E_ROWS; ++r) { const unsigned kk = en[r].x; if (lane + 64 * r < ne && (kk & himask) == (prefix & himask)) __hip_atomic_fetch_add(&h2[(kk >> shift) & dmask], 1u, __ATOMIC_RELAXED, __HIP_MEMORY_SCOPE_WORKGROUP); }
                    LDS_WAIT();
                    const u32x4 c4 = *(const LAS u32x4*)(h2 + lane * 4);
                    const unsigned cnt[4] = {c4.x, c4.y, c4.z, c4.w}; const unsigned tl2 = (c4.x + c4.y) + (c4.z + c4.w);
                    unsigned above = wave_above(tl2); int dsel = -1; unsigned asel = 0u;
#pragma unroll
                    for (int j = 3; j >= 0; --j) { if (dsel < 0 && above < (unsigned)need && above + cnt[j] >= (unsigned)need) { dsel = lane * 4 + j; asel = above; } above += cnt[j]; }
                    const unsigned long long bal = __ballot(dsel >= 0); const int src = __ffsll((long long)bal) - 1;
                    const int d = (int)lane_get((unsigned)dsel, src); const unsigned ab = lane_get(asel, src);
                    need -= (int)ab; prefix |= ((unsigned)d) << shift;
                }
                int selbase = 0, eqseen = 0;
#pragma unroll
                for (int r = 0; r < E_ROWS; ++r) {
                    if (64 * r < ne) {
                        const bool vi = lane + 64 * r < ne; const unsigned kk = en[r].x;
                        const bool gt = vi && kk > prefix, eq = vi && kk == prefix;
                        const unsigned long long beq = __ballot(eq);
                        const int eqrank = eqseen + __popcll(beq & lt_mask);
                        const bool sel = gt || (eq && eqrank < need);
                        const unsigned long long bs = __ballot(sel);
                        if (sel) idxrow[selbase + __popcll(bs & lt_mask)] = (int)en[r].y;
                        selbase += __popcll(bs); eqseen += __popcll(beq);
                    }
                }
            }
        }
        VM_WAIT(); LDS_WAIT(); __syncthreads();
        unsigned nxt = 0u; if (tid == 0) nxt = xb_add(qc, 1u);
        attn_one(C, a, q0 + w, TOPK);
        if (tid == 0) MISC[MISC_Q4] = nxt;
        LDS_WAIT(); __syncthreads();
        cur = __builtin_amdgcn_readfirstlane((int)MISC[MISC_Q4]);
    }
}

__device__ __forceinline__ void p4_hgrn_out(const Ctx& C, const Args& a, unsigned* qc, volatile LAS unsigned* MISC, int& cur) {
    unsigned char* ws = a.ws;
    const float* G = (const float*)(ws + WS_G); bf16* QA = (bf16*)(ws + WS_QA); const bf16* VA = (const bf16*)(ws + WS_VA); const bf16* GA = (const bf16*)(ws + WS_GA);
    const bf16* SPT = (const bf16*)(ws + WS_SPT);
    LAS unsigned char* QI = C.lds;
    LAS unsigned char* QM = QI + 64 * R128;
    LAS unsigned char* KM = QM + 64 * R128;
    LAS unsigned char* vT = KM + 64 * R128;
    LAS unsigned char* SCb = vT + 128 * R64;
    LAS float* segtot = (LAS float*)(SCb + 64 * R64);
    LAS float* rsp = segtot + 8 * 128;
    const int tid = C.tid, lane = C.lane, w = C.wave, fr = lane & 15, fq = lane >> 4;
    while (cur < 1024 + NCH * BH) {
        const int it = cur - 1024;
        unsigned nxt = 0u; if (tid == 0) nxt = xb_add(qc, 1u);
        const int c = it >> 3, h = it & 7;
        bf16x8 sfr[4][4];
        { const bf16* sp0 = SPT + (size_t)it * 16384 + (size_t)(64 * (w & 1) + fr) * 128 + 8 * fq;
#pragma unroll
          for (int ks = 0; ks < 4; ++ks)
#pragma unroll
              for (int ni = 0; ni < 4; ++ni) sfr[ks][ni] = *(const bf16x8*)(sp0 + (size_t)(16 * ni) * 128 + 32 * ks); }
        unsigned short gav[4][4];
#pragma unroll
        for (int r = 0; r < 4; ++r)
#pragma unroll
            for (int ni = 0; ni < 4; ++ni) gav[r][ni] = GA[(size_t)(c * CHUNK + 16 * (w >> 1) + 4 * fq + r) * AW + h * 128 + 64 * (w & 1) + 16 * ni + fr];
        {
            const int k2 = tid & 63, seg = tid >> 6, t0 = c * CHUNK + seg * 8;
            f32x2 g[8], cum[8]; f32x2 run = {0.f, 0.f};
#pragma unroll
            for (int i = 0; i < 8; ++i) { g[i] = *(const f32x2*)(G + (size_t)(t0 + i) * AW + h * 128 + 2 * k2); run += g[i]; cum[i] = run; }
            unsigned qv[8];
#pragma unroll
            for (int i = 0; i < 8; ++i) qv[i] = *(const unsigned*)(QA + (size_t)(t0 + i) * AW + h * 128 + 2 * k2);
            segtot[seg * 128 + 2 * k2] = run.x; segtot[seg * 128 + 2 * k2 + 1] = run.y;
            { const int v = tid & 127, sg = tid >> 7, tv = c * CHUNK + sg * 16; unsigned vp[8];
#pragma unroll
              for (int i = 0; i < 8; ++i) vp[i] = (unsigned)VA[(size_t)(tv + 2 * i) * AW + h * 128 + v] | ((unsigned)VA[(size_t)(tv + 2 * i + 1) * AW + h * 128 + v] << 16);
              *(LAS u32x4*)(vT + v * R64 + sg * 32) = (u32x4){vp[0], vp[1], vp[2], vp[3]}; *(LAS u32x4*)(vT + v * R64 + sg * 32 + 16) = (u32x4){vp[4], vp[5], vp[6], vp[7]}; }
            __syncthreads();
            f32x2 pre = {0.f, 0.f}, cmid = {0.f, 0.f};
#pragma unroll
            for (int s2 = 0; s2 < 8; ++s2) { const f32x2 st = {segtot[s2 * 128 + 2 * k2], segtot[s2 * 128 + 2 * k2 + 1]}; if (s2 < seg) pre += st; if (s2 < 4) cmid += st; }
#pragma unroll
            for (int i = 0; i < 8; ++i) {
                const f32x2 cm = cum[i] + pre; const float q0 = bflo(qv[i]), q1 = bfhi(qv[i]);
                const int row = seg * 8 + i;
                *(LAS unsigned*)(QI + row * R128 + 4 * k2) = pk2(q0 * __expf(cm.x), q1 * __expf(cm.y));
                *(LAS unsigned*)(QM + row * R128 + 4 * k2) = pk2(q0 * __expf(cm.x - cmid.x), q1 * __expf(cm.y - cmid.y));
                *(LAS unsigned*)(KM + row * R128 + 4 * k2) = pk2(-expm1f(g[i].x) * __expf(cmid.x - cm.x), -expm1f(g[i].y) * __expf(cmid.y - cm.y));
            }
        }
        __syncthreads();
        const int tt = w >> 1;
        {
            f32x4 sa[2] = {{0.f, 0.f, 0.f, 0.f}, {0.f, 0.f, 0.f, 0.f}};
#pragma unroll
            for (int ks = 0; ks < 4; ++ks) {
                const bf16x8 qf = *(const LAS bf16x8*)(QM + (16 * tt + fr) * R128 + (32 * ks + 8 * fq) * 2);
#pragma unroll
                for (int si = 0; si < 2; ++si) { const bf16x8 kf = *(const LAS bf16x8*)(KM + (16 * (2 * (w & 1) + si) + fr) * R128 + (32 * ks + 8 * fq) * 2);
                    sa[si] = __builtin_amdgcn_mfma_f32_16x16x32_bf16(qf, kf, sa[si], 0, 0, 0); }
            }
#pragma unroll
            for (int si = 0; si < 2; ++si)
#pragma unroll
                for (int r = 0; r < 4; ++r) { const int t = 16 * tt + 4 * fq + r, s = 16 * (2 * (w & 1) + si) + fr;
                    *(LAS unsigned short*)(SCb + t * R64 + s * 2) = (unsigned short)f2bf(s <= t ? sa[si][r] : 0.f); }
        }
        __syncthreads();
        f32x4 acc[4];
#pragma unroll
        for (int ni = 0; ni < 4; ++ni) acc[ni] = (f32x4){0.f, 0.f, 0.f, 0.f};
        {
#pragma unroll
            for (int ks = 0; ks < 4; ++ks) {
                const bf16x8 qf = *(const LAS bf16x8*)(QI + (16 * tt + fr) * R128 + (32 * ks + 8 * fq) * 2);
#pragma unroll
                for (int ni = 0; ni < 4; ++ni) acc[ni] = __builtin_amdgcn_mfma_f32_16x16x32_bf16(qf, sfr[ks][ni], acc[ni], 0, 0, 0);
            }
#pragma unroll
            for (int ks = 0; ks < 2; ++ks) {
                const bf16x8 pf = *(const LAS bf16x8*)(SCb + (16 * tt + fr) * R64 + (32 * ks + 8 * fq) * 2);
#pragma unroll
                for (int ni = 0; ni < 4; ++ni) { const bf16x8 vf = *(const LAS bf16x8*)(vT + (64 * (w & 1) + 16 * ni + fr) * R64 + (32 * ks + 8 * fq) * 2);
                    acc[ni] = __builtin_amdgcn_mfma_f32_16x16x32_bf16(pf, vf, acc[ni], 0, 0, 0); }
            }
        }
        float ss[4];
#pragma unroll
        for (int r = 0; r < 4; ++r) { float s = 0.f;
#pragma unroll
            for (int ni = 0; ni < 4; ++ni) s += acc[ni][r] * acc[ni][r];
            ss[r] = row16_sum(s); }
        if (fr == 0) {
#pragma unroll
            for (int r = 0; r < 4; ++r) rsp[(16 * tt + 4 * fq + r) * 2 + (w & 1)] = ss[r]; }
        __syncthreads();
#pragma unroll
        for (int r = 0; r < 4; ++r) {
            const int tl = 16 * tt + 4 * fq + r; const float rstd = rsqrtf((rsp[tl * 2] + rsp[tl * 2 + 1]) * (1.f / 128.f) + EPS);
            const size_t rowoff = (size_t)(c * CHUNK + tl) * AW + h * 128;
#pragma unroll
            for (int ni = 0; ni < 4; ++ni) { const int v = 64 * (w & 1) + 16 * ni + fr;
                const unsigned short yv = (unsigned short)f2bf(acc[ni][r] * rstd * a.gnorm_a[v] * bf2f(gav[r][ni])); QA[rowoff + v] = yv; }
        }
        if (tid == 0) MISC[MISC_Q4] = nxt;
        LDS_WAIT(); __syncthreads();
        cur = __builtin_amdgcn_readfirstlane((int)MISC[MISC_Q4]);
    }
}

struct SchedUV {
    pg8::TileOrder T; const char* Ab; const char* Bb;
    __device__ __forceinline__ bool next(int i, pg8::Unit& u) const { u.sub = 0; return T.tile(i, u.pm, u.pn); }
    __device__ __forceinline__ const char* A(const pg8::Unit& u) const { return Ab + ((size_t)u.pm * 256 * 2048 + (size_t)u.pn * 512) * 2; }
    __device__ __forceinline__ const char* B(const pg8::Unit& u) const { return Bb + (size_t)u.pn * 256 * 512 * 2; }
    __device__ __forceinline__ bool keep(const pg8::Unit&) const { return false; }
};
struct EpiUV {
    unsigned char* ws;
    __device__ __forceinline__ void operator()(f32x4 (&acc)[2][2][4][2], const pg8::Unit& u, int wr, int wc, int fr, int fq) const {
        bf16* O = (bf16*)(ws + WS_GB);
        EPI_FOREACH({ const u32x4 gv = *(const u32x4*)(O + (size_t)row * AW + col); u32x4 w;
            w.x = pk2(v0[0] * bflo(gv.x), v0[1] * bfhi(gv.x)); w.y = pk2(v0[2] * bflo(gv.y), v0[3] * bfhi(gv.y)); w.z = pk2(v1[0] * bflo(gv.z), v1[1] * bfhi(gv.z)); w.w = pk2(v1[2] * bflo(gv.w), v1[3] * bfhi(gv.w));
            *(u32x4*)(O + (size_t)row * AW + col) = w; })
    }
};
struct SchedMerge {
    pg8::TileOrder T; const char* Aa; const char* Ab; const char* Ba; const char* Bb;
    __device__ __forceinline__ bool next(int i, pg8::Unit& u) const { u.sub = i & 1; return T.tile(i >> 1, u.pm, u.pn); }
    __device__ __forceinline__ const char* A(const pg8::Unit& u) const { return (u.sub ? Ab : Aa) + (size_t)u.pm * 256 * AW * 2; }
    __device__ __forceinline__ const char* B(const pg8::Unit& u) const { return (u.sub ? Bb : Ba) + (size_t)u.pn * 256 * AW * 2; }
    __device__ __forceinline__ bool keep(const pg8::Unit& u) const { return u.sub == 0; }
};
struct EpiMerge {
    unsigned char* ws;
    __device__ __forceinline__ void operator()(f32x4 (&acc)[2][2][4][2], const pg8::Unit& u, int wr, int wc, int fr, int fq) const {
        const bf16* SA = (const bf16*)(ws + WS_SA); bf16* SB = (bf16*)(ws + WS_SB);
        if (u.sub == 0) {
            EPI_FOREACH({ const u32x4 av = *(const u32x4*)(SA + (size_t)row * D_ + col); const u32x4 bv = *(const u32x4*)(SB + (size_t)row * D_ + col);
                v0[0] *= bflo(av.x) * __builtin_amdgcn_rcpf(bflo(bv.x)); v0[1] *= bfhi(av.x) * __builtin_amdgcn_rcpf(bfhi(bv.x)); v0[2] *= bflo(av.y) * __builtin_amdgcn_rcpf(bflo(bv.y)); v0[3] *= bfhi(av.y) * __builtin_amdgcn_rcpf(bfhi(bv.y));
                v1[0] *= bflo(av.z) * __builtin_amdgcn_rcpf(bflo(bv.z)); v1[1] *= bfhi(av.z) * __builtin_amdgcn_rcpf(bfhi(bv.z)); v1[2] *= bflo(av.w) * __builtin_amdgcn_rcpf(bflo(bv.w)); v1[3] *= bfhi(av.w) * __builtin_amdgcn_rcpf(bfhi(bv.w)); })
        } else {
            EPI_FOREACH({ const u32x4 bv = *(const u32x4*)(SB + (size_t)row * D_ + col); u32x4 w;
                w.x = pk2(v0[0] * bflo(bv.x), v0[1] * bfhi(bv.x)); w.y = pk2(v0[2] * bflo(bv.y), v0[3] * bfhi(bv.y)); w.z = pk2(v1[0] * bflo(bv.z), v1[1] * bfhi(bv.z)); w.w = pk2(v1[2] * bflo(bv.w), v1[3] * bfhi(bv.w));
                *(u32x4*)(SB + (size_t)row * D_ + col) = w; })
        }
    }
};
struct EpiOut {
    const float* x; bf16* ybf; float* RS;
    __device__ __forceinline__ void operator()(f32x4 (&acc)[2][2][4][2], const pg8::Unit& u, int wr, int wc, int fr, int fq) const {
#pragma unroll
        for (int ai = 0; ai < 2; ++ai)
#pragma unroll
            for (int m = 0; m < 4; ++m) { const int row = u.pm * 256 + ai * 128 + wr * 64 + m * 16 + fr; float ss = 0.f;
#pragma unroll
                for (int bj = 0; bj < 2; ++bj) { const int col = u.pn * 256 + bj * 128 + wc * 32 + 8 * fq; const size_t off = (size_t)row * D_ + col;
                    const f32x4 x0 = *(const f32x4*)(x + off), x1 = *(const f32x4*)(x + off + 4); const f32x4 y0 = x0 + acc[ai][bj][m][0], y1 = x1 + acc[ai][bj][m][1];
                    u32x4 pw; pw.x = pk2(y0[0], y0[1]); pw.y = pk2(y0[2], y0[3]); pw.z = pk2(y1[0], y1[1]); pw.w = pk2(y1[2], y1[3]);
                    *(u32x4*)(ybf + off) = pw;
                    ss += (y0[0] * y0[0] + y0[1] * y0[1]) + (y0[2] * y0[2] + y0[3] * y0[3]) + (y1[0] * y1[0] + y1[1] * y1[1]) + (y1[2] * y1[2] + y1[3] * y1[3]); }
                ss = rows_sum(ss);
                if (fq == 0) atomicAdd(RS + row, ss); }
    }
};
__device__ __forceinline__ void p9_final_norm(const Ctx& C, const Args& a) {
    const float* RS = (const float*)(a.ws + WS_CTL) + RS_WORD; const bf16* YBF = (const bf16*)(a.ws + WS_G);
    const int gw = C.wg * NWAVES + C.wave, NGW = C.G * NWAVES;
    for (int m = gw; m < S_; m += NGW) {
        const float rs = rsqrtf(RS[m] * (1.f / D_) + EPS);
        const u32x4* yr = (const u32x4*)(YBF + (size_t)m * D_) + C.lane; f32x4* orow = (f32x4*)(a.out + (size_t)m * D_); const f32x4* wr = (const f32x4*)a.final_norm_w;
#pragma unroll
        for (int j = 0; j < 4; ++j) { const u32x4 yv = yr[64 * j]; const int c4 = 2 * (C.lane + 64 * j);
            const f32x4 w0 = wr[c4], w1 = wr[c4 + 1];
            f32x4 o0, o1; o0.x = bflo(yv.x) * rs * w0.x; o0.y = bfhi(yv.x) * rs * w0.y; o0.z = bflo(yv.y) * rs * w0.z; o0.w = bfhi(yv.y) * rs * w0.w;
            o1.x = bflo(yv.z) * rs * w1.x; o1.y = bfhi(yv.z) * rs * w1.y; o1.z = bflo(yv.w) * rs * w1.z; o1.w = bfhi(yv.w) * rs * w1.w;
            orow[c4] = o0; orow[c4 + 1] = o1; }
    }
}

#ifndef MK_N_LAUNCHES
#define MK_N_LAUNCHES 1
#endif
constexpr int N_PHASES = 10;
__global__ void __launch_bounds__(NTHR, 2) mega_fwd(Args a) {
    extern __shared__ __attribute__((aligned(16))) unsigned char lds_raw[];
    Ctx C; C.lds = (LAS unsigned char*)lds_raw; C.tid = threadIdx.x; C.lane = C.tid & 63; C.wave = __builtin_amdgcn_readfirstlane(C.tid >> 6); C.wg = blockIdx.x; C.G = gridDim.x;
    volatile LAS unsigned* MISC = (volatile LAS unsigned*)(C.lds + MISC_OFF);
    if (C.tid < 32) MISC[C.tid] = 0u;
    __syncthreads();
    unsigned char* ws = a.ws;
    XcdBarrier bar; bar.bar = (unsigned*)(ws + WS_CTL) + CW_BAR; bar.x = 0; bar.st = nullptr;
    const int lo = a.ph_lo, hi = a.ph_hi;
    if (hi - lo > 1) bar = xcd_barrier_post((unsigned*)(ws + WS_CTL) + CW_BAR, MISC + 8);
#define IN(k) (lo <= (k) && (k) < hi)
#define SEAM(k) do { if (IN(k) && IN((k) + 1)) xcd_barrier(bar); } while (0)
    float* dscr = a.out;
    if (IN(0)) { REP(0) p0_prep(C, a); } SEAM(0);
    if (IN(1)) {
        SchedPlain S; S.T.init(S_, NIN, C.G, C.wg); S.Ab = (const char*)(ws + WS_H); S.Bb = (const char*)(ws + WS_WIN); S.tA = (size_t)256 * D_ * 2; S.tB = (size_t)256 * D_ * 2;
        EpiProj E{ws}; REP(1) pg8::gemm_phase(C.lds, D_, D_, D_, S, E);
    } SEAM(1);
    if (IN(2)) { REP(2) p2_norms(C, a); REP(12) p2_hgrn_states(C, a, dscr); } SEAM(2);
    if (IN(3)) {
        SchedPlain S; S.T.init(S_, 4096, C.G, C.wg); S.Ab = (const char*)(ws + WS_CQN); S.Bb = (const char*)(ws + WS_WQ); S.tA = (size_t)256 * QR * 2; S.tB = (size_t)256 * QR * 2;
        EpiQ E{ws}; REP(3) pg8::gemm_phase(C.lds, QR, QR, QR, S, E);
        REP(13) p3_scan(C, a, dscr);
    } SEAM(3);
    if (IN(4)) {
        unsigned* qc = (unsigned*)(ws + WS_CTL) + CW_Q4;
        if (C.tid == 0) MISC[MISC_Q4] = xb_add(qc, 1u);
        attn_setup(C, a);
        int cur = __builtin_amdgcn_readfirstlane((int)MISC[MISC_Q4]);
        p4_indexer(C, a, dscr, qc, MISC, cur); p4_hgrn_out(C, a, qc, MISC, cur);
    } SEAM(4);
    if (IN(6)) {
        SchedUV S; S.T.init(S_, AW, C.G, C.wg); S.Ab = (const char*)(ws + WS_RAW); S.Bb = (const char*)(ws + WS_WUV);
        EpiUV E{ws}; pg8::gemm_phase(C.lds, 2048, 512, 512, S, E);
    } SEAM(6);
    if (IN(7)) {
        SchedMerge S; S.T.init(S_, D_, C.G, C.wg); S.Aa = (const char*)(ws + WS_QA); S.Ab = (const char*)(ws + WS_GB); S.Ba = (const char*)(ws + WS_WPA); S.Bb = (const char*)(ws + WS_WPB);
        EpiMerge E{ws}; pg8::gemm_phase(C.lds, AW, AW, AW, S, E);
    } SEAM(7);
    if (IN(8)) {
        SchedPlain S; S.T.init(S_, D_, C.G, C.wg); S.Ab = (const char*)(ws + WS_SB); S.Bb = (const char*)(ws + WS_WOUT); S.tA = (size_t)256 * D_ * 2; S.tB = (size_t)256 * D_ * 2;
        EpiOut E{a.x, (bf16*)(ws + WS_G), (float*)(ws + WS_CTL) + RS_WORD}; pg8::gemm_phase(C.lds, D_, D_, D_, S, E);
    } SEAM(8);
    if (IN(9)) { p9_final_norm(C, a); }
#undef IN
#undef SEAM
}

extern "C" void kernel_launch(void* const* d_in, const int* in_sizes, int n_in, void* d_out, int out_size, void* d_ws, size_t ws_size, hipStream_t stream) {
    static int grid = 0;
    if (grid == 0) {
        if (n_in != 17 || in_sizes[0] != S_ * D_ || out_size != S_ * D_ || ws_size < WS_END) {
            fprintf(stderr, "kernel_launch: unexpected shapes / workspace (n_in %d, in0 %d, out %d, ws %zu < %zu); nothing launched\n", n_in, n_in > 0 ? in_sizes[0] : -1, out_size, ws_size, (size_t)WS_END); grid = -1; return; }
        int dev = 0, cus = 0;
        if (hipGetDevice(&dev) != hipSuccess || hipDeviceGetAttribute(&cus, hipDeviceAttributeMultiprocessorCount, dev) != hipSuccess) { grid = -1; return; }
        if (hipFuncSetAttribute((const void*)mega_fwd, hipFuncAttributeMaxDynamicSharedMemorySize, LDS_BYTES) != hipSuccess) { fprintf(stderr, "kernel_launch: hipFuncSetAttribute failed\n"); grid = -1; return; }
        (void)hipGetLastError();
        grid = cus;
    }
    if (grid < 0) return;
    (void)hipMemsetAsync((char*)d_ws + WS_CTL, 0, CTL_ZERO_BYTES, stream);
    Args a{};
    const float** ip = (const float**)&a;
    for (int i = 0; i < 17; ++i) ip[i] = (const float*)d_in[i];
    a.out = (float*)d_out; a.ws = (unsigned char*)d_ws;
    constexpr int NL = MK_N_LAUNCHES;
    for (int li = 0; li < NL; ++li) {
        a.ph_lo = li * N_PHASES / NL; a.ph_hi = (li + 1) * N_PHASES / NL;
        hipLaunchKernelGGL(mega_fwd, dim3(grid), dim3(NTHR), LDS_BYTES, stream, a);
    }
}
```

```cpp
#include <hip/hip_runtime.h>
#include <cstdio>

#define LAS __attribute__((address_space(3)))
#define GAS __attribute__((address_space(1)))
typedef unsigned short bf16;
typedef short bf16x8 __attribute__((ext_vector_type(8)));
typedef short s16x4 __attribute__((ext_vector_type(4)));
typedef float f32x4 __attribute__((ext_vector_type(4)));
typedef float f32x2 __attribute__((ext_vector_type(2)));
typedef float f32x16 __attribute__((ext_vector_type(16)));
typedef unsigned u32x4 __attribute__((ext_vector_type(4)));
typedef unsigned u32x2 __attribute__((ext_vector_type(2)));

namespace pg8 {
constexpr int BM = 256, BK = 64, HALF = 128, HTB = HALF * BK * 2, STAGE_BYTES = 8 * HTB, NXCD = 8, WGM = 8;
__device__ __forceinline__ int lds_byte(int r, int c) { const int st = (r >> 4) * 2 + (c >> 5), rr = r & 15, cc = c & 31, ob = rr * 64 + cc * 2; return st * 1024 + (ob ^ (((ob >> 9) & 1) << 5)); }
__device__ __forceinline__ void stage_rc(int b, int& R, int& C) { const int st = b / 1024, sb = b % 1024, swz = sb ^ (((sb >> 9) & 1) << 5); R = (st >> 1) * 16 + swz / 64; C = (st & 1) * 32 + (swz % 64) / 2; }
__device__ __forceinline__ int perm32(int rho) { const int n = rho >> 4, i = rho & 15; return 8 * (i >> 2) + 4 * n + (i & 3); }
struct Unit { int pm, pn, sub; };
struct TileOrder {
    int nM, nN, nwg, G, c;
    __device__ void init(int M, int N, int G_, int c_) { nM = M / BM; nN = N / BM; nwg = nM * nN; G = G_; c = c_; }
    __device__ bool tile(int i, int& pm, int& pn) const {
        const long L = (long)i * G + c; if (L >= nwg) return false;
        int wgid = (int)L; { const int q = nwg / NXCD, r = nwg % NXCD, xcd = wgid % NXCD, off = wgid / NXCD; wgid = (xcd < r ? xcd * (q + 1) : r * (q + 1) + (xcd - r) * q) + off; }
        const int nig = WGM * nN, gid = wgid / nig, fm = gid * WGM, gsz = (nM - fm) < WGM ? (nM - fm) : WGM;
        pm = fm + ((wgid % nig) % gsz); pn = (wgid % nig) / gsz; return true;
    }
};
template <class Epi, class Sched, bool ALIGN_EPI = true, bool SP2 = true>
__device__ __forceinline__ void gemm_phase(LAS unsigned char* lds, const int lda, const int ldb, const int K, const Sched& S, const Epi& E) {
    const int tid = threadIdx.x, wid = __builtin_amdgcn_readfirstlane(tid >> 6), lane = tid & 63, wr = wid >> 2, wc = wid & 3, fr = lane & 15, fq = lane >> 4;
    const int nt = K / BK;
    unsigned voffA[2], voffB[2];
#pragma unroll
    for (int i = 0; i < 2; ++i) { int R, C; stage_rc(tid * 16 + i * 8192, R, C); const int Rb = (R & ~31) + perm32(R & 31);
        voffA[i] = (unsigned)(R * lda + C) * 2u; voffB[i] = (unsigned)(Rb * ldb + C) * 2u; }
    const size_t kstep = (size_t)(BK * 2);
    const size_t hstepA = (size_t)HALF * lda * 2, hstepB = (size_t)HALF * ldb * 2;
    const unsigned ldsw = (unsigned)wid * 1024u;
    const int aoff = lds_byte(wr * 64 + fr, fq * 8), boff = lds_byte(wc * 32 + fr, fq * 8);
#define PG8_SA(b, h) (((b) * 2 + (h)) * HTB)
#define PG8_SB(b, h) ((4 + (b) * 2 + (h)) * HTB)
#define PG8_STAGE(bufoff, gbase, voff) do { _Pragma("unroll") for (int _i = 0; _i < 2; ++_i) \
        __builtin_amdgcn_global_load_lds((const unsigned*)((const char*)(gbase) + (voff)[_i]), (LAS unsigned*)(lds + (bufoff) + ldsw + _i * 8192), 16, 0, 0); } while (0)
#define PG8_LDA(dst, b, h) do { _Pragma("unroll") for (int m = 0; m < 4; ++m) _Pragma("unroll") for (int k = 0; k < 2; ++k) dst[m][k] = *(const LAS bf16x8*)(lds + PG8_SA(b, h) + aoff + m * 2048 + k * 1024); } while (0)
#define PG8_LDB(dst, b, h) do { _Pragma("unroll") for (int n = 0; n < 2; ++n) _Pragma("unroll") for (int k = 0; k < 2; ++k) dst[n][k] = *(const LAS bf16x8*)(lds + PG8_SB(b, h) + boff + n * 2048 + k * 1024); } while (0)
#define PG8_MMA(ai, bj, At, Bt) do { __builtin_amdgcn_s_setprio(1); _Pragma("unroll") for (int m = 0; m < 4; ++m) _Pragma("unroll") for (int n = 0; n < 2; ++n) _Pragma("unroll") for (int k = 0; k < 2; ++k) \
        acc[ai][bj][m][n] = __builtin_amdgcn_mfma_f32_16x16x32_bf16(Bt[n][k], At[m][k], acc[ai][bj][m][n], 0, 0, 0); __builtin_amdgcn_s_setprio(0); } while (0)
#define PG8_WAIT_V(n) asm volatile("s_waitcnt vmcnt(" #n ")" ::: "memory")
#define PG8_WAIT_L(n) asm volatile("s_waitcnt lgkmcnt(" #n ")" ::: "memory")
#define PG8_BAR __builtin_amdgcn_s_barrier()
#define PG8_SCHED __builtin_amdgcn_sched_barrier(0)
    Unit cur, nxt; int ui = 0;
    if (!S.next(0, cur)) return;
    f32x4 acc[2][2][4][2];
#pragma unroll
    for (int a = 0; a < 2; ++a)
#pragma unroll
        for (int b = 0; b < 2; ++b)
#pragma unroll
            for (int m = 0; m < 4; ++m)
#pragma unroll
                for (int n = 0; n < 2; ++n) acc[a][b][m][n] = (f32x4){0.f, 0.f, 0.f, 0.f};
    bf16x8 At[4][2], B0[2][2], B1[2][2];
    const char* cA = S.A(cur); const char* cB = S.B(cur);
    if constexpr (SP2) {
        PG8_STAGE(PG8_SB(0, 0), cB, voffB); PG8_STAGE(PG8_SB(0, 1), cB + hstepB, voffB); PG8_STAGE(PG8_SA(0, 0), cA, voffA); PG8_STAGE(PG8_SA(0, 1), cA + hstepA, voffA);
        if (wr == 1) PG8_BAR;
        PG8_WAIT_V(2); PG8_BAR;
        PG8_STAGE(PG8_SB(1, 0), cB + kstep, voffB); PG8_STAGE(PG8_SA(1, 0), cA + kstep, voffA); PG8_STAGE(PG8_SB(1, 1), cB + hstepB + kstep, voffB);
        PG8_WAIT_V(6); PG8_BAR;
    } else {
        PG8_STAGE(PG8_SB(0, 0), cB, voffB); PG8_STAGE(PG8_SA(0, 0), cA, voffA); PG8_STAGE(PG8_SB(0, 1), cB + hstepB, voffB); PG8_STAGE(PG8_SA(0, 1), cA + hstepA, voffA);
        if (wr == 1) PG8_BAR;
        PG8_WAIT_V(4); PG8_BAR;
        PG8_STAGE(PG8_SB(1, 0), cB + kstep, voffB); PG8_STAGE(PG8_SA(1, 0), cA + kstep, voffA); PG8_STAGE(PG8_SB(1, 1), cB + hstepB + kstep, voffB);
        PG8_WAIT_V(6); PG8_BAR;
    }
    for (;;) {
        const bool has_next = S.next(ui + 1, nxt);
        const char* nA = has_next ? S.A(nxt) : cA; const char* nB = has_next ? S.B(nxt) : cB;
        for (int t = 0; t < nt; t += 2) {
            const bool last = (t == nt - 2);
            const char* a1 = cA + (size_t)(t + 1) * kstep;
            const char* a2 = last ? nA : cA + (size_t)(t + 2) * kstep; const char* b2 = last ? nB : cB + (size_t)(t + 2) * kstep;
            const char* a3 = a2 + kstep; const char* b3 = b2 + kstep;
            if constexpr (SP2) {
            PG8_LDB(B0, 0, 0); PG8_LDB(B1, 0, 1); PG8_SCHED; PG8_LDA(At, 0, 0); PG8_STAGE(PG8_SA(1, 1), a1 + hstepA, voffA);
            PG8_WAIT_V(8); PG8_WAIT_L(0); PG8_BAR; PG8_MMA(0, 0, At, B0); PG8_MMA(0, 1, At, B1); PG8_BAR; PG8_SCHED;
            PG8_LDA(At, 0, 1); PG8_STAGE(PG8_SB(0, 0), b2, voffB); PG8_STAGE(PG8_SB(0, 1), b2 + hstepB, voffB); PG8_STAGE(PG8_SA(0, 0), a2, voffA);
            PG8_WAIT_V(8); PG8_WAIT_L(0); PG8_BAR; PG8_MMA(1, 0, At, B0); PG8_MMA(1, 1, At, B1); PG8_BAR; PG8_SCHED;
            PG8_LDB(B0, 1, 0); PG8_LDB(B1, 1, 1); PG8_SCHED; PG8_LDA(At, 1, 0); PG8_STAGE(PG8_SA(0, 1), a2 + hstepA, voffA);
            PG8_WAIT_V(8); PG8_WAIT_L(0); PG8_BAR; PG8_MMA(0, 0, At, B0); PG8_MMA(0, 1, At, B1); PG8_BAR; PG8_SCHED;
            PG8_LDA(At, 1, 1); PG8_STAGE(PG8_SB(1, 0), b3, voffB); PG8_STAGE(PG8_SB(1, 1), b3 + hstepB, voffB); PG8_STAGE(PG8_SA(1, 0), a3, voffA);
            PG8_WAIT_V(8); PG8_WAIT_L(0); PG8_BAR; PG8_MMA(1, 0, At, B0); PG8_MMA(1, 1, At, B1); PG8_BAR; PG8_SCHED;
            } else {
            PG8_LDB(B0, 0, 0); PG8_SCHED; PG8_LDA(At, 0, 0); PG8_STAGE(PG8_SA(1, 1), a1 + hstepA, voffA);
            PG8_WAIT_L(8); PG8_BAR; PG8_WAIT_L(0); PG8_MMA(0, 0, At, B0); PG8_BAR; PG8_SCHED;
            PG8_LDB(B1, 0, 1); PG8_STAGE(PG8_SB(0, 0), b2, voffB);
            PG8_BAR; PG8_WAIT_L(0); PG8_MMA(0, 1, At, B1); PG8_BAR;
            PG8_LDA(At, 0, 1); PG8_STAGE(PG8_SA(0, 0), a2, voffA);
            PG8_BAR; PG8_WAIT_L(0); PG8_MMA(1, 0, At, B0); PG8_BAR; PG8_SCHED;
            PG8_STAGE(PG8_SB(0, 1), b2 + hstepB, voffB);
            PG8_WAIT_V(6); PG8_BAR; PG8_MMA(1, 1, At, B1); PG8_BAR;
            PG8_LDB(B0, 1, 0); PG8_SCHED; PG8_LDA(At, 1, 0); PG8_STAGE(PG8_SA(0, 1), a2 + hstepA, voffA);
            PG8_WAIT_L(8); PG8_BAR; PG8_WAIT_L(0); PG8_MMA(0, 0, At, B0); PG8_BAR; PG8_SCHED;
            PG8_LDB(B1, 1, 1); PG8_STAGE(PG8_SB(1, 0), b3, voffB);
            PG8_BAR; PG8_WAIT_L(0); PG8_MMA(0, 1, At, B1); PG8_BAR;
            PG8_LDA(At, 1, 1); PG8_STAGE(PG8_SA(1, 0), a3, voffA);
            PG8_BAR; PG8_WAIT_L(0); PG8_MMA(1, 0, At, B0); PG8_BAR; PG8_SCHED;
            PG8_STAGE(PG8_SB(1, 1), b3 + hstepB, voffB);
            PG8_WAIT_V(6); PG8_BAR; PG8_MMA(1, 1, At, B1); PG8_BAR;
            }
        }
        if constexpr (ALIGN_EPI) { if (wr == 0) PG8_BAR; }
        E(acc, cur, wr, wc, fr, fq);
        if (!has_next) break;
        if (!S.keep(cur)) {
#pragma unroll
            for (int a = 0; a < 2; ++a)
#pragma unroll
                for (int b = 0; b < 2; ++b)
#pragma unroll
                    for (int m = 0; m < 4; ++m)
#pragma unroll
                        for (int n = 0; n < 2; ++n) acc[a][b][m][n] = (f32x4){0.f, 0.f, 0.f, 0.f};
        }
        cur = nxt; cA = nA; cB = nB; ++ui;
        if constexpr (ALIGN_EPI) { if (wr == 1) PG8_BAR; }
    }
    PG8_WAIT_V(0);
    if constexpr (!ALIGN_EPI) { if (wr == 0) PG8_BAR; }
    PG8_BAR;
#undef PG8_SA
#undef PG8_SB
#undef PG8_STAGE
#undef PG8_LDA
#undef PG8_LDB
#undef PG8_MMA
#undef PG8_WAIT_V
#undef PG8_WAIT_L
#undef PG8_BAR
#undef PG8_SCHED
}
}

#ifndef PROBE_REP
#define PROBE_REP -1
#endif
#define REP(k) for (int _r = 0; _r < ((k) == PROBE_REP ? 2 : 1); ++_r)
constexpr int S_ = 8192, D_ = 2048, AW = 1024, QR = 512, KVR = 256, IDXD = 128, IDXH = 16, BH = 8, TOPK = 256, CHUNK = 64, NCH = S_ / CHUNK;
constexpr int IN_W = 10128, NIN = 10240;
constexpr float EPS = 1e-6f;
constexpr int NWAVES = 8, NTHR = 512;

constexpr size_t MiB = 1u << 20;
constexpr size_t WS_CTL = 0, CTL_ZERO_BYTES = 64 * 1024;
constexpr size_t WS_LB = 1 * MiB;
constexpr size_t WS_NCNT = 1 * MiB + 64 * 1024;
constexpr size_t WS_DLAST = 1 * MiB + 128 * 1024;
constexpr size_t WS_WIDX = 2 * MiB;
constexpr size_t WS_WQ = 4 * MiB;
constexpr size_t WS_WUV = 8 * MiB;
constexpr size_t WS_WPA = 9 * MiB, WS_WPB = 13 * MiB;
constexpr size_t WS_WOUT = 17 * MiB;
constexpr size_t WS_QA = 25 * MiB;
constexpr size_t WS_G = 41 * MiB;
constexpr size_t WS_VA = 73 * MiB;
constexpr size_t WS_GA = 89 * MiB;
constexpr size_t WS_GB = 105 * MiB;
constexpr size_t WS_SA = 121 * MiB;
constexpr size_t WS_SB = 153 * MiB;
constexpr size_t WS_RAW = 185 * MiB;
constexpr size_t WS_H = 217 * MiB;
constexpr size_t WS_CQN = 217 * MiB, WS_CKVN = 225 * MiB, WS_KIDX = 229 * MiB, WS_IDX = 231 * MiB;
constexpr size_t WS_WIN = 249 * MiB;
constexpr size_t WS_QABS = 249 * MiB;
constexpr size_t WS_SPT = 281 * MiB;
constexpr size_t WS_END = 313 * MiB;
constexpr int CW_BAR = 4096;
constexpr int CW_Q4 = 8192;
constexpr int MISC_Q4 = 16;

typedef __bf16 bf16x2_t __attribute__((ext_vector_type(2)));
typedef short s16x2 __attribute__((ext_vector_type(2)));
__device__ __forceinline__ unsigned pk2(float lo, float hi) { const f32x2 v = {lo, hi}; return __builtin_bit_cast(unsigned, __builtin_convertvector(v, bf16x2_t)); }
__device__ __forceinline__ unsigned f2bf(float f) { return pk2(f, 0.f) & 0xffffu; }
__device__ __forceinline__ unsigned pk2_relu(float lo, float hi) { const f32x2 v = {lo, hi}; const s16x2 z = {0, 0};
    return __builtin_bit_cast(unsigned, __builtin_elementwise_max(__builtin_bit_cast(s16x2, __builtin_convertvector(v, bf16x2_t)), z)); }
__device__ __forceinline__ float bf2f(unsigned short b) { return __builtin_bit_cast(float, ((unsigned)b) << 16); }
__device__ __forceinline__ float bflo(unsigned w) { return __builtin_bit_cast(float, w << 16); }
__device__ __forceinline__ float bfhi(unsigned w) { return __builtin_bit_cast(float, w & 0xffff0000u); }
template <int CTRL, int ROWMASK, bool BOUND> __device__ __forceinline__ unsigned dpp_mov(unsigned x) { return (unsigned)__builtin_amdgcn_update_dpp(0, (int)x, CTRL, ROWMASK, 0xf, BOUND); }
__device__ __forceinline__ float row16_sum(float v) {
    v += __builtin_bit_cast(float, dpp_mov<0x128, 0xf, false>(__builtin_bit_cast(unsigned, v)));
    v += __builtin_bit_cast(float, dpp_mov<0x124, 0xf, false>(__builtin_bit_cast(unsigned, v)));
    v += __builtin_bit_cast(float, dpp_mov<0x122, 0xf, false>(__builtin_bit_cast(unsigned, v)));
    v += __builtin_bit_cast(float, dpp_mov<0x121, 0xf, false>(__builtin_bit_cast(unsigned, v)));
    return v;
}
__device__ __forceinline__ float rows_sum(float v) {
    { const auto r = __builtin_amdgcn_permlane32_swap(__builtin_bit_cast(unsigned, v), __builtin_bit_cast(unsigned, v), false, false); const unsigned a0 = r[0], a1 = r[1];
      v = __builtin_bit_cast(float, a0) + __builtin_bit_cast(float, a1); }
    { const auto r = __builtin_amdgcn_permlane16_swap(__builtin_bit_cast(unsigned, v), __builtin_bit_cast(unsigned, v), false, false); const unsigned a0 = r[0], a1 = r[1];
      v = __builtin_bit_cast(float, a0) + __builtin_bit_cast(float, a1); }
    return v;
}
__device__ __forceinline__ float rows_max(float v) {
    { const auto r = __builtin_amdgcn_permlane32_swap(__builtin_bit_cast(unsigned, v), __builtin_bit_cast(unsigned, v), false, false); const unsigned a0 = r[0], a1 = r[1];
      v = fmaxf(__builtin_bit_cast(float, a0), __builtin_bit_cast(float, a1)); }
    { const auto r = __builtin_amdgcn_permlane16_swap(__builtin_bit_cast(unsigned, v), __builtin_bit_cast(unsigned, v), false, false); const unsigned a0 = r[0], a1 = r[1];
      v = fmaxf(__builtin_bit_cast(float, a0), __builtin_bit_cast(float, a1)); }
    return v;
}
__device__ __forceinline__ float wave_sum(float v) { return rows_sum(row16_sum(v)); }
__device__ __forceinline__ unsigned wave_scan_incl(unsigned x) {
    x += dpp_mov<0x111, 0xf, true>(x); x += dpp_mov<0x112, 0xf, true>(x); x += dpp_mov<0x114, 0xf, true>(x); x += dpp_mov<0x118, 0xf, true>(x);
    x += dpp_mov<0x142, 0xa, false>(x); x += dpp_mov<0x143, 0xc, false>(x);
    return x;
}
__device__ __forceinline__ unsigned wave_above(unsigned x) { const unsigned pi = wave_scan_incl(x); return (unsigned)__builtin_amdgcn_readlane((int)pi, 63) - pi; }
__device__ __forceinline__ unsigned lane_get(unsigned x, int l) { return (unsigned)__builtin_amdgcn_readlane((int)x, l); }
__device__ __forceinline__ float sigmoidf_(float x) { return __builtin_amdgcn_rcpf(1.0f + __expf(-x)); }
__device__ __forceinline__ float siluf_(float x) { return x * __builtin_amdgcn_rcpf(1.0f + __expf(-x)); }
#define LDS_WAIT() asm volatile("s_waitcnt lgkmcnt(0)" ::: "memory")
#define VM_WAIT() asm volatile("s_waitcnt vmcnt(0)" ::: "memory")

#define XB_TMO      128
#define XB_XCNT(j)  (256  + 64 * (j))
#define XB_XSUB(j)  (1280 + 64 * (j))
#define XB_XGEN(j)  (2304 + 64 * (j))
#define XB_TOP      3328
#define XB_TOPGEN   3392
#define XCD_BAR_WORDS 3456
#define XB_SPIN_CAP (1u << 22)
__device__ __forceinline__ unsigned xb_ld(unsigned* p)              { return __hip_atomic_load(p, __ATOMIC_RELAXED, __HIP_MEMORY_SCOPE_AGENT); }
__device__ __forceinline__ unsigned xb_add(unsigned* p, unsigned v) { return __hip_atomic_fetch_add(p, v, __ATOMIC_RELAXED, __HIP_MEMORY_SCOPE_AGENT); }
__device__ __forceinline__ unsigned xb_xcc_id() { return (unsigned)__builtin_amdgcn_s_getreg((3 << 11) | 20) & 0xFu; }
#define XB_SPIN(cond, bar) do { unsigned _sp = 0; while (cond) { __builtin_amdgcn_s_sleep(1); \
    if ((++_sp & 255u) == 0u) { if (xb_ld(&(bar)[XB_TMO])) break; if (_sp > XB_SPIN_CAP) { atomicAdd(&(bar)[XB_TMO], 1u); break; } } } } while (0)
struct XcdBarrier { unsigned* bar; unsigned x; volatile LAS unsigned* st; };
__device__ __forceinline__ XcdBarrier xcd_barrier_post(unsigned* bar, volatile LAS unsigned* st) {
    XcdBarrier b; b.bar = bar; b.x = xb_xcc_id(); b.st = st;
    if (threadIdx.x == 0) (void)xb_add(&bar[XB_XCNT(b.x)], 1u);
    return b;
}
__device__ __forceinline__ void xcd_barrier_complete(unsigned* bar, unsigned x, unsigned& nloc, unsigned& nx) {
    const unsigned G = gridDim.x * gridDim.y * gridDim.z;
    unsigned sum, cnt, mine, sp = 0u;
    for (;;) {
        sum = 0u; cnt = 0u; mine = 0u;
#pragma unroll
        for (unsigned j = 0; j < 16; ++j) { const unsigned c = xb_ld(&bar[XB_XCNT(j)]); sum += c; cnt += (c > 0u) ? 1u : 0u; mine = (j == x) ? c : mine; }
        if (sum == G) break;
        __builtin_amdgcn_s_sleep(1);
        if ((++sp & 255u) == 0u) { if (xb_ld(&bar[XB_TMO])) break; if (sp > XB_SPIN_CAP) { atomicAdd(&bar[XB_TMO], 1u); break; } }
    }
    nloc = mine > 0u ? mine : 1u; nx = cnt > 0u ? cnt : 1u;
}
__device__ __forceinline__ void xcd_barrier(const XcdBarrier& b) {
    asm volatile("s_waitcnt vmcnt(0)" ::: "memory");
    __syncthreads();
    if (threadIdx.x == 0) {
        unsigned* bar = b.bar;
        __builtin_amdgcn_s_waitcnt(0);
        unsigned nloc = b.st[0], nx = b.st[1];
        if (nloc == 0u) { xcd_barrier_complete(bar, b.x, nloc, nx); b.st[0] = nloc; b.st[1] = nx; }
        const unsigned old = xb_add(&bar[XB_XSUB(b.x)], 1u);
        const unsigned gen = old / nloc;
        if (old + 1u == (gen + 1u) * nloc) {
            __builtin_amdgcn_fence(__ATOMIC_RELEASE, "agent");
            asm volatile("s_waitcnt vmcnt(0)" ::: "memory");
            const unsigned og = xb_add(&bar[XB_TOP], 1u);
            const unsigned tg = og / nx;
            if (og + 1u == (tg + 1u) * nx) xb_add(&bar[XB_TOPGEN], 1u);
            else XB_SPIN(xb_ld(&bar[XB_TOPGEN]) == tg, bar);
            __builtin_amdgcn_fence(__ATOMIC_ACQUIRE, "agent");
            asm volatile("s_waitcnt vmcnt(0)" ::: "memory");
        } else {
            XB_SPIN(xb_ld(&bar[XB_TOPGEN]) == gen, bar);
            __builtin_amdgcn_fence(__ATOMIC_ACQUIRE, "agent");
            asm volatile("s_waitcnt vmcnt(0)" ::: "memory");
        }
    }
    __syncthreads();
}

struct Args {
    const float *x, *norm_w, *w_in, *lb_table, *gnorm_a, *q_norm_w, *kv_norm_w, *w_uq, *w_qidx, *w_ukv, *kidx_norm_w, *kidx_norm_b, *w_pa, *w_pb, *w_out, *rel_bias, *final_norm_w;
    float* out; unsigned char* ws; int ph_lo, ph_hi;
};
constexpr int LDS_BYTES = 155648;
constexpr int MISC_OFF = 154624;
struct Ctx { LAS unsigned char* lds; int tid, lane, wave, wg, G; };

struct P0Item { const float* src; bf16* dst; int N, ldk, sc; };
__device__ __forceinline__ P0Item p0_decode(const Args& a, unsigned char* ws, int it, int lane) {
    constexpr int I_IN = (D_ / 64) * (NIN / 32), I_QI = (QR / 64) * (2048 / 32), I_PA = (AW / 64) * (D_ / 32), I_OUT = (D_ / 64) * (D_ / 32);
    const int c4 = lane & 7; P0Item d; int r = it;
    if (r < I_IN) { const int kb = r / (NIN / 32), nb = r % (NIN / 32), np = 32 * nb + 4 * c4;
        d.src = a.w_in + (size_t)(64 * kb) * IN_W; d.N = IN_W; d.sc = np < 5008 ? np : (np < 5120 ? -1 : np - 112); d.dst = (bf16*)(ws + WS_WIN) + (size_t)(32 * nb) * D_ + 64 * kb; d.ldk = D_; return d; } r -= I_IN;
    if (r < I_QI) { const int kb = r / 64, nb = r % 64; d.src = a.w_qidx + (size_t)(64 * kb) * 2048; d.N = 2048; d.sc = 32 * nb + 4 * c4; d.dst = (bf16*)(ws + WS_WQ) + (size_t)(2048 + 32 * nb) * QR + 64 * kb; d.ldk = QR; return d; } r -= I_QI;
    if (r < 2 * I_PA) { const bool pb = r >= I_PA; if (pb) r -= I_PA; const int kb = r / 64, nb = r % 64;
        d.src = (pb ? a.w_pb : a.w_pa) + (size_t)(64 * kb) * D_; d.N = D_; d.sc = 32 * nb + 4 * c4; d.dst = (bf16*)(ws + (pb ? WS_WPB : WS_WPA)) + (size_t)(32 * nb) * AW + 64 * kb; d.ldk = AW; return d; } r -= 2 * I_PA;
    if (r < I_OUT) { const int kb = r / 64, nb = r % 64; d.src = a.w_out + (size_t)(64 * kb) * D_; d.N = D_; d.sc = 32 * nb + 4 * c4; d.dst = (bf16*)(ws + WS_WOUT) + (size_t)(32 * nb) * D_ + 64 * kb; d.ldk = D_; return d; } r -= I_OUT;
    {
        const int kb = r / 32, nb = r % 32, k0 = 64 * kb, hh = k0 >> 8, c0 = k0 & 255, np = 32 * nb + 4 * c4, h = np >> 7, dd = np & 127;
        d.src = a.w_ukv + (size_t)c0 * 2048; d.N = 2048; d.sc = (hh == (h & 1)) ? h * 256 + 128 + dd : -1; d.dst = (bf16*)(ws + WS_WUV) + (size_t)(32 * nb) * 512 + k0; d.ldk = 512; return d; }
}
__device__ __forceinline__ void p0_item_load(const P0Item& d, int lane, f32x4 (&v)[8]) {
    const int kr = lane >> 3;
#pragma unroll
    for (int i = 0; i < 8; ++i) v[i] = d.sc >= 0 ? __builtin_nontemporal_load((const f32x4*)(d.src + (size_t)(kr + 8 * i) * d.N + d.sc)) : (f32x4){0.f, 0.f, 0.f, 0.f};
}
__device__ __forceinline__ void p0_item_put(const P0Item& d, int lane, const f32x4 (&v)[8], LAS float* scr) {
    const int c4 = lane & 7, kr = lane >> 3;
#pragma unroll
    for (int i = 0; i < 8; ++i) { LAS float* p = scr + (kr + 8 * i) * 33 + 4 * c4; p[0] = v[i].x; p[1] = v[i].y; p[2] = v[i].z; p[3] = v[i].w; }
    LDS_WAIT(); asm volatile("" ::: "memory");
    const int c = lane & 7;
#pragma unroll
    for (int j = 0; j < 4; ++j) { const int n = (lane >> 3) + 8 * j; const LAS float* sp = scr + (8 * c) * 33 + n;
        u32x4 o; o.x = pk2(sp[0 * 33], sp[1 * 33]); o.y = pk2(sp[2 * 33], sp[3 * 33]); o.z = pk2(sp[4 * 33], sp[5 * 33]); o.w = pk2(sp[6 * 33], sp[7 * 33]);
        *(u32x4*)(d.dst + (size_t)n * d.ldk + 8 * c) = o; }
    LDS_WAIT(); asm volatile("" ::: "memory");
}
constexpr int P0_I_IN = (D_ / 64) * (NIN / 32);
constexpr int P0_NITEMS = (D_ / 64) * (NIN / 32) + (QR / 64) * (2048 / 32) + 2 * (AW / 64) * (D_ / 32) + (D_ / 64) * (D_ / 32) + (512 / 64) * (1024 / 32);
__device__ __forceinline__ void p0_transposes(const Ctx& C, const Args& a, const int ib, const int ie) {
    unsigned char* ws = a.ws;
    LAS float* scr = (LAS float*)(C.lds + C.wave * 16384);
    const int gw = C.wg * NWAVES + C.wave, NGW = C.G * NWAVES;
    f32x4 va[8], vb[8]; int it = ib + gw;
    P0Item da, db;
    if (it < ie) { da = p0_decode(a, ws, it, C.lane); p0_item_load(da, C.lane, va); }
    while (it < ie) {
        const int i1 = it + NGW; if (i1 < ie) { db = p0_decode(a, ws, i1, C.lane); p0_item_load(db, C.lane, vb); }
        p0_item_put(da, C.lane, va, scr);
        if (i1 >= ie) break;
        const int i2 = i1 + NGW; if (i2 < ie) { da = p0_decode(a, ws, i2, C.lane); p0_item_load(da, C.lane, va); }
        p0_item_put(db, C.lane, vb, scr);
        it = i2;
    }
}
__device__ __forceinline__ void p0_prep(const Ctx& C, const Args& a) {
    unsigned char* ws = a.ws;
    const int gw = C.wg * NWAVES + C.wave, NGW = C.G * NWAVES;
    p0_transposes(C, a, 0, P0_I_IN);
    f32x4 nw[8];
#pragma unroll
    for (int j = 0; j < 8; ++j) nw[j] = ((const f32x4*)a.norm_w)[C.lane + 64 * j];
    {
#define P0_HLOAD(vv, m_) do { const f32x4* xr_ = (const f32x4*)(a.x + (size_t)(m_) * D_) + C.lane; _Pragma("unroll") for (int j_ = 0; j_ < 8; ++j_) vv[j_] = __builtin_nontemporal_load(xr_ + 64 * j_); } while (0)
#define P0_HPUT(vv, m_) do { float s_ = 0.f; _Pragma("unroll") for (int j_ = 0; j_ < 8; ++j_) s_ += (vv[j_].x * vv[j_].x + vv[j_].y * vv[j_].y) + (vv[j_].z * vv[j_].z + vv[j_].w * vv[j_].w); \
            const float rs_ = rsqrtf(wave_sum(s_) * (1.f / D_) + EPS); u32x2* o8_ = (u32x2*)((bf16*)(ws + WS_H) + (size_t)(m_) * D_) + C.lane; \
            _Pragma("unroll") for (int j_ = 0; j_ < 8; ++j_) { const f32x4 w_ = nw[j_]; u32x2 o_; o_.x = pk2(vv[j_].x * rs_ * w_.x, vv[j_].y * rs_ * w_.y); o_.y = pk2(vv[j_].z * rs_ * w_.z, vv[j_].w * rs_ * w_.w); o8_[64 * j_] = o_; } } while (0)
        f32x4 va[8], vb[8]; int m = gw;
        if (m < S_) P0_HLOAD(va, m);
        while (m < S_) {
            const int m1 = m + NGW; if (m1 < S_) P0_HLOAD(vb, m1);
            P0_HPUT(va, m);
            if (m1 >= S_) break;
            const int m2 = m1 + NGW; if (m2 < S_) P0_HLOAD(va, m2);
            P0_HPUT(vb, m1);
            m = m2;
        }
#undef P0_HLOAD
#undef P0_HPUT
    }
    { const int g = C.wg * NTHR + C.tid; if (g < AW) { const float l0 = a.lb_table[g], l1 = a.lb_table[AW + g], mx = fmaxf(l0, l1), e0 = __expf(l0 - mx), e1 = __expf(l1 - mx); ((float*)(ws + WS_LB))[g] = e0 / (e0 + e1); } }

}

__device__ __forceinline__ void p1_side(const Ctx& C, const Args& a) {
    unsigned char* ws = a.ws;
    p0_transposes(C, a, P0_I_IN, P0_NITEMS);
    {
        bf16* WqT = (bf16*)(ws + WS_WQ);
        const int lane = C.lane, w = C.wave, fr = lane & 15, fq = lane >> 4, rt = w & 3, ct0 = 2 * (w >> 2);
        for (int it = C.wg; it < 256; it += C.G) {
            const int h = it >> 5, cb = (it >> 3) & 3, rb = it & 7, c0 = cb * 64, r0 = rb * 64;
            const float* ap = a.w_uq + (size_t)(r0 + 16 * rt + fr) * 1024 + h * 128 + 8 * fq;
            f32x4 av[4][2], bv[2][4][2];
#pragma unroll
            for (int ks = 0; ks < 4; ++ks) { av[ks][0] = *(const f32x4*)(ap + 32 * ks); av[ks][1] = *(const f32x4*)(ap + 32 * ks + 4); }
#pragma unroll
            for (int t = 0; t < 2; ++t) { const float* bp = a.w_ukv + (size_t)(c0 + 16 * (ct0 + t) + fr) * 2048 + h * 256 + 8 * fq;
#pragma unroll
                for (int ks = 0; ks < 4; ++ks) { bv[t][ks][0] = *(const f32x4*)(bp + 32 * ks); bv[t][ks][1] = *(const f32x4*)(bp + 32 * ks + 4); } }
#define FOLD_SPLIT(x0, x1, hi_, lo_) do { const unsigned h0_ = pk2(x0.x, x0.y), h1_ = pk2(x0.z, x0.w), h2_ = pk2(x1.x, x1.y), h3_ = pk2(x1.z, x1.w); \
                hi_ = (u32x4){h0_, h1_, h2_, h3_}; \
                lo_ = (u32x4){pk2(x0.x - bflo(h0_), x0.y - bfhi(h0_)), pk2(x0.z - bflo(h1_), x0.w - bfhi(h1_)), pk2(x1.x - bflo(h2_), x1.y - bfhi(h2_)), pk2(x1.z - bflo(h3_), x1.w - bfhi(h3_))}; } while (0)
            f32x4 acc[2] = {{0.f, 0.f, 0.f, 0.f}, {0.f, 0.f, 0.f, 0.f}};
#pragma unroll
            for (int ks = 0; ks < 4; ++ks) { u32x4 ahi, alo; FOLD_SPLIT(av[ks][0], av[ks][1], ahi, alo);
#pragma unroll
                for (int t = 0; t < 2; ++t) { u32x4 bhi, blo; FOLD_SPLIT(bv[t][ks][0], bv[t][ks][1], bhi, blo);
                    acc[t] = __builtin_amdgcn_mfma_f32_16x16x32_bf16(__builtin_bit_cast(bf16x8, ahi), __builtin_bit_cast(bf16x8, bhi), acc[t], 0, 0, 0);
                    acc[t] = __builtin_amdgcn_mfma_f32_16x16x32_bf16(__builtin_bit_cast(bf16x8, ahi), __builtin_bit_cast(bf16x8, blo), acc[t], 0, 0, 0);
                    acc[t] = __builtin_amdgcn_mfma_f32_16x16x32_bf16(__builtin_bit_cast(bf16x8, alo), __builtin_bit_cast(bf16x8, bhi), acc[t], 0, 0, 0); } }
#undef FOLD_SPLIT
#pragma unroll
            for (int t = 0; t < 2; ++t) { const float sc = 0.08838834764831845f; u32x2 o; o.x = pk2(acc[t][0] * sc, acc[t][1] * sc); o.y = pk2(acc[t][2] * sc, acc[t][3] * sc);
                *(u32x2*)(WqT + (size_t)(h * 256 + c0 + 16 * (ct0 + t) + fr) * QR + r0 + 16 * rt + 4 * fq) = o; }
        }
    }
    __syncthreads();
}

struct SchedPlain {
    pg8::TileOrder T; const char* Ab; const char* Bb; size_t tA, tB;
    __device__ __forceinline__ bool next(int i, pg8::Unit& u) const { u.sub = 0; return T.tile(i, u.pm, u.pn); }
    __device__ __forceinline__ const char* A(const pg8::Unit& u) const { return Ab + (size_t)u.pm * tA; }
    __device__ __forceinline__ const char* B(const pg8::Unit& u) const { return Bb + (size_t)u.pn * tB; }
    __device__ __forceinline__ bool keep(const pg8::Unit&) const { return false; }
};
#define EPI_FOREACH(...) \
    _Pragma("unroll") for (int ai = 0; ai < 2; ++ai) _Pragma("unroll") for (int m = 0; m < 4; ++m) { const int row = u.pm * 256 + ai * 128 + wr * 64 + m * 16 + fr; \
    _Pragma("unroll") for (int bj = 0; bj < 2; ++bj) { const int col = u.pn * 256 + bj * 128 + wc * 32 + 8 * fq; f32x4& v0 = acc[ai][bj][m][0]; f32x4& v1 = acc[ai][bj][m][1]; __VA_ARGS__ } }

struct EpiProj {
    unsigned char* ws;
    __device__ __forceinline__ void operator()(f32x4 (&acc)[2][2][4][2], const pg8::Unit& u, int wr, int wc, int fr, int fq) const {
        const int pn = u.pn;
        if (pn < 4) {
            bf16* O = (bf16*)(ws + WS_QA);
            EPI_FOREACH({ u32x4 w; const float s = 0.08838834764831845f; w.x = pk2(siluf_(v0[0]) * s, siluf_(v0[1]) * s); w.y = pk2(siluf_(v0[2]) * s, siluf_(v0[3]) * s); w.z = pk2(siluf_(v1[0]) * s, siluf_(v1[1]) * s); w.w = pk2(siluf_(v1[2]) * s, siluf_(v1[3]) * s);
                *(u32x4*)(O + (size_t)row * AW + col) = w; })
        } else if (pn < 8) {
            bf16* O = (bf16*)(ws + WS_G); const float* lb = (const float*)(ws + WS_LB);
            EPI_FOREACH({ const int c = col - 1024; const f32x4 l0 = *(const f32x4*)(lb + c), l1 = *(const f32x4*)(lb + c + 4); f32x4 o0, o1;
                _Pragma("unroll") for (int j = 0; j < 4; ++j) { o0[j] = 0.6931471805599453f * __builtin_amdgcn_logf(l0[j] + (1.f - l0[j]) * sigmoidf_(v0[j])); o1[j] = 0.6931471805599453f * __builtin_amdgcn_logf(l1[j] + (1.f - l1[j]) * sigmoidf_(v1[j])); }
                u32x4 w; w.x = pk2(o0[0], o0[1]); w.y = pk2(o0[2], o0[3]); w.z = pk2(o1[0], o1[1]); w.w = pk2(o1[2], o1[3]); *(u32x4*)(O + (size_t)row * AW + c) = w; })
        } else if (pn < 12) {
            bf16* O = (bf16*)(ws + WS_VA);
            EPI_FOREACH({ u32x4 w; w.x = pk2(v0[0], v0[1]); w.y = pk2(v0[2], v0[3]); w.z = pk2(v1[0], v1[1]); w.w = pk2(v1[2], v1[3]); *(u32x4*)(O + (size_t)row * AW + col - 2048) = w; })
        } else if (pn < 16 || (pn >= 20 && pn < 24)) {
            bf16* O = (bf16*)(ws + (pn < 16 ? WS_GA : WS_GB)); const int cb = pn < 16 ? 3072 : 5120;
            EPI_FOREACH({ u32x4 w; w.x = pk2(siluf_(v0[0]), siluf_(v0[1])); w.y = pk2(siluf_(v0[2]), siluf_(v0[3])); w.z = pk2(siluf_(v1[0]), siluf_(v1[1])); w.w = pk2(siluf_(v1[2]), siluf_(v1[3]));
                *(u32x4*)(O + (size_t)row * AW + col - cb) = w; })
        } else if (pn < 20) {
            float* O = (float*)(ws + WS_RAW);
            EPI_FOREACH({ *(f32x4*)(O + (size_t)row * 1024 + col - 4096) = v0; *(f32x4*)(O + (size_t)row * 1024 + col - 4096 + 4) = v1; })
        } else {
            bf16* O = (bf16*)(ws + (pn < 32 ? WS_SA : WS_SB)); const int cb = pn < 32 ? 6144 : 8192;
            EPI_FOREACH({ u32x4 w; w.x = pk2(sigmoidf_(v0[0]), sigmoidf_(v0[1])); w.y = pk2(sigmoidf_(v0[2]), sigmoidf_(v0[3])); w.z = pk2(sigmoidf_(v1[0]), sigmoidf_(v1[1])); w.w = pk2(sigmoidf_(v1[2]), sigmoidf_(v1[3]));
                *(u32x4*)(O + (size_t)row * D_ + col - cb) = w; })
        }
    }
};

__device__ __forceinline__ void p2_norms(const Ctx& C, const Args& a) {
    unsigned char* ws = a.ws;
    const int gw = C.wg * NWAVES + C.wave, NGW = C.G * NWAVES, lane = C.lane;
    const float* RAW = (const float*)(ws + WS_RAW);
    const f32x4 qw0 = *(const f32x4*)(a.q_norm_w + 4 * lane), qw1 = *(const f32x4*)(a.q_norm_w + 256 + 4 * lane), kvw = *(const f32x4*)(a.kv_norm_w + 4 * lane);
    const f32x2 kiw = *(const f32x2*)(a.kidx_norm_w + 2 * lane), kib = *(const f32x2*)(a.kidx_norm_b + 2 * lane);
    for (int t = gw; t < S_; t += NGW) {
        const float* r = RAW + (size_t)t * 1024;
        { const f32x4 v0 = *(const f32x4*)(r + 4 * lane), v1 = *(const f32x4*)(r + 256 + 4 * lane);
          const float ss = wave_sum((v0.x * v0.x + v0.y * v0.y) + (v0.z * v0.z + v0.w * v0.w) + (v1.x * v1.x + v1.y * v1.y) + (v1.z * v1.z + v1.w * v1.w));
          const float rs = rsqrtf(ss * (1.f / QR) + EPS);
          const f32x4 w0 = qw0, w1 = qw1;
          bf16* o = (bf16*)(ws + WS_CQN) + (size_t)t * QR;
          u32x2 p0, p1; p0.x = pk2(v0.x * rs * w0.x, v0.y * rs * w0.y); p0.y = pk2(v0.z * rs * w0.z, v0.w * rs * w0.w); p1.x = pk2(v1.x * rs * w1.x, v1.y * rs * w1.y); p1.y = pk2(v1.z * rs * w1.z, v1.w * rs * w1.w);
          *(u32x2*)(o + 4 * lane) = p0; *(u32x2*)(o + 256 + 4 * lane) = p1; }
        { const f32x4 v0 = *(const f32x4*)(r + 512 + 4 * lane);
          const float ss = wave_sum((v0.x * v0.x + v0.y * v0.y) + (v0.z * v0.z + v0.w * v0.w));
          const float rs = rsqrtf(ss * (1.f / KVR) + EPS);
          const f32x4 w0 = kvw;
          u32x2 p0; p0.x = pk2(v0.x * rs * w0.x, v0.y * rs * w0.y); p0.y = pk2(v0.z * rs * w0.z, v0.w * rs * w0.w);
          *(u32x2*)((bf16*)(ws + WS_CKVN) + (size_t)t * KVR + 4 * lane) = p0; }
        { const f32x2 v = *(const f32x2*)(r + 768 + 2 * lane);
          const float mu = wave_sum(v.x + v.y) * (1.f / IDXD); const float d0 = v.x - mu, d1 = v.y - mu;
          const float var = wave_sum(d0 * d0 + d1 * d1) * (1.f / IDXD); const float rs = rsqrtf(var + EPS);
          const f32x2 w = kiw, b = kib;
          *(unsigned*)((bf16*)(ws + WS_KIDX) + (size_t)t * IDXD + 2 * lane) = pk2(d0 * rs * w.x + b.x, d1 * rs * w.y + b.y); }
        if (lane < IDXH) ((float*)(ws + WS_WIDX))[(size_t)t * IDXH + lane] = r[896 + lane] * 0.02209708691207961f;
    }
}
constexpr int R64 = 144, R128 = 272;
__device__ __forceinline__ void p2_hgrn_states(const Ctx& C, const Args& a, bf16* UT) {
    unsigned char* ws = a.ws;
    const bf16* G = (const bf16*)(ws + WS_G); const bf16* VA = (const bf16*)(ws + WS_VA); float* DL = (float*)(ws + WS_DLAST);
    LAS unsigned char* kdT = C.lds;
    LAS unsigned char* vT = C.lds + 128 * R64;
    LAS float* segtot = (LAS float*)(C.lds + 2 * 128 * R64);
    const int tid = C.tid, lane = C.lane, w = C.wave;
    for (int it = C.wg; it < NCH * BH; it += C.G) {
        const int c = it >> 3, h = it & 7;
        const int k = tid & 127, seg = tid >> 7, t0 = c * CHUNK + seg * 16;
        float g[16], cum[16]; float run = 0.f;
#pragma unroll
        for (int i = 0; i < 16; ++i) { g[i] = bf2f(G[(size_t)(t0 + i) * AW + h * 128 + k]); run += g[i]; cum[i] = run; }
        segtot[seg * 128 + k] = run;
        unsigned short vv[16];
#pragma unroll
        for (int i = 0; i < 16; ++i) vv[i] = VA[(size_t)(t0 + i) * AW + h * 128 + k];
        __syncthreads();
        float pre = 0.f, last = 0.f;
#pragma unroll
        for (int s2 = 0; s2 < 4; ++s2) { const float st = segtot[s2 * 128 + k]; if (s2 < seg) pre += st; last += st; }
        unsigned kd[8], vp[8];
#pragma unroll
        for (int i = 0; i < 8; ++i) {
            const float c0 = cum[2 * i] + pre, c1 = cum[2 * i + 1] + pre;
            const float k0 = (1.f - __expf(g[2 * i])) * __expf(last - c0), k1 = (1.f - __expf(g[2 * i + 1])) * __expf(last - c1);
            kd[i] = pk2(k0, k1); vp[i] = (unsigned)vv[2 * i] | ((unsigned)vv[2 * i + 1] << 16);
        }
        *(LAS u32x4*)(kdT + k * R64 + seg * 32) = (u32x4){kd[0], kd[1], kd[2], kd[3]}; *(LAS u32x4*)(kdT + k * R64 + seg * 32 + 16) = (u32x4){kd[4], kd[5], kd[6], kd[7]};
        *(LAS u32x4*)(vT + k * R64 + seg * 32) = (u32x4){vp[0], vp[1], vp[2], vp[3]}; *(LAS u32x4*)(vT + k * R64 + seg * 32 + 16) = (u32x4){vp[4], vp[5], vp[6], vp[7]};
        if (seg == 0) DL[(size_t)it * 128 + k] = __expf(last);
        __syncthreads();
        f32x4 acc[4][2];
#pragma unroll
        for (int kt = 0; kt < 4; ++kt)
#pragma unroll
            for (int vi = 0; vi < 2; ++vi) acc[kt][vi] = (f32x4){0.f, 0.f, 0.f, 0.f};
        const int fr = lane & 15, fq = lane >> 4;
#pragma unroll
        for (int ks = 0; ks < 2; ++ks) {
            bf16x8 kf[4], vf[2];
#pragma unroll
            for (int kt = 0; kt < 4; ++kt) { const int kr = 64 * (w & 1) + 32 * (kt >> 1) + 8 * (fr >> 2) + 4 * (kt & 1) + (fr & 3);
                kf[kt] = *(const LAS bf16x8*)(kdT + kr * R64 + (32 * ks + 8 * fq) * 2); }
#pragma unroll
            for (int vi = 0; vi < 2; ++vi) vf[vi] = *(const LAS bf16x8*)(vT + (32 * (w >> 1) + 16 * vi + fr) * R64 + (32 * ks + 8 * fq) * 2);
#pragma unroll
            for (int kt = 0; kt < 4; ++kt)
#pragma unroll
                for (int vi = 0; vi < 2; ++vi) acc[kt][vi] = __builtin_amdgcn_mfma_f32_16x16x32_bf16(kf[kt], vf[vi], acc[kt][vi], 0, 0, 0);
        }
        bf16* U = UT + (size_t)it * 16384;
#pragma unroll
        for (int vi = 0; vi < 2; ++vi)
#pragma unroll
            for (int t = 0; t < 2; ++t) { const f32x4 x0 = acc[2 * t][vi], x1 = acc[2 * t + 1][vi];
                const u32x4 o = {pk2(x0[0], x0[1]), pk2(x0[2], x0[3]), pk2(x1[0], x1[1]), pk2(x1[2], x1[3])};
                *(u32x4*)(U + (size_t)(32 * (w >> 1) + 16 * vi + fr) * 128 + 64 * (w & 1) + 32 * t + 8 * fq) = o; }
        __syncthreads();
    }
}

struct EpiQ {
    unsigned char* ws;
    __device__ __forceinline__ void operator()(f32x4 (&acc)[2][2][4][2], const pg8::Unit& u, int wr, int wc, int fr, int fq) const {
        bf16* O = (bf16*)(ws + (u.pn < 8 ? WS_QABS : WS_RAW)); const int cb = u.pn < 8 ? 0 : 2048;
        EPI_FOREACH({ u32x4 w; w.x = pk2(v0[0], v0[1]); w.y = pk2(v0[2], v0[3]); w.z = pk2(v1[0], v1[1]); w.w = pk2(v1[2], v1[3]); *(u32x4*)(O + (size_t)row * 2048 + col - cb) = w; })
    }
};
__device__ __forceinline__ void p3_scan(const Ctx& C, const Args& a, const bf16* UT) {
    unsigned char* ws = a.ws;
    const float* DL = (const float*)(ws + WS_DLAST); bf16* SPT = (bf16*)(ws + WS_SPT);
    for (int e = C.wg * NTHR + C.tid; e < BH * 128 * 128; e += C.G * NTHR) {
        const int h = e >> 14, k = e & 127;
        float Sv = 0.f;
        for (int c0 = 0; c0 < NCH; c0 += 16) {
            float u[16], d[16];
#pragma unroll
            for (int j = 0; j < 16; ++j) { u[j] = bf2f(UT[(size_t)(c0 + j) * (BH * 16384) + e]); d[j] = DL[(size_t)((c0 + j) * BH + h) * 128 + k]; }
#pragma unroll
            for (int j = 0; j < 16; ++j) { SPT[(size_t)(c0 + j) * (BH * 16384) + e] = (bf16)f2bf(Sv); Sv = d[j] * Sv + u[j]; }
        }
    }
}

__device__ __forceinline__ int t5_bucket(int rel) {
    const int n = rel < 0 ? -rel : rel; int b = rel > 0 ? 16 : 0;
    const int large = n < 12 ? 8 : n < 16 ? 9 : n < 23 ? 10 : n < 32 ? 11 : n < 46 ? 12 : n < 64 ? 13 : n < 91 ? 14 : 15;
    return b + (n < 8 ? n : large);
}
__device__ __forceinline__ int swz_sigma(int r) { return ((r & 3) << 1) | ((((r >> 3) ^ (r >> 2)) & 1) << 3) | ((r >> 2) & 1); }
__device__ __forceinline__ int lat_off(int row, int c) { return row * 512 + ((((c & 15) ^ swz_sigma(row & 15)) | (c & 16)) << 4); }
constexpr int AT_SIDX = 131072, AT_BIAS = 139264;
__device__ __forceinline__ void attn_setup(const Ctx& C, const Args& a) {
    LAS float* bias2 = (LAS float*)(C.lds + AT_BIAS);
    for (int e = C.tid; e < 2 * 92 * 8; e += NTHR) { const int sg = e / (92 * 8), nn = (e / 8) % 92, h = e & 7; bias2[e] = a.rel_bias[t5_bucket(sg ? nn : -nn) * BH + h]; }
    __syncthreads();
}
__device__ __forceinline__ void attn_one(const Ctx& C, const Args& a, const int t, const int n) {
    unsigned char* ws = a.ws;
    const bf16* QABS = (const bf16*)(ws + WS_QABS); const char* CKVNb = (const char*)(ws + WS_CKVN);
    bf16* OL = (bf16*)(ws + WS_RAW);
    int lane = C.lane; asm volatile("" : "+v"(lane));
    const int w = C.wave, fr = lane & 15, fq = lane >> 4;
    LAS unsigned char* L = C.lds + w * 16384;
    const LAS int* sidx = (const LAS int*)(C.lds + AT_SIDX) + w * 256;
    const LAS float* bias2 = (const LAS float*)(C.lds + AT_BIAS);
    const int q4 = fr >> 2, p4 = fr & 3;
    unsigned aqk[4], apv[8];
    { const int s = swz_sigma(fr); const unsigned b0 = (unsigned)(fr * 512 + 16 * (fq ^ (s & 3))) | (unsigned)(64 * (s >> 2));
#pragma unroll
      for (int k = 0; k < 4; ++k) aqk[k] = (unsigned)(size_t)L + (b0 ^ (unsigned)(64 * k)); }
    { const int rr = 4 * fq + q4, s = swz_sigma(rr & 15); const unsigned b0 = (unsigned)(rr * 512 + 16 * ((p4 >> 1) ^ (s & 1)) + 8 * (p4 & 1)) | (unsigned)(32 * (s >> 1));
#pragma unroll
      for (int k = 0; k < 8; ++k) apv[k] = (unsigned)(size_t)L + (b0 ^ (unsigned)(32 * k)); }
    unsigned c16[16];
#pragma unroll
    for (int i = 0; i < 16; ++i) { const int row = 2 * i + (lane >> 5), pos = lane & 31; c16[i] = (unsigned)(((pos & 16) | ((pos & 15) ^ swz_sigma(row & 15))) << 4); }
    {
        bf16x8 qf[8];
#pragma unroll
        for (int ks = 0; ks < 8; ++ks) { if (fr < BH) qf[ks] = *(const bf16x8*)(QABS + (size_t)t * 2048 + fr * 256 + 32 * ks + 8 * fq); else qf[ks] = (bf16x8){0, 0, 0, 0, 0, 0, 0, 0}; }
        f32x4 oa[16];
#pragma unroll
        for (int i = 0; i < 16; ++i) oa[i] = (f32x4){0.f, 0.f, 0.f, 0.f};
        float m_run = -INFINITY, l_run = 0.f;
        LDS_WAIT();
#define AT_GATHER(sj_) do { _Pragma("unroll") for (int i_ = 0; i_ < 16; ++i_) \
            __builtin_amdgcn_global_load_lds((const unsigned*)(CKVNb + (unsigned)(sj_[i_] * 512 + (int)c16[i_])), (LAS unsigned*)(L + i_ * 1024), 16, 0, 0); } while (0)
        { int sj0[16];
#pragma unroll
          for (int i = 0; i < 16; ++i) sj0[i] = sidx[2 * i + (lane >> 5)];
          AT_GATHER(sj0); }
        for (int ch = 0; ch * 32 < n; ++ch) {
            const bool more = 32 * (ch + 1) < n;
            const u32x4 s0 = *(const LAS u32x4*)(sidx + 32 * ch + 4 * fq), s1 = *(const LAS u32x4*)(sidx + 32 * ch + 16 + 4 * fq);
            float bv[2][4];
#pragma unroll
            for (int T = 0; T < 2; ++T)
#pragma unroll
                for (int r = 0; r < 4; ++r) { const int rel = (int)(T ? s1[r] : s0[r]) - t; const int nn = rel < 0 ? -rel : rel; bv[T][r] = bias2[((rel > 0 ? 92 : 0) + (nn < 91 ? nn : 91)) * 8 + (fr & 7)]; }
            VM_WAIT();
            f32x4 lg[2] = {{0.f, 0.f, 0.f, 0.f}, {0.f, 0.f, 0.f, 0.f}};
            {
                u32x4 kf[8][2];
#define AT_KRD(ks) do { _Pragma("unroll") for (int T = 0; T < 2; ++T) asm volatile("ds_read_b128 %0, %1 offset:%2" : "=v"(kf[ks][T]) : "v"(aqk[(ks) & 3]), "n"(256 * ((ks) >> 2) + 8192 * T)); } while (0)
                AT_KRD(0); AT_KRD(1); AT_KRD(2); AT_KRD(3); AT_KRD(4); AT_KRD(5);
                asm volatile("s_waitcnt lgkmcnt(4)" : "+v"(kf[0][0]), "+v"(kf[0][1]), "+v"(kf[1][0]), "+v"(kf[1][1]), "+v"(kf[2][0]), "+v"(kf[2][1]), "+v"(kf[3][0]), "+v"(kf[3][1]));
                AT_KRD(6); AT_KRD(7);
#undef AT_KRD
#pragma unroll
                for (int ks = 0; ks < 4; ++ks)
#pragma unroll
                    for (int T = 0; T < 2; ++T) lg[T] = __builtin_amdgcn_mfma_f32_16x16x32_bf16(__builtin_bit_cast(bf16x8, kf[ks][T]), qf[ks], lg[T], 0, 0, 0);
                asm volatile("s_waitcnt lgkmcnt(0)" : "+v"(kf[4][0]), "+v"(kf[4][1]), "+v"(kf[5][0]), "+v"(kf[5][1]), "+v"(kf[6][0]), "+v"(kf[6][1]), "+v"(kf[7][0]), "+v"(kf[7][1]));
#pragma unroll
                for (int ks = 4; ks < 8; ++ks)
#pragma unroll
                    for (int T = 0; T < 2; ++T) lg[T] = __builtin_amdgcn_mfma_f32_16x16x32_bf16(__builtin_bit_cast(bf16x8, kf[ks][T]), qf[ks], lg[T], 0, 0, 0);
            }
            int sjn[16];
#pragma unroll
            for (int i = 0; i < 16; ++i) sjn[i] = sidx[(more ? 32 * (ch + 1) : 0) + 2 * i + (lane >> 5)];
            u32x2 lo[16], hi[16];
#define AT_VRD(ct) do { asm volatile("ds_read_b64_tr_b16 %0, %1 offset:%2" : "=v"(lo[ct]) : "v"(apv[(ct) & 7]), "n"(256 * ((ct) >> 3))); \
                        asm volatile("ds_read_b64_tr_b16 %0, %1 offset:%2" : "=v"(hi[ct]) : "v"(apv[(ct) & 7]), "n"(256 * ((ct) >> 3) + 8192)); } while (0)
#define AT_VWAIT(g, cnt) asm volatile("s_waitcnt lgkmcnt(" #cnt ")" : "+v"(lo[4 * (g)]), "+v"(hi[4 * (g)]), "+v"(lo[4 * (g) + 1]), "+v"(hi[4 * (g) + 1]), "+v"(lo[4 * (g) + 2]), "+v"(hi[4 * (g) + 2]), "+v"(lo[4 * (g) + 3]), "+v"(hi[4 * (g) + 3]))
            AT_VRD(0); AT_VRD(1); AT_VRD(2); AT_VRD(3); AT_VRD(4); AT_VRD(5);
            AT_VWAIT(0, 4); AT_VRD(6); AT_VRD(7); AT_VRD(8); AT_VRD(9);
            AT_VWAIT(1, 4); AT_VRD(10); AT_VRD(11); AT_VRD(12); AT_VRD(13);
            AT_VWAIT(2, 4); AT_VRD(14); AT_VRD(15);
            AT_VWAIT(3, 0);
            asm volatile("" ::: "memory");
            if (more) AT_GATHER(sjn);
#undef AT_VRD
#undef AT_VWAIT
            float mx = -INFINITY;
#pragma unroll
            for (int T = 0; T < 2; ++T)
#pragma unroll
                for (int r = 0; r < 4; ++r) { const int j = 32 * ch + 16 * T + 4 * fq + r; float v = lg[T][r] + bv[T][r];
                    v = (j < n) ? v : -INFINITY; lg[T][r] = v; mx = fmaxf(mx, v); }
            mx = rows_max(mx);
            const float m_new = fmaxf(m_run, mx), scale = __expf(m_run - m_new);
            float sm = 0.f;
#pragma unroll
            for (int T = 0; T < 2; ++T)
#pragma unroll
                for (int r = 0; r < 4; ++r) { const float p = __expf(lg[T][r] - m_new); lg[T][r] = p; sm += p; }
            l_run = l_run * scale + sm; m_run = m_new;
            bf16x8 pf; { const unsigned w0 = pk2(lg[0][0], lg[0][1]), w1 = pk2(lg[0][2], lg[0][3]), w2 = pk2(lg[1][0], lg[1][1]), w3 = pk2(lg[1][2], lg[1][3]);
                pf = __builtin_bit_cast(bf16x8, (u32x4){w0, w1, w2, w3}); }
            if (__any(scale != 1.f)) {
#pragma unroll
                for (int ct = 0; ct < 16; ++ct) oa[ct] *= scale; }
            {
#pragma unroll
                for (int c4 = 0; c4 < 16; ++c4) { const u32x4 cw = {lo[c4].x, lo[c4].y, hi[c4].x, hi[c4].y};
                    oa[c4] = __builtin_amdgcn_mfma_f32_16x16x32_bf16(__builtin_bit_cast(bf16x8, cw), pf, oa[c4], 0, 0, 0); }
            }
        }
#undef AT_GATHER
        l_run = rows_sum(l_run);
        { const float inv = __builtin_amdgcn_rcpf(l_run); bf16* o = OL + (size_t)t * 2048 + (fr & 7) * 256 + (fq & 1) * 16 + (fq >> 1) * 8;
#pragma unroll
          for (int p = 0; p < 8; ++p) {
              unsigned a0 = pk2(oa[2 * p][0] * inv, oa[2 * p][1] * inv), a1 = pk2(oa[2 * p][2] * inv, oa[2 * p][3] * inv);
              unsigned b0 = pk2(oa[2 * p + 1][0] * inv, oa[2 * p + 1][1] * inv), b1 = pk2(oa[2 * p + 1][2] * inv, oa[2 * p + 1][3] * inv);
              { const auto r = __builtin_amdgcn_permlane16_swap(a0, b0, false, false); a0 = r[0]; b0 = r[1]; }
              { const auto r = __builtin_amdgcn_permlane16_swap(a1, b1, false, false); a1 = r[0]; b1 = r[1]; }
              if (fr < BH) *(u32x4*)(o + 32 * p) = (u32x4){a0, a1, b0, b1}; } }
    }
}

__device__ __forceinline__ unsigned fkey(float f) { const unsigned u = __builtin_bit_cast(unsigned, f); return (u & 0x80000000u) ? ~u : (u | 0x80000000u); }
__device__ __forceinline__ void lds_add_u32(LAS unsigned* p, unsigned v) { asm volatile("ds_add_u32 %0, %1" :: "v"((unsigned)(size_t)p), "v"(v) : "memory"); }
constexpr int IX_KBUF = 65536, IX_CAP = 512;
__device__ __noinline__ void select_slow(const float* sc, int nvis, LAS int* idxrow, LAS unsigned* hist, int lane) {
    unsigned prefix = 0u; int need = TOPK;
#pragma unroll 1
    for (int pass = 0; pass < 4; ++pass) {
        const int shift = 24 - 8 * pass;
#pragma unroll
        for (int j = 0; j < 4; ++j) hist[lane * 4 + j] = 0u;
        LDS_WAIT();
        const unsigned himask = pass == 0 ? 0u : (0xffffffffu << (shift + 8));
        for (int i = lane; i < nvis; i += 64) { const unsigned kk = fkey(sc[i]); if ((kk & himask) == (prefix & himask)) __hip_atomic_fetch_add(&hist[(kk >> shift) & 255u], 1u, __ATOMIC_RELAXED, __HIP_MEMORY_SCOPE_WORKGROUP); }
        LDS_WAIT();
        unsigned cnt[4]; unsigned tl = 0u;
#pragma unroll
        for (int j = 0; j < 4; ++j) { cnt[j] = hist[lane * 4 + j]; tl += cnt[j]; }
        unsigned incl = tl;
#pragma unroll
        for (int o = 1; o < 64; o <<= 1) { const unsigned v = __shfl_down(incl, o); if (lane + o < 64) incl += v; }
        unsigned above = incl - tl;
        int dsel = -1; unsigned asel = 0u;
#pragma unroll
        for (int j = 3; j >= 0; --j) { if (dsel < 0 && above < (unsigned)need && above + cnt[j] >= (unsigned)need) { dsel = lane * 4 + j; asel = above; } above += cnt[j]; }
        const unsigned long long bal = __ballot(dsel >= 0);
        const int src = __ffsll((long long)bal) - 1;
        const int d = __shfl(dsel, src); const unsigned ab = __shfl(asel, src);
        need -= (int)ab; prefix |= ((unsigned)d) << shift;
    }
    int base = 0, eqseen = 0;
    for (int i0 = 0; i0 < nvis; i0 += 64) {
        const int i = i0 + lane; const unsigned kk = fkey(sc[i]);
        const bool gt = kk > prefix, eq = kk == prefix;
        const unsigned long long beq = __ballot(eq);
        const unsigned long long lt_mask = (1ull << lane) - 1ull;
        const int eqrank = eqseen + __popcll(beq & lt_mask);
        const bool sel = gt || (eq && eqrank < need);
        const unsigned long long bs = __ballot(sel);
        if (sel) idxrow[base + __popcll(bs & lt_mask)] = i;
        base += __popcll(bs); eqseen += __popcll(beq);
    }
}
__device__ __forceinline__ void p4_indexer(const Ctx& C, const Args& a, float* SCall, unsigned* qc, volatile LAS unsigned* MISC, int& cur) {
    unsigned char* ws = a.ws;
    const bf16* QIDX = (const bf16*)(ws + WS_RAW); const char* KIDXb = (const char*)(ws + WS_KIDX); const float* WIDX = (const float*)(ws + WS_WIDX);
    LAS int* sidx = (LAS int*)(C.lds + AT_SIDX) + C.wave * 256;
    float* SC = SCall + (size_t)C.wg * (8 * 8192);
    LAS unsigned* HIST = (LAS unsigned*)C.lds;
    LAS unsigned char* KBUF = C.lds + 8192;
    const int tid = C.tid, w = C.wave, quad = w & 1, kg = w >> 1;
    bf16x8 af[4][4]; u32x4 wA[2][2];
#define IX_PREP(q0_) do { \
        _Pragma("unroll") for (int j_ = 0; j_ < 4; ++j_) { const bf16* qp_ = QIDX + (size_t)((q0_) + 4 * quad + j_) * 2048 + r16 * 128 + 8 * kq; \
            _Pragma("unroll") for (int ks_ = 0; ks_ < 4; ++ks_) af[j_][ks_] = *(const bf16x8*)(qp_ + 32 * ks_); } \
        { const int grp_ = r16 >> 2, mem_ = r16 & 3;             \
          const f32x4 wv_ = mem_ < 2 ? *(const f32x4*)(WIDX + (size_t)((q0_) + 4 * quad + 2 * (grp_ & 1) + mem_) * IDXH + 4 * kq) : (f32x4){0.f, 0.f, 0.f, 0.f}; \
          const unsigned w01_ = pk2(wv_[0], wv_[1]), w23_ = pk2(wv_[2], wv_[3]); \
          _Pragma("unroll") for (int p_ = 0; p_ < 2; ++p_) _Pragma("unroll") for (int T_ = 0; T_ < 2; ++T_) { const bool on_ = (grp_ == 2 * T_ + p_) && mem_ < 2; \
                  wA[p_][T_] = (u32x4){(on_ && mem_ == 0) ? w01_ : 0u, (on_ && mem_ == 0) ? w23_ : 0u, (on_ && mem_ == 1) ? w01_ : 0u, (on_ && mem_ == 1) ? w23_ : 0u}; } } \
        _Pragma("unroll") for (int i_ = 0; i_ < 8; ++i_) ((LAS u32x4*)(HIST + w * 4096))[lane + 64 * i_] = (u32x4){0u, 0u, 0u, 0u};        \
    } while (0)
    {
        int lane = C.lane; asm volatile("" : "+v"(lane)); const int r16 = lane & 15, kq = lane >> 4; const int q0f = (1023 - cur) * 8;
        if (cur < 1024 && ((q0f >> 6) + 1) * CHUNK > TOPK) IX_PREP(q0f);
    }
    while (cur < 1024) {
        int lane = C.lane; asm volatile("" : "+v"(lane));
        const int r16 = lane & 15, kq = lane >> 4;
        const int tile = 1023 - cur;
        const int q0 = tile * 8, nvis = ((q0 >> 6) + 1) * CHUNK;
        if (nvis <= TOPK) {
            for (int j = lane; j < TOPK; j += 64) sidx[j] = j < nvis ? j : 0;
            LDS_WAIT(); __syncthreads();
            unsigned nxt = 0u; if (tid == 0) nxt = xb_add(qc, 1u) + (unsigned)C.G;
            attn_one(C, a, q0 + w, nvis);
            if (tid == 0) MISC[MISC_Q4] = nxt;
            LDS_WAIT(); __syncthreads();
            cur = __builtin_amdgcn_readfirstlane((int)MISC[MISC_Q4]);
#pragma unroll
            for (int j_ = 0; j_ < 4; ++j_)
#pragma unroll
                for (int ks_ = 0; ks_ < 4; ++ks_) asm volatile("" : "=v"(af[j_][ks_]));
#pragma unroll
            for (int p_ = 0; p_ < 2; ++p_)
#pragma unroll
                for (int T_ = 0; T_ < 2; ++T_) asm volatile("" : "=v"(wA[p_][T_]));
            continue;
        }
        unsigned nxt = 0u; if (tid == 0) nxt = xb_add(qc, 1u) + (unsigned)C.G;
        const int ntile = nvis >> 5, nstep = (ntile + 3) >> 2;
        const unsigned soffA = (unsigned)((16 * quad + (lane >> 4)) * 256 + (((lane & 15) ^ (lane >> 4)) << 4));
#define IX_STAGE(step_, buf_) do { const int kt_ = 4 * (step_) + kg; if (kt_ < ntile) { const char* sb_ = KIDXb + (size_t)kt_ * 8192; unsigned so_ = soffA; asm volatile("" : "+v"(so_));   \
            _Pragma("unroll") for (int i_ = 0; i_ < 4; ++i_) { \
            __builtin_amdgcn_global_load_lds((const unsigned*)(sb_ + ((so_ ^ (unsigned)(64 * i_)) + (unsigned)(1024 * i_))), (LAS unsigned*)(KBUF + (4 * (buf_) + kg) * 16384 + (4 * quad + i_) * 1024), 16, 0, 0); } } } while (0)
        const unsigned flane = (unsigned)((4 * quad + 2 * (kq & 1)) * 8192 + 16 * (kq >> 1) + r16);
        LAS unsigned* const hlane = HIST + (4 * quad + 2 * (kq & 1)) * 4096;
#define IX_FLUSH(yv, kt_) do { if ((kt_) < ntile) { _Pragma("unroll") for (int j = 0; j < 2; ++j) { float* scb_ = SC + (size_t)((kt_) * 32 + j * 8192); scb_[flane] = yv[j]; \
            const unsigned bin = fkey(yv[j]) >> 20; lds_add_u32(hlane + j * 4096 + (bin >> 1), 1u << (16 * (bin & 1u))); } } } while (0)
        u32x4 bfr[2][4]; f32x4 acc[4][2];
#define IX_READS(step_) do { const unsigned tb_ = (unsigned)(size_t)(KBUF + (4 * ((step_) & 1) + kg) * 16384) + (unsigned)(r16 * 256 + ((kq ^ r16) << 4));   \
            _Pragma("unroll") for (int ks_ = 0; ks_ < 4; ++ks_) _Pragma("unroll") for (int T_ = 0; T_ < 2; ++T_) \
                asm volatile("ds_read_b128 %0, %1 offset:%2" : "=v"(bfr[T_][ks_]) : "v"(tb_ ^ (unsigned)(64 * ks_)), "n"(4096 * T_)); } while (0)
#define IX_MFMA1() do { _Pragma("unroll") for (int j_ = 0; j_ < 4; ++j_) _Pragma("unroll") for (int T_ = 0; T_ < 2; ++T_) acc[j_][T_] = (f32x4){0.f, 0.f, 0.f, 0.f}; \
            asm volatile("s_waitcnt lgkmcnt(4)\n\ts_setprio 1" : "+v"(bfr[0][0]), "+v"(bfr[1][0]), "+v"(bfr[0][1]), "+v"(bfr[1][1])); \
            _Pragma("unroll") for (int ks_ = 0; ks_ < 2; ++ks_) _Pragma("unroll") for (int j_ = 0; j_ < 4; ++j_) _Pragma("unroll") for (int T_ = 0; T_ < 2; ++T_) \
                acc[j_][T_] = __builtin_amdgcn_mfma_f32_16x16x32_bf16(af[j_][ks_], __builtin_bit_cast(bf16x8, bfr[T_][ks_]), acc[j_][T_], 0, 0, 0); \
            asm volatile("s_waitcnt lgkmcnt(0)" : "+v"(bfr[0][2]), "+v"(bfr[1][2]), "+v"(bfr[0][3]), "+v"(bfr[1][3])); \
            _Pragma("unroll") for (int ks_ = 2; ks_ < 4; ++ks_) _Pragma("unroll") for (int j_ = 0; j_ < 4; ++j_) _Pragma("unroll") for (int T_ = 0; T_ < 2; ++T_) \
                acc[j_][T_] = __builtin_amdgcn_mfma_f32_16x16x32_bf16(af[j_][ks_], __builtin_bit_cast(bf16x8, bfr[T_][ks_]), acc[j_][T_], 0, 0, 0); } while (0)
#define IX_TAIL(yv_) do { f32x4 y_ = {0.f, 0.f, 0.f, 0.f}; \
            _Pragma("unroll") for (int p_ = 0; p_ < 2; ++p_) _Pragma("unroll") for (int T_ = 0; T_ < 2; ++T_) { const f32x4 xa_ = acc[2 * p_][T_], xb_ = acc[2 * p_ + 1][T_]; \
                const u32x4 fr4_ = {pk2_relu(xa_.x, xa_.y), pk2_relu(xa_.z, xa_.w), pk2_relu(xb_.x, xb_.y), pk2_relu(xb_.z, xb_.w)}; \
                y_ = __builtin_amdgcn_mfma_f32_16x16x32_bf16(__builtin_bit_cast(bf16x8, wA[p_][T_]), __builtin_bit_cast(bf16x8, fr4_), y_, 0, 0, 0); } \
            yv_[0] = y_.x; yv_[1] = y_.y; } while (0)
#define IX_ACC_OPS "+v"(acc[0][0]), "+v"(acc[0][1]), "+v"(acc[1][0]), "+v"(acc[1][1]), "+v"(acc[2][0]), "+v"(acc[2][1]), "+v"(acc[3][0]), "+v"(acc[3][1])
        IX_STAGE(0, 0);
        VM_WAIT(); if (tid == 0) MISC[MISC_Q4] = nxt; LDS_WAIT(); __builtin_amdgcn_s_barrier();
        if (nstep > 1) IX_STAGE(1, 1);
        float yp[2] = {0.f, 0.f};
        if (w < 4) {
            for (int step = 0; step < nstep; ++step) {
                IX_READS(step);
                if (step > 0) IX_FLUSH(yp, 4 * (step - 1) + kg);
                if (step > 0 && step + 1 < nstep) IX_STAGE(step + 1, (step + 1) & 1);
                IX_MFMA1();
                asm volatile("s_setprio 0\n\ts_waitcnt lgkmcnt(0)\n\ts_barrier" : IX_ACC_OPS :: "memory");
                IX_TAIL(yp);
                asm volatile("s_waitcnt vmcnt(0) lgkmcnt(0)\n\ts_barrier" : "+v"(yp[0]), "+v"(yp[1]) :: "memory");
            }
            IX_FLUSH(yp, 4 * (nstep - 1) + kg);
        } else {
            for (int step = 0; step < nstep; ++step) {
                if (step > 0) { IX_TAIL(yp); IX_FLUSH(yp, 4 * (step - 1) + kg); }
                if (step > 0 && step + 1 < nstep) IX_STAGE(step + 1, (step + 1) & 1);
                IX_READS(step);
                asm volatile("s_barrier" ::: "memory");
                IX_MFMA1();
                asm volatile("s_setprio 0\n\ts_waitcnt vmcnt(0) lgkmcnt(0)\n\ts_barrier" : IX_ACC_OPS :: "memory");
            }
            IX_TAIL(yp); IX_FLUSH(yp, 4 * (nstep - 1) + kg);
        }
        VM_WAIT(); LDS_WAIT();
        __builtin_amdgcn_s_barrier();
#undef IX_READS
        const int ncur = __builtin_amdgcn_readfirstlane((int)MISC[MISC_Q4]);
#undef IX_MFMA1
#undef IX_TAIL
#undef IX_ACC_OPS
#undef IX_STAGE
#undef IX_FLUSH
        for (int rep_q = 0; rep_q < (PROBE_REP == 42 ? 2 : 1); ++rep_q)
        {
            const float* sc = SC + (size_t)w * 8192; LAS int* idxrow = sidx; const unsigned long long lt_mask = (1ull << lane) - 1ull;
            LAS unsigned* hq = HIST + w * 4096;
            unsigned tl = 0u;
#pragma unroll 8
            for (int i = 0; i < 32; ++i) { const unsigned v = hq[lane * 32 + ((i + lane) & 31)]; tl += (v & 0xffffu) + (v >> 16); }
            const unsigned above_l = wave_above(tl);
            const unsigned long long own = __ballot(above_l < (unsigned)TOPK && above_l + tl >= (unsigned)TOPK);
            const int lo = __ffsll((long long)own) - 1;
            const unsigned above_o = lane_get(above_l, lo);
            const unsigned vw = hq[lo * 32 + (lane >> 1)]; const unsigned cb = (lane & 1) ? (vw >> 16) : (vw & 0xffffu);
            const unsigned above_b = above_o + wave_above(cb);
            const unsigned long long ownb = __ballot(above_b < (unsigned)TOPK && above_b + cb >= (unsigned)TOPK);
            const int lb = __ffsll((long long)ownb) - 1;
            const int b1 = lo * 64 + lb; const unsigned ab1 = lane_get(above_b, lb), cn1 = lane_get(cb, lb);
            if (cn1 > (unsigned)IX_CAP) { __builtin_amdgcn_fence(__ATOMIC_ACQUIRE, "agent"); VM_WAIT(); select_slow(sc, nvis, idxrow, hq, lane); }
            else {
                constexpr int E_ROWS = (TOPK + IX_CAP) / 64;
                LAS unsigned* E = (LAS unsigned*)(KBUF + w * 16384);
                const auto scrs = __builtin_amdgcn_make_buffer_rsrc((void*)sc, 0, 8192 * 4, 0x00020000);
                const unsigned klo = (unsigned)b1 << 20;
                int ebase = 0;
                for (int i0 = 0; i0 < nvis; i0 += 2048) {
                    f32x4 v[8];
#pragma unroll
                    for (int j = 0; j < 8; ++j) v[j] = __builtin_bit_cast(f32x4, __builtin_amdgcn_raw_buffer_load_b128(scrs, (unsigned)(((i0 + j * 256 + 4 * lane) & 8191) * 4), 0, 16));
#pragma unroll
                    for (int jp = 0; jp < 4; ++jp) if (i0 + jp * 512 < nvis) {
                        unsigned kk[2][4], ge[2][4], cnt[2];
#pragma unroll
                        for (int q = 0; q < 2; ++q) { const int e0 = i0 + (2 * jp + q) * 256 + 4 * lane; const unsigned valid = e0 < nvis ? 1u : 0u;
#pragma unroll
                            for (int e = 0; e < 4; ++e) { const float fe = v[2 * jp + q][e]; const unsigned u = __builtin_bit_cast(unsigned, fe); kk[q][e] = u ^ ((unsigned)((int)u >> 31) | 0x80000000u);
                                ge[q][e] = (kk[q][e] >= klo ? 1u : 0u) & valid; }
                            cnt[q] = (ge[q][0] + ge[q][1]) + (ge[q][2] + ge[q][3]); }
                        const unsigned packed = cnt[0] | (cnt[1] << 16);
                        const unsigned scan = wave_scan_incl(packed), total = lane_get(scan, 63), excl = scan - packed;
                        const int tA = (int)(total & 0xffffu);
                        int eo = ebase + (int)(excl & 0xffffu);
#pragma unroll
                        for (int e = 0; e < 4; ++e) { const int e0 = i0 + (2 * jp) * 256 + 4 * lane; if (ge[0][e]) { const u32x2 pr = {kk[0][e], (unsigned)(e0 + e)}; *(LAS u32x2*)(E + 2 * eo) = pr; } eo += (int)ge[0][e]; }
                        eo = ebase + tA + (int)(excl >> 16);
#pragma unroll
                        for (int e = 0; e < 4; ++e) { const int e0 = i0 + (2 * jp + 1) * 256 + 4 * lane; if (ge[1][e]) { const u32x2 pr = {kk[1][e], (unsigned)(e0 + e)}; *(LAS u32x2*)(E + 2 * eo) = pr; } eo += (int)ge[1][e]; }
                        ebase += tA + (int)(total >> 16); }
                }
                LDS_WAIT();
                const int ne = (int)(ab1 + cn1);
                u32x2 en[E_ROWS];
#pragma unroll
                for (int r = 0; r < E_ROWS; ++r) en[r] = *(const LAS u32x2*)(E + 2 * (lane + 64 * r));
                int need = TOPK - (int)ab1;
                LAS unsigned* h2 = hq;
                unsigned prefix = klo;
#pragma unroll 1
                for (int pass = 0; pass < 3; ++pass) {
                    const int shift = pass == 0 ? 12 : pass == 1 ? 4 : 0; const unsigned dmask = pass == 2 ? 15u : 255u; const unsigned himask = 0xffffffffu << (pass == 0 ? 20 : pass == 1 ? 12 : 4);
                    *(LAS u32x4*)(h2 + lane * 4) = (u32x4){0u, 0u, 0u, 0u};
                    LDS_WAIT();
#pragma unroll
                    for (int r = 0; r < E_ROWS; ++r) { const unsigned kk = en[r].x; if (lane + 64 * r < ne && (kk & himask) == (prefix & himask)) __hip_atomic_fetch_add(&h2[(kk >> shift) & dmask], 1u, __ATOMIC_RELAXED, __HIP_MEMORY_SCOPE_WORKGROUP); }
                    LDS_WAIT();
                    const u32x4 c4 = *(const LAS u32x4*)(h2 + lane * 4);
                    const unsigned cnt[4] = {c4.x, c4.y, c4.z, c4.w}; const unsigned tl2 = (c4.x + c4.y) + (c4.z + c4.w);
                    unsigned above = wave_above(tl2); int dsel = -1; unsigned asel = 0u;
#pragma unroll
                    for (int j = 3; j >= 0; --j) { if (dsel < 0 && above < (unsigned)need && above + cnt[j] >= (unsigned)need) { dsel = lane * 4 + j; asel = above; } above += cnt[j]; }
                    const unsigned long long bal = __ballot(dsel >= 0); const int src = __ffsll((long long)bal) - 1;
                    const int d = (int)lane_get((unsigned)dsel, src); const unsigned ab = lane_get(asel, src);
                    need -= (int)ab; prefix |= ((unsigned)d) << shift;
                }
                int selbase = 0, eqseen = 0;
#pragma unroll
                for (int r = 0; r < E_ROWS; ++r) {
                    if (64 * r < ne) {
                        const bool vi = lane + 64 * r < ne; const unsigned kk = en[r].x;
                        const bool gt = vi && kk > prefix, eq = vi && kk == prefix;
                        const unsigned long long beq = __ballot(eq);
                        const int eqrank = eqseen + __popcll(beq & lt_mask);
                        const bool sel = gt || (eq && eqrank < need);
                        const unsigned long long bs = __ballot(sel);
                        if (sel) idxrow[selbase + __popcll(bs & lt_mask)] = (int)en[r].y;
                        selbase += __popcll(bs); eqseen += __popcll(beq);
                    }
                }
            }
        }
        VM_WAIT(); LDS_WAIT();
        attn_one(C, a, q0 + w, TOPK);
        {   const int q0n = (1023 - ncur) * 8;
            if (ncur < 1024 && ((q0n >> 6) + 1) * CHUNK > TOPK) { LDS_WAIT(); IX_PREP(q0n); }
            else {
#pragma unroll
                for (int j_ = 0; j_ < 4; ++j_)
#pragma unroll
                    for (int ks_ = 0; ks_ < 4; ++ks_) asm volatile("" : "=v"(af[j_][ks_]));
#pragma unroll
                for (int p_ = 0; p_ < 2; ++p_)
#pragma unroll
                    for (int T_ = 0; T_ < 2; ++T_) asm volatile("" : "=v"(wA[p_][T_])); } }
        LDS_WAIT(); __syncthreads();
        cur = ncur;
    }
#undef IX_PREP
}

__device__ __forceinline__ void p4_hgrn_out(const Ctx& C, const Args& a, unsigned* qc, volatile LAS unsigned* MISC, int& cur) {
    unsigned char* ws = a.ws;
    const bf16* G = (const bf16*)(ws + WS_G); bf16* QA = (bf16*)(ws + WS_QA); const bf16* VA = (const bf16*)(ws + WS_VA); const bf16* GA = (const bf16*)(ws + WS_GA);
    const bf16* SPT = (const bf16*)(ws + WS_SPT);
    LAS unsigned char* QI = C.lds;
    LAS unsigned char* QM = QI + 64 * R128;
    LAS unsigned char* KM = QM + 64 * R128;
    LAS unsigned char* vT = KM + 64 * R128;
    LAS unsigned char* SCb = vT + 128 * R64;
    LAS float* segtot = (LAS float*)(SCb + 64 * R64);
    LAS float* rsp = segtot + 8 * 128;
    LAS unsigned char* Simg = C.lds + 86016;
    const int tid = C.tid, lane = C.lane, w = C.wave, fr = lane & 15, fq = lane >> 4;
    while (cur < 1024 + NCH * BH) {
        const int it = cur - 1024;
        unsigned nxt = 0u; if (tid == 0) nxt = xb_add(qc, 1u) + (unsigned)C.G;
        const int c = it >> 3, h = it & 7;
        { const char* sp0 = (const char*)(SPT + (size_t)it * 16384);
#pragma unroll
          for (int i = 0; i < 4; ++i) { const int row = 16 * w + 4 * i + (lane >> 4); const int key = (row & 3) | (((row >> 3) & 3) << 2);
              __builtin_amdgcn_global_load_lds((const unsigned*)(sp0 + row * 256 + (((lane & 15) ^ key) << 4)), (LAS unsigned*)(Simg + (16 * w + 4 * i) * 256), 16, 0, 0); } }
        u32x4 gav[2];
#pragma unroll
        for (int u = 0; u < 2; ++u) gav[u] = *(const u32x4*)(GA + (size_t)(c * CHUNK + 16 * (w >> 1) + fr) * AW + h * 128 + 64 * (w & 1) + 32 * u + 8 * fq);
        {
            const int k2 = tid & 63, seg = tid >> 6, t0 = c * CHUNK + seg * 8;
            f32x2 g[8], cum[8]; f32x2 run = {0.f, 0.f};
#pragma unroll
            for (int i = 0; i < 8; ++i) { const unsigned gw_ = *(const unsigned*)(G + (size_t)(t0 + i) * AW + h * 128 + 2 * k2); g[i] = (f32x2){bflo(gw_), bfhi(gw_)}; run += g[i]; cum[i] = run; }
            unsigned qv[8];
#pragma unroll
            for (int i = 0; i < 8; ++i) qv[i] = *(const unsigned*)(QA + (size_t)(t0 + i) * AW + h * 128 + 2 * k2);
            segtot[seg * 128 + 2 * k2] = run.x; segtot[seg * 128 + 2 * k2 + 1] = run.y;
            { const int v = tid & 127, sg = tid >> 7, tv = c * CHUNK + sg * 16; unsigned vp[8];
#pragma unroll
              for (int i = 0; i < 8; ++i) vp[i] = (unsigned)VA[(size_t)(tv + 2 * i) * AW + h * 128 + v] | ((unsigned)VA[(size_t)(tv + 2 * i + 1) * AW + h * 128 + v] << 16);
              *(LAS u32x4*)(vT + v * R64 + sg * 32) = (u32x4){vp[0], vp[1], vp[2], vp[3]}; *(LAS u32x4*)(vT + v * R64 + sg * 32 + 16) = (u32x4){vp[4], vp[5], vp[6], vp[7]}; }
            __syncthreads();
            f32x2 pre = {0.f, 0.f}, cmid = {0.f, 0.f};
#pragma unroll
            for (int s2 = 0; s2 < 8; ++s2) { const f32x2 st = {segtot[s2 * 128 + 2 * k2], segtot[s2 * 128 + 2 * k2 + 1]}; if (s2 < seg) pre += st; if (s2 < 4) cmid += st; }
#pragma unroll
            for (int i = 0; i < 8; ++i) {
                const f32x2 cm = cum[i] + pre; const float q0 = bflo(qv[i]), q1 = bfhi(qv[i]);
                const int row = seg * 8 + i;
                *(LAS unsigned*)(QI + row * R128 + 4 * k2) = pk2(q0 * __expf(cm.x), q1 * __expf(cm.y));
                *(LAS unsigned*)(QM + row * R128 + 4 * k2) = pk2(q0 * __expf(cm.x - cmid.x), q1 * __expf(cm.y - cmid.y));
                *(LAS unsigned*)(KM + row * R128 + 4 * k2) = pk2((1.f - __expf(g[i].x)) * __expf(cmid.x - cm.x), (1.f - __expf(g[i].y)) * __expf(cmid.y - cm.y));
            }
        }
        VM_WAIT();
        __syncthreads();
        const int tt = w >> 1;
        {
            f32x4 sa[2] = {{0.f, 0.f, 0.f, 0.f}, {0.f, 0.f, 0.f, 0.f}};
#pragma unroll
            for (int ks = 0; ks < 4; ++ks) {
                const bf16x8 qf = *(const LAS bf16x8*)(QM + (16 * tt + fr) * R128 + (32 * ks + 8 * fq) * 2);
#pragma unroll
                for (int si = 0; si < 2; ++si) { const bf16x8 kf = *(const LAS bf16x8*)(KM + (16 * (2 * (w & 1) + si) + fr) * R128 + (32 * ks + 8 * fq) * 2);
                    sa[si] = __builtin_amdgcn_mfma_f32_16x16x32_bf16(qf, kf, sa[si], 0, 0, 0); }
            }
#pragma unroll
            for (int si = 0; si < 2; ++si)
#pragma unroll
                for (int r = 0; r < 4; ++r) { const int t = 16 * tt + 4 * fq + r, s = 16 * (2 * (w & 1) + si) + fr;
                    *(LAS unsigned short*)(SCb + t * R64 + s * 2) = (unsigned short)f2bf(s <= t ? sa[si][r] : 0.f); }
        }
        __syncthreads();
        f32x4 acc[4];
#pragma unroll
        for (int ni = 0; ni < 4; ++ni) acc[ni] = (f32x4){0.f, 0.f, 0.f, 0.f};
        {
#pragma unroll
            for (int ks = 0; ks < 4; ++ks) {
                const bf16x8 qf = *(const LAS bf16x8*)(QI + (16 * tt + fr) * R128 + (32 * ks + 8 * fq) * 2);
#pragma unroll
                for (int ni = 0; ni < 4; ++ni) { const int n = 64 * (w & 1) + 32 * (ni >> 1) + 8 * (fr >> 2) + 4 * (ni & 1) + (fr & 3);
                    const bf16x8 sf = *(const LAS bf16x8*)(Simg + n * 256 + (((4 * ks + fq) ^ fr) << 4));
                    acc[ni] = __builtin_amdgcn_mfma_f32_16x16x32_bf16(sf, qf, acc[ni], 0, 0, 0); }
            }
#pragma unroll
            for (int ks = 0; ks < 2; ++ks) {
                const bf16x8 pf = *(const LAS bf16x8*)(SCb + (16 * tt + fr) * R64 + (32 * ks + 8 * fq) * 2);
#pragma unroll
                for (int ni = 0; ni < 4; ++ni) { const bf16x8 vf = *(const LAS bf16x8*)(vT + (64 * (w & 1) + 32 * (ni >> 1) + 8 * (fr >> 2) + 4 * (ni & 1) + (fr & 3)) * R64 + (32 * ks + 8 * fq) * 2);
                    acc[ni] = __builtin_amdgcn_mfma_f32_16x16x32_bf16(vf, pf, acc[ni], 0, 0, 0); }
            }
        }
        { float sq = 0.f;
#pragma unroll
          for (int ni = 0; ni < 4; ++ni) sq += (acc[ni][0] * acc[ni][0] + acc[ni][1] * acc[ni][1]) + (acc[ni][2] * acc[ni][2] + acc[ni][3] * acc[ni][3]);
          sq = rows_sum(sq);
          if (fq == 0) rsp[(16 * tt + fr) * 2 + (w & 1)] = sq; }
        __syncthreads();
        { const int tl = 16 * tt + fr; const float rstd = rsqrtf((rsp[tl * 2] + rsp[tl * 2 + 1]) * (1.f / 128.f) + EPS);
          bf16* orow = QA + (size_t)(c * CHUNK + tl) * AW + h * 128 + 64 * (w & 1) + 8 * fq;
#pragma unroll
          for (int u = 0; u < 2; ++u) { const int v0 = 64 * (w & 1) + 32 * u + 8 * fq; const f32x4 n0 = *(const f32x4*)(a.gnorm_a + v0), n1 = *(const f32x4*)(a.gnorm_a + v0 + 4);
              const f32x4 x0 = acc[2 * u], x1 = acc[2 * u + 1]; const u32x4 gv = gav[u]; u32x4 o;
              o.x = pk2(x0[0] * rstd * n0[0] * bflo(gv.x), x0[1] * rstd * n0[1] * bfhi(gv.x)); o.y = pk2(x0[2] * rstd * n0[2] * bflo(gv.y), x0[3] * rstd * n0[3] * bfhi(gv.y));
              o.z = pk2(x1[0] * rstd * n1[0] * bflo(gv.z), x1[1] * rstd * n1[1] * bfhi(gv.z)); o.w = pk2(x1[2] * rstd * n1[2] * bflo(gv.w), x1[3] * rstd * n1[3] * bfhi(gv.w));
              *(u32x4*)(orow + 32 * u) = o; } }
        if (tid == 0) MISC[MISC_Q4] = nxt;
        LDS_WAIT(); __syncthreads();
        cur = __builtin_amdgcn_readfirstlane((int)MISC[MISC_Q4]);
    }
}

struct SchedUV {
    pg8::TileOrder T; const char* Ab; const char* Bb;
    __device__ __forceinline__ bool next(int i, pg8::Unit& u) const { u.sub = 0; return T.tile(i, u.pm, u.pn); }
    __device__ __forceinline__ const char* A(const pg8::Unit& u) const { return Ab + ((size_t)u.pm * 256 * 2048 + (size_t)u.pn * 512) * 2; }
    __device__ __forceinline__ const char* B(const pg8::Unit& u) const { return Bb + (size_t)u.pn * 256 * 512 * 2; }
    __device__ __forceinline__ bool keep(const pg8::Unit&) const { return false; }
};
struct EpiUV {
    unsigned char* ws;
    __device__ __forceinline__ void operator()(f32x4 (&acc)[2][2][4][2], const pg8::Unit& u, int wr, int wc, int fr, int fq) const {
        bf16* O = (bf16*)(ws + WS_GB);
        EPI_FOREACH({ const u32x4 gv = *(const u32x4*)(O + (size_t)row * AW + col); u32x4 w;
            w.x = pk2(v0[0] * bflo(gv.x), v0[1] * bfhi(gv.x)); w.y = pk2(v0[2] * bflo(gv.y), v0[3] * bfhi(gv.y)); w.z = pk2(v1[0] * bflo(gv.z), v1[1] * bfhi(gv.z)); w.w = pk2(v1[2] * bflo(gv.w), v1[3] * bfhi(gv.w));
            *(u32x4*)(O + (size_t)row * AW + col) = w; })
    }
};
struct SchedMerge {
    pg8::TileOrder T; const char* Aa; const char* Ab; const char* Ba; const char* Bb;
    __device__ __forceinline__ bool next(int i, pg8::Unit& u) const { u.sub = i & 1; return T.tile(i >> 1, u.pm, u.pn); }
    __device__ __forceinline__ const char* A(const pg8::Unit& u) const { return (u.sub ? Ab : Aa) + (size_t)u.pm * 256 * AW * 2; }
    __device__ __forceinline__ const char* B(const pg8::Unit& u) const { return (u.sub ? Bb : Ba) + (size_t)u.pn * 256 * AW * 2; }
    __device__ __forceinline__ bool keep(const pg8::Unit& u) const { return u.sub == 0; }
};
struct EpiMerge {
    unsigned char* ws;
#define EM_LD(dst_, base_, row_, col_) asm volatile("global_load_dwordx4 %0, %1, %2" : "=v"(dst_) : "v"((unsigned)(((row_) * D_ + (col_)) * 2)), "s"(base_) : "memory")
#define EM_WAIT8(v_) asm volatile("s_waitcnt vmcnt(0)" : "+v"(v_[0][0]), "+v"(v_[0][1]), "+v"(v_[1][0]), "+v"(v_[1][1]), "+v"(v_[2][0]), "+v"(v_[2][1]), "+v"(v_[3][0]), "+v"(v_[3][1]))
    __device__ __forceinline__ void operator()(f32x4 (&acc)[2][2][4][2], const pg8::Unit& u, int wr, int wc, int fr, int fq) const {
        const bf16* SA = (const bf16*)(ws + WS_SA); bf16* SB = (bf16*)(ws + WS_SB);
        if (u.sub == 0) {
#pragma unroll
            for (int ai = 0; ai < 2; ++ai) { u32x4 av[4][2], bv[4][2];
#pragma unroll
                for (int m = 0; m < 4; ++m)
#pragma unroll
                    for (int bj = 0; bj < 2; ++bj) { const int row = u.pm * 256 + ai * 128 + wr * 64 + m * 16 + fr, col = u.pn * 256 + bj * 128 + wc * 32 + 8 * fq;
                        EM_LD(av[m][bj], SA, row, col); EM_LD(bv[m][bj], SB, row, col); }
                EM_WAIT8(av); EM_WAIT8(bv);
#pragma unroll
                for (int m = 0; m < 4; ++m)
#pragma unroll
                    for (int bj = 0; bj < 2; ++bj) { const u32x4 a4 = av[m][bj], b4 = bv[m][bj]; f32x4& v0 = acc[ai][bj][m][0]; f32x4& v1 = acc[ai][bj][m][1];
                        v0[0] *= bflo(a4.x) * __builtin_amdgcn_rcpf(bflo(b4.x)); v0[1] *= bfhi(a4.x) * __builtin_amdgcn_rcpf(bfhi(b4.x)); v0[2] *= bflo(a4.y) * __builtin_amdgcn_rcpf(bflo(b4.y)); v0[3] *= bfhi(a4.y) * __builtin_amdgcn_rcpf(bfhi(b4.y));
                        v1[0] *= bflo(a4.z) * __builtin_amdgcn_rcpf(bflo(b4.z)); v1[1] *= bfhi(a4.z) * __builtin_amdgcn_rcpf(bfhi(b4.z)); v1[2] *= bflo(a4.w) * __builtin_amdgcn_rcpf(bflo(b4.w)); v1[3] *= bfhi(a4.w) * __builtin_amdgcn_rcpf(bfhi(b4.w)); } }
        } else {
#pragma unroll
            for (int ai = 0; ai < 2; ++ai) { u32x4 bv[4][2];
#pragma unroll
                for (int m = 0; m < 4; ++m)
#pragma unroll
                    for (int bj = 0; bj < 2; ++bj) { const int row = u.pm * 256 + ai * 128 + wr * 64 + m * 16 + fr, col = u.pn * 256 + bj * 128 + wc * 32 + 8 * fq; EM_LD(bv[m][bj], SB, row, col); }
                EM_WAIT8(bv);
#pragma unroll
                for (int m = 0; m < 4; ++m)
#pragma unroll
                    for (int bj = 0; bj < 2; ++bj) { const int row = u.pm * 256 + ai * 128 + wr * 64 + m * 16 + fr, col = u.pn * 256 + bj * 128 + wc * 32 + 8 * fq;
                        const u32x4 b4 = bv[m][bj]; const f32x4 v0 = acc[ai][bj][m][0], v1 = acc[ai][bj][m][1]; u32x4 w;
                        w.x = pk2(v0[0] * bflo(b4.x), v0[1] * bfhi(b4.x)); w.y = pk2(v0[2] * bflo(b4.y), v0[3] * bfhi(b4.y)); w.z = pk2(v1[0] * bflo(b4.z), v1[1] * bfhi(b4.z)); w.w = pk2(v1[2] * bflo(b4.w), v1[3] * bfhi(b4.w));
                        *(u32x4*)(SB + (size_t)row * D_ + col) = w; } }
        }
    }
#undef EM_LD
#undef EM_WAIT8
};
struct EpiOut {
    const float* x; bf16* ybf;
    __device__ __forceinline__ void operator()(f32x4 (&acc)[2][2][4][2], const pg8::Unit& u, int wr, int wc, int fr, int fq) const {
#pragma unroll
        for (int ai = 0; ai < 2; ++ai) {
            f32x4 xv[4][2][2];
#pragma unroll
            for (int m = 0; m < 4; ++m)
#pragma unroll
                for (int bj = 0; bj < 2; ++bj)
#pragma unroll
                    for (int hf = 0; hf < 2; ++hf) { const int row = u.pm * 256 + ai * 128 + wr * 64 + m * 16 + fr, col = u.pn * 256 + bj * 128 + wc * 32 + 8 * fq + 4 * hf;
                        asm volatile("global_load_dwordx4 %0, %1, %2" : "=v"(xv[m][bj][hf]) : "v"((unsigned)((row * D_ + col) * 4)), "s"(x) : "memory"); }
            asm volatile("s_waitcnt vmcnt(0)" : "+v"(xv[0][0][0]), "+v"(xv[0][0][1]), "+v"(xv[0][1][0]), "+v"(xv[0][1][1]), "+v"(xv[1][0][0]), "+v"(xv[1][0][1]), "+v"(xv[1][1][0]), "+v"(xv[1][1][1]),
                                                "+v"(xv[2][0][0]), "+v"(xv[2][0][1]), "+v"(xv[2][1][0]), "+v"(xv[2][1][1]), "+v"(xv[3][0][0]), "+v"(xv[3][0][1]), "+v"(xv[3][1][0]), "+v"(xv[3][1][1]));
#pragma unroll
            for (int m = 0; m < 4; ++m)
#pragma unroll
                for (int bj = 0; bj < 2; ++bj) { const int row = u.pm * 256 + ai * 128 + wr * 64 + m * 16 + fr, col = u.pn * 256 + bj * 128 + wc * 32 + 8 * fq; const size_t off = (size_t)row * D_ + col;
                    const f32x4 y0 = xv[m][bj][0] + acc[ai][bj][m][0], y1 = xv[m][bj][1] + acc[ai][bj][m][1];
                    u32x4 pw; pw.x = pk2(y0[0], y0[1]); pw.y = pk2(y0[2], y0[3]); pw.z = pk2(y1[0], y1[1]); pw.w = pk2(y1[2], y1[3]);
                    *(u32x4*)(ybf + off) = pw; }
        }
    }
};
__device__ __forceinline__ int uv_key(int n) { return swz_sigma((n & 3) | (((n >> 3) & 3) << 2)); }
__device__ __forceinline__ void p6_uv(const Ctx& C, const Args& a) {
    unsigned char* ws = a.ws;
    const bf16* OL = (const bf16*)(ws + WS_RAW); const char* WUVb = (const char*)(ws + WS_WUV); bf16* GB = (bf16*)(ws + WS_GB);
    const int lane = C.lane, w = C.wave, fr = lane & 15, fq = lane >> 4;
    LAS unsigned char* Wl = C.lds;
    for (int u = C.wg; u < 256; u += C.G) {
        const int rb = u >> 3, h = u & 7;
#pragma unroll
        for (int i = 0; i < 8; ++i) { const int n = 16 * w + 2 * i + (lane >> 5), pos = lane & 31; const int sc = (pos & 16) | ((pos & 15) ^ uv_key(n));
            __builtin_amdgcn_global_load_lds((const unsigned*)(WUVb + ((size_t)(h * 128 + n) * 512 + (h & 1) * 256) * 2 + sc * 16), (LAS unsigned*)(Wl + (16 * w + 2 * i) * 512), 16, 0, 0); }
        bf16x8 of[2][8];
#pragma unroll
        for (int m = 0; m < 2; ++m)
#pragma unroll
            for (int ks = 0; ks < 8; ++ks) of[m][ks] = *(const bf16x8*)(OL + (size_t)(rb * 256 + 32 * w + 16 * m + fr) * 2048 + h * 256 + 32 * ks + 8 * fq);
        asm volatile("" ::: "memory");
        u32x4 gvv[2][4];
#pragma unroll
        for (int m = 0; m < 2; ++m)
#pragma unroll
            for (int t = 0; t < 4; ++t) gvv[m][t] = *(const u32x4*)(GB + (size_t)(rb * 256 + 32 * w + 16 * m + fr) * AW + h * 128 + 8 * fq + 32 * t);
        asm volatile("s_waitcnt vmcnt(8)" ::: "memory");
        __syncthreads();
        f32x4 acc[8][2];
#pragma unroll
        for (int nt = 0; nt < 8; ++nt)
#pragma unroll
            for (int m = 0; m < 2; ++m) acc[nt][m] = (f32x4){0.f, 0.f, 0.f, 0.f};
#pragma unroll
        for (int ks = 0; ks < 8; ++ks) {
            bf16x8 wf[8];
#pragma unroll
            for (int nt = 0; nt < 8; ++nt) { const int n = 32 * (nt >> 1) + 8 * (fr >> 2) + 4 * (nt & 1) + (fr & 3), c = 4 * ks + fq;
                wf[nt] = *(const LAS bf16x8*)(Wl + n * 512 + ((((c & 15) ^ uv_key(n)) | (c & 16)) << 4)); }
#pragma unroll
            for (int nt = 0; nt < 8; ++nt)
#pragma unroll
                for (int m = 0; m < 2; ++m) acc[nt][m] = __builtin_amdgcn_mfma_f32_16x16x32_bf16(wf[nt], of[m][ks], acc[nt][m], 0, 0, 0);
        }
#pragma unroll
        for (int m = 0; m < 2; ++m) { bf16* gp = GB + (size_t)(rb * 256 + 32 * w + 16 * m + fr) * AW + h * 128 + 8 * fq;
#pragma unroll
            for (int t = 0; t < 4; ++t) { const u32x4 gv = gvv[m][t]; const f32x4 x0 = acc[2 * t][m], x1 = acc[2 * t + 1][m]; u32x4 o;
                o.x = pk2(x0[0] * bflo(gv.x), x0[1] * bfhi(gv.x)); o.y = pk2(x0[2] * bflo(gv.y), x0[3] * bfhi(gv.y)); o.z = pk2(x1[0] * bflo(gv.z), x1[1] * bfhi(gv.z)); o.w = pk2(x1[2] * bflo(gv.w), x1[3] * bfhi(gv.w));
                *(u32x4*)(gp + 32 * t) = o; } }
        LDS_WAIT(); __syncthreads();
    }
}

__device__ __forceinline__ void p9_final_norm(const Ctx& C, const Args& a) {
    const bf16* YBF = (const bf16*)(a.ws + WS_G);
    const int gw = C.wg * NWAVES + C.wave, NGW = C.G * NWAVES;
    f32x4 fw[4][2];
#pragma unroll
    for (int j = 0; j < 4; ++j) { fw[j][0] = ((const f32x4*)a.final_norm_w)[2 * (C.lane + 64 * j)]; fw[j][1] = ((const f32x4*)a.final_norm_w)[2 * (C.lane + 64 * j) + 1]; }
    for (int m = gw; m < S_; m += NGW) {
        const u32x4* yr = (const u32x4*)(YBF + (size_t)m * D_) + C.lane; f32x4* orow = (f32x4*)(a.out + (size_t)m * D_);
        u32x4 yq[4]; float ss = 0.f;
#pragma unroll
        for (int j = 0; j < 4; ++j) { yq[j] = yr[64 * j];
#pragma unroll
            for (int e = 0; e < 4; ++e) { const unsigned wv = yq[j][e]; const float lo = bflo(wv), hi = bfhi(wv); ss += lo * lo + hi * hi; } }
        const float rs = rsqrtf(wave_sum(ss) * (1.f / D_) + EPS);
#pragma unroll
        for (int j = 0; j < 4; ++j) { const u32x4 yv = yq[j]; const int c4 = 2 * (C.lane + 64 * j);
            const f32x4 w0 = fw[j][0], w1 = fw[j][1];
            f32x4 o0, o1; o0.x = bflo(yv.x) * rs * w0.x; o0.y = bfhi(yv.x) * rs * w0.y; o0.z = bflo(yv.y) * rs * w0.z; o0.w = bfhi(yv.y) * rs * w0.w;
            o1.x = bflo(yv.z) * rs * w1.x; o1.y = bfhi(yv.z) * rs * w1.y; o1.z = bflo(yv.w) * rs * w1.z; o1.w = bfhi(yv.w) * rs * w1.w;
            orow[c4] = o0; orow[c4 + 1] = o1; }
    }
}

#ifndef MK_N_LAUNCHES
#define MK_N_LAUNCHES 1
#endif
constexpr int N_PHASES = 10;
__global__ void __launch_bounds__(NTHR, 2) mega_fwd(Args a) {
    extern __shared__ __attribute__((aligned(16))) unsigned char lds_raw[];
    Ctx C; C.lds = (LAS unsigned char*)lds_raw; C.tid = threadIdx.x; C.lane = C.tid & 63; C.wave = __builtin_amdgcn_readfirstlane(C.tid >> 6); C.wg = blockIdx.x; C.G = gridDim.x;
    volatile LAS unsigned* MISC = (volatile LAS unsigned*)(C.lds + MISC_OFF);
    if (C.tid < 32) MISC[C.tid] = 0u;
    __syncthreads();
    unsigned char* ws = a.ws;
    XcdBarrier bar; bar.bar = (unsigned*)(ws + WS_CTL) + CW_BAR; bar.x = 0; bar.st = nullptr;
    const int lo = a.ph_lo, hi = a.ph_hi;
    if (hi - lo > 1) bar = xcd_barrier_post((unsigned*)(ws + WS_CTL) + CW_BAR, MISC + 8);
#define IN(k) (lo <= (k) && (k) < hi)
#define SEAM(k) do { if (IN(k) && IN((k) + 1)) xcd_barrier(bar); } while (0)
    float* dscr = a.out;
    if (IN(0)) { REP(0) p0_prep(C, a); } SEAM(0);
    if (IN(1)) {
        SchedPlain S; S.T.init(S_, NIN, C.G, C.wg); S.Ab = (const char*)(ws + WS_H); S.Bb = (const char*)(ws + WS_WIN); S.tA = (size_t)256 * D_ * 2; S.tB = (size_t)256 * D_ * 2;
        EpiProj E{ws};
        if (C.wg & 1) { p1_side(C, a); pg8::gemm_phase(C.lds, D_, D_, D_, S, E); }
        else { pg8::gemm_phase(C.lds, D_, D_, D_, S, E); p1_side(C, a); }
    } SEAM(1);
    if (IN(2)) { REP(2) p2_norms(C, a); REP(12) p2_hgrn_states(C, a, (bf16*)dscr); } SEAM(2);
    if (IN(3)) {
        SchedPlain S; S.T.init(S_, 4096, C.G, C.wg); S.Ab = (const char*)(ws + WS_CQN); S.Bb = (const char*)(ws + WS_WQ); S.tA = (size_t)256 * QR * 2; S.tB = (size_t)256 * QR * 2;
        EpiQ E{ws}; REP(3) pg8::gemm_phase(C.lds, QR, QR, QR, S, E);
        REP(13) p3_scan(C, a, (const bf16*)dscr);
    }
    if (IN(4)) attn_setup(C, a);
    SEAM(3);
    if (IN(4)) {
        unsigned* qc = (unsigned*)(ws + WS_CTL) + CW_Q4;
        int cur = C.wg;
        p4_indexer(C, a, dscr, qc, MISC, cur); p4_hgrn_out(C, a, qc, MISC, cur);
    } SEAM(4);
    if (IN(6)) { p6_uv(C, a);
    } SEAM(6);
    if (IN(7)) {
        SchedMerge S; S.T.init(S_, D_, C.G, C.wg); S.Aa = (const char*)(ws + WS_QA); S.Ab = (const char*)(ws + WS_GB); S.Ba = (const char*)(ws + WS_WPA); S.Bb = (const char*)(ws + WS_WPB);
        EpiMerge E{ws}; pg8::gemm_phase(C.lds, AW, AW, AW, S, E);
    } SEAM(7);
    if (IN(8)) {
        SchedPlain S; S.T.init(S_, D_, C.G, C.wg); S.Ab = (const char*)(ws + WS_SB); S.Bb = (const char*)(ws + WS_WOUT); S.tA = (size_t)256 * D_ * 2; S.tB = (size_t)256 * D_ * 2;
        EpiOut E{a.x, (bf16*)(ws + WS_G)}; pg8::gemm_phase(C.lds, D_, D_, D_, S, E);
    } SEAM(8);
    if (IN(9)) { p9_final_norm(C, a); }
#undef IN
#undef SEAM
}

extern "C" void kernel_launch(void* const* d_in, const int* in_sizes, int n_in, void* d_out, int out_size, void* d_ws, size_t ws_size, hipStream_t stream) {
    static int grid = 0;
    if (grid == 0) {
        if (n_in != 17 || in_sizes[0] != S_ * D_ || out_size != S_ * D_ || ws_size < WS_END) {
            fprintf(stderr, "kernel_launch: unexpected shapes / workspace (n_in %d, in0 %d, out %d, ws %zu < %zu); nothing launched\n", n_in, n_in > 0 ? in_sizes[0] : -1, out_size, ws_size, (size_t)WS_END); grid = -1; return; }
        int dev = 0, cus = 0;
        if (hipGetDevice(&dev) != hipSuccess || hipDeviceGetAttribute(&cus, hipDeviceAttributeMultiprocessorCount, dev) != hipSuccess) { grid = -1; return; }
        if (hipFuncSetAttribute((const void*)mega_fwd, hipFuncAttributeMaxDynamicSharedMemorySize, LDS_BYTES) != hipSuccess) { fprintf(stderr, "kernel_launch: hipFuncSetAttribute failed\n"); grid = -1; return; }
        (void)hipGetLastError();
        grid = cus;
    }
    if (grid < 0) return;
    (void)hipMemsetAsync((char*)d_ws + WS_CTL, 0, CTL_ZERO_BYTES, stream);
    Args a{};
    const float** ip = (const float**)&a;
    for (int i = 0; i < 17; ++i) ip[i] = (const float*)d_in[i];
    a.out = (float*)d_out; a.ws = (unsigned char*)d_ws;
    constexpr int NL = MK_N_LAUNCHES;
    for (int li = 0; li < NL; ++li) {
        a.ph_lo = li * N_PHASES / NL; a.ph_hi = (li + 1) * N_PHASES / NL;
        hipLaunchKernelGGL(mega_fwd, dim3(grid), dim3(NTHR), LDS_BYTES, stream, a);
    }
}
```
